# Optimizing an MI355X kernel written in HIP

```python
import math
import jax, jax.numpy as jnp
from jax import lax
import numpy as np

D_MODEL = 1024
BATCH = 8
SEQ = 2048
DEPTH = 1
DEC_BATCH = 128
DEC_SEQ = 8
PAST_LEN = 16384
PAGE_SIZE = 128

D_MIX = D_MODEL
HG_HEADS = 4
HG_DK = 128
HG_DV = D_MIX // 2 // HG_HEADS
ML_HEADS = 4
ML_DK = 128
ML_DV = D_MIX // 2 // ML_HEADS
HG_KW = HG_HEADS * HG_DK
HG_W = HG_HEADS * HG_DV
ML_KW = ML_HEADS * ML_DK
ML_W = ML_HEADS * ML_DV
D_FF = 2816
CONV_W = 3
CHUNK = 64
EPS = 1e-6
IN_SIZES = (HG_KW, HG_KW, HG_W, HG_W, ML_KW, ML_KW, ML_W, ML_W, ML_HEADS, ML_HEADS)
IN_COLS = 2 * HG_KW + 2 * HG_W + 2 * ML_KW + 2 * ML_W + 2 * ML_HEADS

kernel_name = 'hymba_hgrn2_mlstm_convffn_step'


def _split_points():
    pts, acc = [], 0
    for s in IN_SIZES[:-1]:
        acc += s
        pts.append(acc)
    return pts


def _rmsnorm(x, g):
    xf = x.astype(jnp.float32)
    y = xf * lax.rsqrt(jnp.mean(xf * xf, axis=-1, keepdims=True) + EPS)
    return (y * g.astype(jnp.float32)).astype(x.dtype)


def _chunk_len(T):
    return max(d for d in range(1, min(CHUNK, T) + 1) if T % d == 0)


def _to_chunks(a, L):
    B, T, H, d = a.shape
    return a.reshape(B, T // L, L, H, d).transpose(1, 0, 3, 2, 4)


def _from_chunks(a):
    N, B, H, L, d = a.shape
    return a.transpose(1, 0, 3, 2, 4).reshape(B, N * L, H, d)


def _hgrn2_chunked(q, logf, k, v, S0):
    T = q.shape[1]
    L = _chunk_len(T)
    mask = jnp.tril(jnp.ones((L, L), dtype=bool))

    def body(S, inp):
        qc, gc, kc, vc = inp
        b = jnp.cumsum(gc, axis=2)
        inter = jnp.einsum('bhtk,bhkv->bhtv', qc * jnp.exp(b), S)
        diff = b[:, :, :, None, :] - b[:, :, None, :, :]
        decay = jnp.exp(jnp.where(mask[:, :, None], diff, -jnp.inf))
        A = jnp.einsum('bhtk,bhtsk,bhsk->bhts', qc, decay, kc)
        intra = jnp.einsum('bhts,bhsv->bhtv', A, vc)
        b_last = b[:, :, -1]
        S_new = jnp.exp(b_last)[..., None] * S + jnp.einsum(
            'bhsk,bhsv->bhkv', kc * jnp.exp(b_last[:, :, None] - b), vc)
        return S_new, inter + intra

    S_end, o = lax.scan(body, S0, (_to_chunks(q, L), _to_chunks(logf, L),
                                   _to_chunks(k, L), _to_chunks(v, L)))
    return _from_chunks(o), S_end


def _mlstm_chunked(q, k, v, ig, lf, C0, n0, m0):
    T = q.shape[1]
    L = _chunk_len(T)
    mask = jnp.tril(jnp.ones((L, L), dtype=bool))

    def body(carry, inp):
        C, n, m = carry
        qc, kc, vc, ic, fc = inp
        ic = ic[..., 0]
        fc = fc[..., 0]
        a = jnp.cumsum(fc, axis=-1)
        logD = a[..., :, None] - a[..., None, :] + ic[..., None, :]
        logD = jnp.where(mask, logD, -jnp.inf)
        log_inter = a + m[..., None]
        m_t = jnp.maximum(log_inter, jnp.max(logD, axis=-1))
        Dw = jnp.exp(logD - m_t[..., None])
        wi = jnp.exp(log_inter - m_t)
        Sw = jnp.einsum('bhtk,bhsk->bhts', qc, kc) * Dw
        num = wi[..., None] * jnp.einsum('bhtk,bhkv->bhtv', qc, C) + jnp.einsum('bhts,bhsv->bhtv', Sw, vc)
        den = wi * jnp.einsum('bhtk,bhk->bht', qc, n) + jnp.sum(Sw, axis=-1)
        h = num / jnp.maximum(jnp.abs(den), jnp.exp(-m_t))[..., None]
        a_L = a[..., -1]
        log_end = a_L[..., None] - a + ic
        m_new = jnp.maximum(a_L + m, jnp.max(log_end, axis=-1))
        w_end = jnp.exp(log_end - m_new[..., None])
        f_end = jnp.exp(a_L + m - m_new)
        C_new = f_end[..., None, None] * C + jnp.einsum('bhs,bhsk,bhsv->bhkv', w_end, kc, vc)
        n_new = f_end[..., None] * n + jnp.einsum('bhs,bhsk->bhk', w_end, kc)
        return (C_new, n_new, m_new), h

    (C_e, n_e, m_e), h = lax.scan(body, (C0, n0, m0), (
        _to_chunks(q, L), _to_chunks(k, L), _to_chunks(v, L),
        _to_chunks(ig[..., None], L), _to_chunks(lf[..., None], L)))
    return _from_chunks(h), C_e, n_e, m_e


def _layer(x, S_hg, C_ml, n_ml, m_ml, conv_buf, lb, norm1_g, w_in, hg_norm_g, ml_b_ig,
           ml_b_fg, ml_norm_g, w_out, norm2_g, w_gate, w_val, conv_w, conv_b, w_down):
    B, T, _ = x.shape
    f32 = jnp.float32
    h = _rmsnorm(x, norm1_g)
    proj = h @ w_in
    hq, hf, hi, hgate, mq, mk, mv, mo, mig, mfg = jnp.split(proj, _split_points(), axis=-1)

    f = lb + (1.0 - lb) * jax.nn.sigmoid(hf.astype(f32))
    logf = jnp.log(f).reshape(B, T, HG_HEADS, HG_DK)
    k_hg = (1.0 - f).reshape(B, T, HG_HEADS, HG_DK)
    o_hg, S_new = _hgrn2_chunked(hq.astype(f32).reshape(B, T, HG_HEADS, HG_DK), logf, k_hg,
                                 hi.astype(f32).reshape(B, T, HG_HEADS, HG_DV), S_hg.astype(f32))
    o_hg = _rmsnorm(o_hg, hg_norm_g.reshape(HG_HEADS, HG_DV)) * jax.nn.silu(
        hgate.astype(f32).reshape(B, T, HG_HEADS, HG_DV))
    o_hg = o_hg.reshape(B, T, HG_W).astype(x.dtype)

    q_ml = mq.astype(f32).reshape(B, T, ML_HEADS, ML_DK)
    k_ml = mk.astype(f32).reshape(B, T, ML_HEADS, ML_DK) * (ML_DK ** -0.5)
    v_ml = mv.astype(f32).reshape(B, T, ML_HEADS, ML_DV)
    ig = (mig + ml_b_ig).astype(f32)
    lf = jax.nn.log_sigmoid((mfg + ml_b_fg).astype(f32))
    o_ml, C_new, n_new, m_new = _mlstm_chunked(q_ml, k_ml, v_ml, ig, lf, C_ml.astype(f32),
                                               n_ml.astype(f32), m_ml.astype(f32))
    o_ml = _rmsnorm(o_ml, ml_norm_g.reshape(ML_HEADS, ML_DV)) * jax.nn.sigmoid(
        mo.astype(f32).reshape(B, T, ML_HEADS, ML_DV))
    o_ml = o_ml.reshape(B, T, ML_W).astype(x.dtype)

    x = x + jnp.concatenate([o_hg, o_ml], axis=-1) @ w_out

    h2 = _rmsnorm(x, norm2_g)
    u = h2 @ w_gate
    val = h2 @ w_val
    upad = jnp.concatenate([conv_buf.astype(u.dtype), u], axis=1)
    conv = conv_b
    for j in range(CONV_W):
        conv = conv + conv_w[j] * upad[:, j:j + T]
    x = x + (jax.nn.gelu(conv) * val) @ w_down
    new_buf = upad[:, T:]
    dt = x.dtype
    return x, S_new.astype(dt), C_new.astype(dt), n_new.astype(dt), m_new.astype(dt), new_buf.astype(dt)


def _trunk(x, S_hg, C_ml, n_ml, m_ml, conv_buf, norm1_g, w_in, hg_lb_logits, hg_norm_g, ml_b_ig,
           ml_b_fg, ml_norm_g, w_out, norm2_g, w_gate, w_val, conv_w, conv_b, w_down, final_norm_g):
    lb_all = jnp.cumsum(jax.nn.softmax(hg_lb_logits.astype(jnp.float32), axis=0), axis=0)
    Ss, Cs, ns, ms, bufs = [], [], [], [], []
    for l in range(DEPTH):
        x, s, c, n, m, b = _layer(x, S_hg[l], C_ml[l], n_ml[l], m_ml[l], conv_buf[l], lb_all[l],
                                  norm1_g[l], w_in[l], hg_norm_g[l], ml_b_ig[l], ml_b_fg[l],
                                  ml_norm_g[l], w_out[l], norm2_g[l], w_gate[l], w_val[l],
                                  conv_w[l], conv_b[l], w_down[l])
        Ss.append(s); Cs.append(c); ns.append(n); ms.append(m); bufs.append(b)
    y = _rmsnorm(x, final_norm_g)
    return y, jnp.stack(Ss), jnp.stack(Cs), jnp.stack(ns), jnp.stack(ms), jnp.stack(bufs)


def setup_inputs(seed: int = 0) -> dict:
    key = jax.random.key(seed)
    ks = jax.random.split(key, 24)
    nrm = jax.random.normal
    f32 = jnp.float32
    return {
        'x_prompt': nrm(ks[0], (BATCH, SEQ, D_MODEL), f32),
        'x_sample': nrm(ks[1], (DEC_BATCH, DEC_SEQ, D_MODEL), f32),
        'state_hgrn_S': 0.5 * nrm(ks[2], (DEPTH, DEC_BATCH, HG_HEADS, HG_DK, HG_DV), f32),
        'state_mlstm_C': 0.5 * nrm(ks[3], (DEPTH, DEC_BATCH, ML_HEADS, ML_DK, ML_DV), f32),
        'state_mlstm_n': 0.5 * nrm(ks[4], (DEPTH, DEC_BATCH, ML_HEADS, ML_DK), f32),
        'state_mlstm_m': nrm(ks[5], (DEPTH, DEC_BATCH, ML_HEADS), f32),
        'state_conv': nrm(ks[6], (DEPTH, DEC_BATCH, CONV_W - 1, D_FF), f32),
        'norm1_g': 1.0 + 0.02 * nrm(ks[7], (DEPTH, D_MODEL), f32),
        'w_in': nrm(ks[8], (DEPTH, D_MODEL, IN_COLS), f32) * D_MODEL ** -0.5,
        'hg_lb_logits': 0.1 * nrm(ks[9], (DEPTH + 1, HG_KW), f32),
        'hg_norm_g': 1.0 + 0.02 * nrm(ks[10], (DEPTH, HG_W), f32),
        'ml_b_ig': 0.1 * nrm(ks[11], (DEPTH, ML_HEADS), f32),
        'ml_b_fg': 3.0 + 0.1 * nrm(ks[12], (DEPTH, ML_HEADS), f32),
        'ml_norm_g': 1.0 + 0.02 * nrm(ks[13], (DEPTH, ML_W), f32),
        'w_out': nrm(ks[14], (DEPTH, D_MIX, D_MODEL), f32) * D_MIX ** -0.5,
        'norm2_g': 1.0 + 0.02 * nrm(ks[15], (DEPTH, D_MODEL), f32),
        'w_gate': nrm(ks[16], (DEPTH, D_MODEL, D_FF), f32) * D_MODEL ** -0.5,
        'w_val': nrm(ks[17], (DEPTH, D_MODEL, D_FF), f32) * D_MODEL ** -0.5,
        'conv_w': nrm(ks[18], (DEPTH, CONV_W, D_FF), f32) * CONV_W ** -0.5,
        'conv_b': 0.02 * nrm(ks[19], (DEPTH, D_FF), f32),
        'w_down': nrm(ks[20], (DEPTH, D_FF, D_MODEL), f32) * D_FF ** -0.5,
        'final_norm_g': 1.0 + 0.02 * nrm(ks[21], (D_MODEL,), f32),
    }


def reference(x_prompt, x_sample, state_hgrn_S, state_mlstm_C, state_mlstm_n, state_mlstm_m,
              state_conv, norm1_g, w_in, hg_lb_logits, hg_norm_g, ml_b_ig, ml_b_fg, ml_norm_g,
              w_out, norm2_g, w_gate, w_val, conv_w, conv_b, w_down, final_norm_g):
    B = x_prompt.shape[0]
    dt = x_prompt.dtype
    S0 = jnp.zeros((DEPTH, B, HG_HEADS, HG_DK, HG_DV), dt)
    C0 = jnp.zeros((DEPTH, B, ML_HEADS, ML_DK, ML_DV), dt)
    n0 = jnp.zeros((DEPTH, B, ML_HEADS, ML_DK), dt)
    m0 = jnp.zeros((DEPTH, B, ML_HEADS), dt)
    buf0 = jnp.zeros((DEPTH, B, CONV_W - 1, D_FF), dt)
    y_prompt, S_p, C_p, n_p, m_p, buf_p = _trunk(
        x_prompt, S0, C0, n0, m0, buf0, norm1_g, w_in, hg_lb_logits, hg_norm_g, ml_b_ig, ml_b_fg,
        ml_norm_g, w_out, norm2_g, w_gate, w_val, conv_w, conv_b, w_down, final_norm_g)
    y_sample, S_s, C_s, n_s, m_s, buf_s = _trunk(
        x_sample, state_hgrn_S, state_mlstm_C, state_mlstm_n, state_mlstm_m, state_conv,
        norm1_g, w_in, hg_lb_logits, hg_norm_g, ml_b_ig, ml_b_fg, ml_norm_g, w_out, norm2_g,
        w_gate, w_val, conv_w, conv_b, w_down, final_norm_g)
    return (y_prompt, y_sample, S_p, S_s, C_p, C_s, n_p, n_s, m_p, m_s, buf_p, buf_s)
```

```cpp
#include <hip/hip_runtime.h>
#include <hip/hip_cooperative_groups.h>
#include <cstdio>
#include <cstdint>
namespace cg = cooperative_groups;
#ifndef ONE_LAUNCH
#define ONE_LAUNCH 1
#endif
#ifndef PHMASK
#define PHMASK 255
#endif
#ifndef NAIVE_MIXER
#define NAIVE_MIXER 0
#endif
#ifndef REPMASK
#define REPMASK 0
#endif
namespace pg8 {
#define PG8_LAS __attribute__((address_space(3)))
typedef unsigned short bf16_t;
typedef short bf16x8 __attribute__((ext_vector_type(8)));
typedef float f32x4 __attribute__((ext_vector_type(4)));
typedef unsigned u32x4 __attribute__((ext_vector_type(4)));
constexpr int BM = 256, BK = 64, HALF = 128, HTB = HALF * BK * 2  , STAGE_BYTES = 8 * HTB, NXCD = 8, WGM = 8;

__host__ __device__ __forceinline__ int lds_byte(int r, int c) { const int st = (r >> 4) * 2 + (c >> 5), rr = r & 15, cc = c & 31, ob = rr * 64 + cc * 2; return st * 1024 + (ob ^ (((ob >> 9) & 1) << 5)); }
__host__ __device__ __forceinline__ void stage_rc(int b, int& R, int& C) { const int st = b / 1024, sb = b % 1024, swz = sb ^ (((sb >> 9) & 1) << 5); R = (st >> 1) * 16 + swz / 64; C = (st & 1) * 32 + (swz % 64) / 2; }
__host__ __device__ __forceinline__ int perm32(int rho) { const int n = rho >> 4, i = rho & 15; return 8 * (i >> 2) + 4 * n + (i & 3); }

struct Unit { int pm, pn; };
struct Gemm { const bf16_t* A; const bf16_t* Bt; int M, N, K; };

struct StaticOrder {
    int nM, nN, nwg, G, c;
    __host__ __device__ void init(int M, int N, int G_, int c_) { nM = M / BM; nN = N / BM; nwg = nM * nN; G = G_; c = c_; }
    __host__ __device__ bool next(int i, Unit& u) const {
        const long L = (long)i * G + c; if (L >= nwg) return false;
        int wgid = (int)L; { const int q = nwg / NXCD, r = nwg % NXCD, xcd = wgid % NXCD, off = wgid / NXCD; wgid = (xcd < r ? xcd * (q + 1) : r * (q + 1) + (xcd - r) * q) + off; }
        const int nig = WGM * nN, gid = wgid / nig, fm = gid * WGM, gsz = (nM - fm) < WGM ? (nM - fm) : WGM;
        u.pm = fm + ((wgid % nig) % gsz); u.pn = (wgid % nig) / gsz; return true;
    }
    __device__ __forceinline__ void a_ready(const Unit&) const {}
    __device__ __forceinline__ void done(const Unit&) const {}
};

typedef float f32x2_t __attribute__((ext_vector_type(2)));
typedef __bf16 bf16x2_t __attribute__((ext_vector_type(2)));
__device__ __forceinline__ unsigned cvt_pk_bf16(float lo, float hi) { const f32x2_t v = {lo, hi}; return __builtin_bit_cast(unsigned, __builtin_convertvector(v, bf16x2_t)); }
template <class Epi, class Sched>
__device__ __forceinline__ void gemm_phase(PG8_LAS unsigned char* lds, const Gemm g, const Sched& S, const Epi& E) {
    const int tid = threadIdx.x, wid = __builtin_amdgcn_readfirstlane(tid >> 6), lane = tid & 63, wr = wid >> 2, wc = wid & 3, fr = lane & 15, fq = lane >> 4;
    const int K = g.K, nt = K / BK;
    unsigned voffA[2], voffB[2];
#pragma unroll
    for (int i = 0; i < 2; ++i) { int R, C; stage_rc(tid * 16 + i * 8192, R, C); const int Rb = Epi::PERM ? ((R & ~31) + perm32(R & 31)) : R;
        voffA[i] = (unsigned)(R * K + C) * 2u; voffB[i] = (unsigned)(Rb * K + C) * 2u; }
    const size_t kstep = (size_t)(BK * 2);
    const size_t hstep = (size_t)HALF * K * 2;
    const size_t tstep = 2 * hstep;
    const unsigned ldsw = (unsigned)wid * 1024u;
    const int aoff = lds_byte(wr * 64 + fr, fq * 8), boff = lds_byte(wc * 32 + fr, fq * 8);
#define PG8_SA(b, h) (((b) * 2 + (h)) * HTB)
#define PG8_SB(b, h) ((4 + (b) * 2 + (h)) * HTB)
#define PG8_STAGE(bufoff, gbase, voff) do { _Pragma("unroll") for (int _i = 0; _i < 2; ++_i) \
        __builtin_amdgcn_global_load_lds((const unsigned*)((const char*)(gbase) + (voff)[_i]), (PG8_LAS unsigned*)(lds + (bufoff) + ldsw + _i * 8192), 16, 0, 0); } while (0)
#define PG8_LDA(dst, b, h) do { _Pragma("unroll") for (int m = 0; m < 4; ++m) _Pragma("unroll") for (int k = 0; k < 2; ++k) dst[m][k] = *(const PG8_LAS bf16x8*)(lds + PG8_SA(b, h) + aoff + m * 2048 + k * 1024); } while (0)
#define PG8_LDB(dst, b, h) do { _Pragma("unroll") for (int n = 0; n < 2; ++n) _Pragma("unroll") for (int k = 0; k < 2; ++k) dst[n][k] = *(const PG8_LAS bf16x8*)(lds + PG8_SB(b, h) + boff + n * 2048 + k * 1024); } while (0)
#define PG8_MMA(ai, bj, At, Bt) do { __builtin_amdgcn_s_setprio(1); _Pragma("unroll") for (int m = 0; m < 4; ++m) _Pragma("unroll") for (int n = 0; n < 2; ++n) _Pragma("unroll") for (int k = 0; k < 2; ++k) \
        acc[ai][bj][m][n] = __builtin_amdgcn_mfma_f32_16x16x32_bf16(Bt[n][k], At[m][k], acc[ai][bj][m][n], 0, 0, 0); __builtin_amdgcn_s_setprio(0); } while (0)
#define PG8_WAIT_V(n) asm volatile("s_waitcnt vmcnt(" #n ")" ::: "memory")
#define PG8_WAIT_L(n) asm volatile("s_waitcnt lgkmcnt(" #n ")" ::: "memory")
#define PG8_BAR __builtin_amdgcn_s_barrier()
#define PG8_SCHED __builtin_amdgcn_sched_barrier(0)
    Unit cur, nxt; int ui = 0;
    if (!S.next(0, cur)) return;
    f32x4 acc[2][2][4][2];
#pragma unroll
    for (int a = 0; a < 2; ++a)
#pragma unroll
        for (int b = 0; b < 2; ++b)
#pragma unroll
            for (int m = 0; m < 4; ++m)
#pragma unroll
                for (int n = 0; n < 2; ++n) acc[a][b][m][n] = (f32x4){0.f, 0.f, 0.f, 0.f};
    bf16x8 At[4][2], B0[2][2], B1[2][2];
    const char* cA = (const char*)g.A + (size_t)cur.pm * tstep; const char* cB = (const char*)g.Bt + (size_t)cur.pn * tstep;
    S.a_ready(cur);
    PG8_STAGE(PG8_SB(0, 0), cB, voffB); PG8_STAGE(PG8_SA(0, 0), cA, voffA); PG8_STAGE(PG8_SB(0, 1), cB + hstep, voffB); PG8_STAGE(PG8_SA(0, 1), cA + hstep, voffA);
    if (wr == 1) PG8_BAR;
    PG8_WAIT_V(4); PG8_BAR;
    PG8_STAGE(PG8_SB(1, 0), cB + kstep, voffB); PG8_STAGE(PG8_SA(1, 0), cA + kstep, voffA); PG8_STAGE(PG8_SB(1, 1), cB + hstep + kstep, voffB);
    PG8_WAIT_V(6); PG8_BAR;
    for (;;) {
        const bool has_next = S.next(ui + 1, nxt);
        const char* nA = has_next ? (const char*)g.A + (size_t)nxt.pm * tstep : cA; const char* nB = has_next ? (const char*)g.Bt + (size_t)nxt.pn * tstep : cB;
        for (int t = 0; t < nt; t += 2) {
            const bool last = (t == nt - 2);
            const char* a1 = cA + (size_t)(t + 1) * kstep;
            const char* a2 = last ? nA : cA + (size_t)(t + 2) * kstep; const char* b2 = last ? nB : cB + (size_t)(t + 2) * kstep;
            const char* a3 = a2 + kstep; const char* b3 = b2 + kstep;
            if (last && has_next) S.a_ready(nxt);
            PG8_LDB(B0, 0, 0); PG8_SCHED; PG8_LDA(At, 0, 0); PG8_STAGE(PG8_SA(1, 1), a1 + hstep, voffA);
            PG8_WAIT_L(8); PG8_BAR; PG8_WAIT_L(0); PG8_MMA(0, 0, At, B0); PG8_BAR; PG8_SCHED;
            PG8_LDB(B1, 0, 1); PG8_STAGE(PG8_SB(0, 0), b2, voffB);
            PG8_BAR; PG8_WAIT_L(0); PG8_MMA(0, 1, At, B1); PG8_BAR;
            PG8_LDA(At, 0, 1); PG8_STAGE(PG8_SA(0, 0), a2, voffA);
            PG8_BAR; PG8_WAIT_L(0); PG8_MMA(1, 0, At, B0); PG8_BAR; PG8_SCHED;
            PG8_STAGE(PG8_SB(0, 1), b2 + hstep, voffB);
            PG8_WAIT_V(6); PG8_BAR; PG8_MMA(1, 1, At, B1); PG8_BAR;
            PG8_LDB(B0, 1, 0); PG8_SCHED; PG8_LDA(At, 1, 0); PG8_STAGE(PG8_SA(0, 1), a2 + hstep, voffA);
            PG8_WAIT_L(8); PG8_BAR; PG8_WAIT_L(0); PG8_MMA(0, 0, At, B0); PG8_BAR; PG8_SCHED;
            PG8_LDB(B1, 1, 1); PG8_STAGE(PG8_SB(1, 0), b3, voffB);
            PG8_BAR; PG8_WAIT_L(0); PG8_MMA(0, 1, At, B1); PG8_BAR;
            PG8_LDA(At, 1, 1); PG8_STAGE(PG8_SA(1, 0), a3, voffA);
            PG8_BAR; PG8_WAIT_L(0); PG8_MMA(1, 0, At, B0); PG8_BAR; PG8_SCHED;
            PG8_STAGE(PG8_SB(1, 1), b3 + hstep, voffB);
            PG8_WAIT_V(6); PG8_BAR; PG8_MMA(1, 1, At, B1); PG8_BAR;
        }
        if constexpr (!Epi::AFTER_DRAIN) { E(acc, cur, wr, wc, fr, fq); S.done(cur); }
        if (!has_next) break;
#pragma unroll
        for (int a = 0; a < 2; ++a)
#pragma unroll
            for (int b = 0; b < 2; ++b)
#pragma unroll
                for (int m = 0; m < 4; ++m)
#pragma unroll
                    for (int n = 0; n < 2; ++n) acc[a][b][m][n] = (f32x4){0.f, 0.f, 0.f, 0.f};
        cur = nxt; cA = nA; cB = nB; ++ui;
    }
    PG8_WAIT_V(0);
    if (wr == 0) PG8_BAR;
    PG8_BAR;
    if constexpr (Epi::AFTER_DRAIN) { E.fused(acc, cur, wr, wc, fr, fq, lds, wid, lane); S.done(cur); }
#undef PG8_SA
#undef PG8_SB
#undef PG8_STAGE
#undef PG8_LDA
#undef PG8_LDB
#undef PG8_MMA
#undef PG8_WAIT_V
#undef PG8_WAIT_L
#undef PG8_BAR
#undef PG8_SCHED
}

}
using pg8::bf16_t; using pg8::f32x4; using pg8::u32x4; using pg8::Unit; using pg8::cvt_pk_bf16;
typedef unsigned u32x2 __attribute__((ext_vector_type(2)));
constexpr int DM = 1024, MROWS = 17408, MPROMPT = 16384, NPROJ = 4096, INCOLS = 4104, DFF = 2816, NGV = 5632;
constexpr float EPS = 1e-6f;
constexpr size_t O_Y = 0, O_SP = 17825792, O_SS = 18350080, O_CP = 26738688, O_CS = 27262976, O_NP = 35651584, O_NS = 35655680,
                 O_MP = 35721216, O_MS = 35721248, O_VP = 35721760, O_VS = 35766816;
constexpr int NIN = 4352;
constexpr size_t WS_CTL = 0, WS_WIN = 4096, WS_WOUT = WS_WIN + (size_t)NIN * 1024 * 2, WS_WGV = WS_WOUT + 1024 * 1024 * 2, WS_WD = WS_WGV + 5632 * 1024 * 2,
                 WS_GATES = WS_WD + 1024 * 2816 * 2, WS_SSQ2 = WS_GATES + 17408 * 32, WS_SSQ3 = WS_SSQ2 + 17408 * 4, WS_UHL = WS_SSQ3 + 17408 * 4, WS_UHF = WS_UHL + 256 * 2 * 2816 * 4,
                 WS_X1 = WS_UHF + 256 * 4 * 2816 * 4, WS_R1 = WS_X1 + (size_t)17408 * 1024 * 4, WS_END = WS_R1 + (size_t)17408 * 4096 * 2;
static_assert(WS_END <= 268435456, "workspace budget");
constexpr size_t R1_X1B = 1048576, R1_ACT = 36700160 + 1048576;
constexpr int LDS_BYTES = 160 * 1024 - 2048;

struct Params { const float* in[22]; float* out; unsigned char* ws; };

__device__ __forceinline__ float bf2f(unsigned short b) { return __uint_as_float(((unsigned)b) << 16); }
__device__ __forceinline__ unsigned short f2bf(float f) { unsigned u = __float_as_uint(f); u += 0x7fffu + ((u >> 16) & 1u); return (unsigned short)(u >> 16); }
__device__ __forceinline__ float wave_sum(float v) {
#pragma unroll
    for (int o = 1; o < 64; o <<= 1) v += __shfl_xor(v, o);
    return v;
}
__device__ __forceinline__ float sigmoidf_(float x) { return __builtin_amdgcn_rcpf(1.0f + __expf(-x)); }

__device__ __forceinline__ void p0_transpose_item(const float* W, int ldw, int K, bf16_t* WT, int drow0, int k0, int n0, int nmax, const float* kscale, float* scr, int lane) {
    const int ncol = min(n0 + (lane & 31), nmax);
    float v[32];
#pragma unroll
    for (int i = 0; i < 32; ++i) v[i] = W[(size_t)(k0 + 2 * i + (lane >> 5)) * ldw + ncol];
    if (kscale) {
#pragma unroll
        for (int i = 0; i < 32; ++i) v[i] *= kscale[k0 + 2 * i + (lane >> 5)]; }
#pragma unroll
    for (int i = 0; i < 32; ++i) scr[(2 * i + (lane >> 5)) * 33 + (lane & 31)] = v[i];
    asm volatile("s_waitcnt lgkmcnt(0)" ::: "memory");
    const int c = lane & 7;
#pragma unroll
    for (int j = 0; j < 4; ++j) { const int n = (lane >> 3) + 8 * j; const float* s = scr + (8 * c) * 33 + n;
        u32x4 o; o.x = cvt_pk_bf16(s[0 * 33], s[1 * 33]); o.y = cvt_pk_bf16(s[2 * 33], s[3 * 33]); o.z = cvt_pk_bf16(s[4 * 33], s[5 * 33]); o.w = cvt_pk_bf16(s[6 * 33], s[7 * 33]);
        *(u32x4*)(WT + (size_t)(drow0 + n) * K + k0 + 8 * c) = o; }
    asm volatile("s_waitcnt lgkmcnt(0)" ::: "memory");
}

__device__ __forceinline__ void phase0(const Params& p, unsigned char* shm) {
    const int tid = threadIdx.x, wave = tid >> 6, lane = tid & 63;
    float* scr = (float*)(shm + wave * 8704);
    const int gw = blockIdx.x * 8 + wave, NGW = gridDim.x * 8;
    bf16_t* WinT = (bf16_t*)(p.ws + WS_WIN); bf16_t* WoutT = (bf16_t*)(p.ws + WS_WOUT); bf16_t* WgvT = (bf16_t*)(p.ws + WS_WGV); bf16_t* WdT = (bf16_t*)(p.ws + WS_WD);
    { float* z = (float*)(p.ws + WS_SSQ2); for (int i = blockIdx.x * 512 + tid; i < 2 * MROWS; i += gridDim.x * 512) z[i] = 0.f; }
    if (blockIdx.x == 0 && tid < 64) ((unsigned*)(p.ws + WS_CTL))[tid] = 0u;
    bf16_t* H = (bf16_t*)p.out;
    {   f32x4 g1[4];
#pragma unroll
        for (int j = 0; j < 4; ++j) g1[j] = *(const f32x4*)(p.in[7] + 4 * lane + 256 * j);
        int row = gw; f32x4 v[4];
        if (row < MROWS) { const float* xr = row < MPROMPT ? p.in[0] + (size_t)row * DM : p.in[1] + (size_t)(row - MPROMPT) * DM;
#pragma unroll
            for (int j = 0; j < 4; ++j) v[j] = *(const f32x4*)(xr + 4 * lane + 256 * j); }
        while (row < MROWS) {
            const int nrow = row + NGW; f32x4 nv[4];
#pragma unroll
            for (int j = 0; j < 4; ++j) nv[j] = (f32x4){0.f, 0.f, 0.f, 0.f};
            if (nrow < MROWS) { const float* xr = nrow < MPROMPT ? p.in[0] + (size_t)nrow * DM : p.in[1] + (size_t)(nrow - MPROMPT) * DM;
#pragma unroll
                for (int j = 0; j < 4; ++j) nv[j] = *(const f32x4*)(xr + 4 * lane + 256 * j); }
            float s = 0.f;
#pragma unroll
            for (int j = 0; j < 4; ++j) s += (v[j].x * v[j].x + v[j].y * v[j].y) + (v[j].z * v[j].z + v[j].w * v[j].w);
            const float rs = rsqrtf(wave_sum(s) * (1.f / DM) + EPS);
#pragma unroll
            for (int j = 0; j < 4; ++j) { const f32x4 o = v[j] * rs * g1[j];
                *(u32x2*)(H + (size_t)row * DM + 4 * lane + 256 * j) = (u32x2){cvt_pk_bf16(o.x, o.y), cvt_pk_bf16(o.z, o.w)}; }
#pragma unroll
            for (int j = 0; j < 4; ++j) v[j] = nv[j];
            row = nrow;
        }
    }
    constexpr int I_IN = 16 * 129, I_OUT = 16 * 32, I_G = 16 * 88, I_D = 44 * 32, NIT = I_IN + I_OUT + 2 * I_G + I_D;
    for (int it = gw; it < NIT; it += NGW) {
        int r = it;
        if (r < I_IN) { const int kb = r / 129, nb = r % 129; p0_transpose_item(p.in[8], INCOLS, DM, WinT, 32 * nb, 64 * kb, 32 * nb, INCOLS - 1, nullptr, scr, lane); continue; } r -= I_IN;
        if (r < I_OUT) { const int kb = r / 32, nb = r % 32; p0_transpose_item(p.in[14], DM, DM, WoutT, 32 * nb, 64 * kb, 32 * nb, DM - 1, nullptr, scr, lane); continue; } r -= I_OUT;
        if (r < I_G) { const int kb = r / 88, nb = r % 88, n0 = 32 * nb; p0_transpose_item(p.in[16], DFF, DM, WgvT, 256 * (n0 >> 7) + (n0 & 127), 64 * kb, n0, DFF - 1, p.in[15], scr, lane); continue; } r -= I_G;
        if (r < I_G) { const int kb = r / 88, nb = r % 88, n0 = 32 * nb; p0_transpose_item(p.in[17], DFF, DM, WgvT, 256 * (n0 >> 7) + 128 + (n0 & 127), 64 * kb, n0, DFF - 1, p.in[15], scr, lane); continue; } r -= I_G;
        { const int kb = r / 32, nb = r % 32; p0_transpose_item(p.in[20], DM, DFF, WdT, 32 * nb, 64 * kb, 32 * nb, DM - 1, nullptr, scr, lane); }
    }
}
struct EpiInProj {
    static constexpr bool PERM = true, AFTER_DRAIN = false;
    bf16_t* O; const float* lbl; float* gates; const float* b_ig; const float* b_fg;
    __device__ __forceinline__ void operator()(const f32x4 (&acc)[2][2][4][2], const Unit& u, int wr, int wc, int fr, int fq) const {
        const int seg = u.pn >> 1, row0 = u.pm * 256 + wr * 64 + fr, col0 = u.pn * 256 + wc * 32 + 8 * fq;
        if (seg == 8) {
            if (wc == 0 && fq == 0) {
                float bi[4], bf_[4];
#pragma unroll
                for (int e = 0; e < 4; ++e) { bi[e] = b_ig[e]; bf_[e] = b_fg[e]; }
#pragma unroll
                for (int ai = 0; ai < 2; ++ai)
#pragma unroll
                    for (int m = 0; m < 4; ++m) { float* gp = gates + (size_t)(row0 + ai * 128 + m * 16) * 8; f32x4 a = acc[ai][0][m][0], b = acc[ai][0][m][1];
#pragma unroll
                        for (int e = 0; e < 4; ++e) { a[e] += bi[e]; const float z = b[e] + bf_[e]; b[e] = z > 0.f ? -log1pf(__expf(-z)) : z - log1pf(__expf(z)); }
                        *(f32x4*)gp = a; *(f32x4*)(gp + 4) = b; }
            }
            return;
        }
        float lb[2][8];
        if (seg == 1) {
#pragma unroll
            for (int bj = 0; bj < 2; ++bj)
#pragma unroll
                for (int e = 0; e < 8; ++e) { const int c = col0 + bj * 128 + e - 512; lb[bj][e] = __builtin_amdgcn_rcpf(1.0f + __expf(lbl[512 + c] - lbl[c])); }
        }
#pragma unroll
        for (int ai = 0; ai < 2; ++ai)
#pragma unroll
            for (int m = 0; m < 4; ++m) { bf16_t* rowp = O + (size_t)(row0 + ai * 128 + m * 16) * NPROJ + col0;
#pragma unroll
                for (int bj = 0; bj < 2; ++bj) { float v[8];
#pragma unroll
                    for (int e = 0; e < 8; ++e) v[e] = acc[ai][bj][m][e >> 2][e & 3];
                    if (seg == 1) {
#pragma unroll
                        for (int e = 0; e < 8; ++e) v[e] = __logf(lb[bj][e] + (1.0f - lb[bj][e]) * sigmoidf_(v[e]));
                    } else if (seg == 3) {
#pragma unroll
                        for (int e = 0; e < 8; ++e) v[e] = v[e] * sigmoidf_(v[e]);
                    } else if (seg == 5) {
#pragma unroll
                        for (int e = 0; e < 8; ++e) v[e] = v[e] * 0.08838834764831845f;
                    } else if (seg == 7) {
#pragma unroll
                        for (int e = 0; e < 8; ++e) v[e] = sigmoidf_(v[e]);
                    }
                    u32x4 w; w.x = cvt_pk_bf16(v[0], v[1]); w.y = cvt_pk_bf16(v[2], v[3]); w.z = cvt_pk_bf16(v[4], v[5]); w.w = cvt_pk_bf16(v[6], v[7]);
                    *(u32x4*)(rowp + bj * 128) = w; } }
    }
};
struct EpiResid {
    static constexpr bool PERM = true, AFTER_DRAIN = false;
    const float* base_p; const float* base_s;
    float* out; bf16_t* outb; float* ssq;
    __device__ __forceinline__ void operator()(const f32x4 (&acc)[2][2][4][2], const Unit& u, int wr, int wc, int fr, int fq) const {
        const int row0 = u.pm * 256 + wr * 64 + fr, col0 = u.pn * 256 + wc * 32 + 8 * fq;
        const float* base = u.pm < 64 ? base_p : base_s - (size_t)MPROMPT * DM;
#pragma unroll
        for (int ai = 0; ai < 2; ++ai)
#pragma unroll
            for (int m = 0; m < 4; ++m) { const int row = row0 + ai * 128 + m * 16; const size_t off = (size_t)row * DM + col0; float ss = 0.f;
#pragma unroll
                for (int bj = 0; bj < 2; ++bj) { const f32x4 xa = *(const f32x4*)(base + off + bj * 128), xb = *(const f32x4*)(base + off + bj * 128 + 4);
                    const f32x4 v0 = acc[ai][bj][m][0] + xa, v1 = acc[ai][bj][m][1] + xb;
                    *(f32x4*)(out + off + bj * 128) = v0; *(f32x4*)(out + off + bj * 128 + 4) = v1;
                    if (outb) { u32x4 w; w.x = cvt_pk_bf16(v0[0], v0[1]); w.y = cvt_pk_bf16(v0[2], v0[3]); w.z = cvt_pk_bf16(v1[0], v1[1]); w.w = cvt_pk_bf16(v1[2], v1[3]); *(u32x4*)(outb + off + bj * 128) = w; }
                    ss += (v0[0] * v0[0] + v0[1] * v0[1]) + (v0[2] * v0[2] + v0[3] * v0[3]) + (v1[0] * v1[0] + v1[1] * v1[1]) + (v1[2] * v1[2] + v1[3] * v1[3]); }
                ss += __shfl_xor(ss, 16); ss += __shfl_xor(ss, 32);
                if (fq == 0) atomicAdd(ssq + row, ss); }
    }
};
__device__ __forceinline__ float gelu_tanh(float x) { const float z = 0.7978845608028654f * (x + 0.044715f * x * x * x); return x * __builtin_amdgcn_rcpf(1.0f + __expf(-2.0f * z)); }
__device__ __forceinline__ float rot16(float x, int lane, int n) { return __shfl(x, (lane & ~15) | ((lane - n) & 15)); }
struct EpiGateVal {
    static constexpr bool PERM = true, AFTER_DRAIN = false;
    bf16_t* ACT; const float* ssq2; const float* conv_w; const float* conv_b; const float* state_conv; float* UHL; float* UHF; float* out_vp; float* out_vs;
    __device__ __forceinline__ void operator()(const f32x4 (&acc)[2][2][4][2], const Unit& u, int wr, int wc, int fr, int fq) const {
        const int lane = threadIdx.x & 63;
        const int c0 = u.pn * 128 + wc * 32 + 8 * fq;
        float w0[8], w1[8], w2[8], cb[8];
#pragma unroll
        for (int e = 0; e < 8; ++e) { w0[e] = conv_w[c0 + e]; w1[e] = conv_w[DFF + c0 + e]; w2[e] = conv_w[2 * DFF + c0 + e]; cb[e] = conv_b[c0 + e]; }
        const bool sample = u.pm >= 64;
#pragma unroll
        for (int ai = 0; ai < 2; ++ai) {
            float r1p[8], r2p[8];
#pragma unroll
            for (int e = 0; e < 8; ++e) { r1p[e] = 0.f; r2p[e] = 0.f; }
#pragma unroll
            for (int m = 0; m < 4; ++m) { const int row = u.pm * 256 + ai * 128 + wr * 64 + m * 16 + fr;
                const float rs = rsqrtf(ssq2[row] * (1.f / DM) + EPS);
                float uu[8], vv[8], r1[8], r2[8];
#pragma unroll
                for (int e = 0; e < 8; ++e) { uu[e] = acc[ai][0][m][e >> 2][e & 3] * rs; vv[e] = acc[ai][1][m][e >> 2][e & 3] * rs; }
#pragma unroll
                for (int e = 0; e < 8; ++e) { r1[e] = rot16(uu[e], lane, 1); r2[e] = rot16(uu[e], lane, 2); }
                float p1[8], p2[8]; bool valid = true;
                if (!sample) {
#pragma unroll
                    for (int e = 0; e < 8; ++e) { p1[e] = fr >= 1 ? r1[e] : r1p[e]; p2[e] = fr >= 2 ? r2[e] : r2p[e]; }
                    if (m == 0 && fr < 2) { valid = false; const int gi = row >> 6; float* d = UHF + ((size_t)(gi * 2 + fr) * 2) * DFF + c0;
                        *(f32x4*)d = (f32x4){uu[0], uu[1], uu[2], uu[3]}; *(f32x4*)(d + 4) = (f32x4){uu[4], uu[5], uu[6], uu[7]};
                        *(f32x4*)(d + DFF) = (f32x4){vv[0], vv[1], vv[2], vv[3]}; *(f32x4*)(d + DFF + 4) = (f32x4){vv[4], vv[5], vv[6], vv[7]}; }
                    if (m == 3 && fr >= 14) { const int gi = row >> 6; float* d = UHL + (size_t)(gi * 2 + (fr - 14)) * DFF + c0;
                        *(f32x4*)d = (f32x4){uu[0], uu[1], uu[2], uu[3]}; *(f32x4*)(d + 4) = (f32x4){uu[4], uu[5], uu[6], uu[7]};
                        if ((row & 2047) >= 2046) { float* o = out_vp + (size_t)((row >> 11) * 2 + (fr - 14)) * DFF + c0;
                            *(f32x4*)o = (f32x4){uu[0], uu[1], uu[2], uu[3]}; *(f32x4*)(o + 4) = (f32x4){uu[4], uu[5], uu[6], uu[7]}; } }
                } else {
                    const int pos = fr & 7, b = (row - MPROMPT) >> 3; const float* sc = state_conv + (size_t)b * 2 * DFF + c0;
                    float b0[8], b1[8];
#pragma unroll
                    for (int e = 0; e < 8; ++e) { b0[e] = 0.f; b1[e] = 0.f; }
                    if (pos < 2) {
#pragma unroll
                        for (int e = 0; e < 8; ++e) { b0[e] = sc[e]; b1[e] = sc[DFF + e]; } }
#pragma unroll
                    for (int e = 0; e < 8; ++e) { p1[e] = pos >= 1 ? r1[e] : b1[e]; p2[e] = pos >= 2 ? r2[e] : (pos == 1 ? b1[e] : b0[e]); }
                    if (pos >= 6) { float* o = out_vs + (size_t)(b * 2 + (pos - 6)) * DFF + c0;
                        *(f32x4*)o = (f32x4){uu[0], uu[1], uu[2], uu[3]}; *(f32x4*)(o + 4) = (f32x4){uu[4], uu[5], uu[6], uu[7]}; }
                }
                if (valid) { float a[8];
#pragma unroll
                    for (int e = 0; e < 8; ++e) a[e] = gelu_tanh(cb[e] + w0[e] * p2[e] + w1[e] * p1[e] + w2[e] * uu[e]) * vv[e];
                    u32x4 w; w.x = cvt_pk_bf16(a[0], a[1]); w.y = cvt_pk_bf16(a[2], a[3]); w.z = cvt_pk_bf16(a[4], a[5]); w.w = cvt_pk_bf16(a[6], a[7]);
                    *(u32x4*)(ACT + (size_t)row * DFF + c0) = w; }
#pragma unroll
                for (int e = 0; e < 8; ++e) { r1p[e] = r1[e]; r2p[e] = r2[e]; }
            }
        }
    }
};
#define LAS __attribute__((address_space(3)))
#define LDS_BARRIER() do { asm volatile("s_waitcnt lgkmcnt(0)" ::: "memory"); __builtin_amdgcn_s_barrier(); asm volatile("" ::: "memory"); } while (0)
typedef short bf16x8 __attribute__((ext_vector_type(8)));
constexpr int QT_OFF = 0, KT_OFF = 17408, KHT_OFF = 34816, VT_OFF = 53248, SW_OFF = 73984, ST_OFF = 83200, RAWV_OFF = 122368, SM_OFF = 138752;
constexpr int F_DLAST = 0, F_PTOT = 128, F_SG = 640, F_SM = 704, F_SWI = 768, F_SMT = 832, F_SWEND = 896, F_SDEN = 960, F_SSSQ = 1024, F_SCAL = 1152;
__device__ __forceinline__ bf16x8 ldfrag(const LAS unsigned char* base, int stride_b, int row, int kcol) { return *(const LAS bf16x8*)(base + row * stride_b + kcol * 2); }
__device__ __forceinline__ f32x4 mfma16(bf16x8 a, bf16x8 b, f32x4 c) { return __builtin_amdgcn_mfma_f32_16x16x32_bf16(a, b, c, 0, 0, 0); }
__device__ __forceinline__ u32x2 pack4(f32x4 v) { return (u32x2){cvt_pk_bf16(v[0], v[1]), cvt_pk_bf16(v[2], v[3])}; }

template <bool IS_ML>
__device__ __forceinline__ void mixer_item(const Params& p, LAS unsigned char* L, const int sqi, const int h, const bool prompt) {
    const int tid = threadIdx.x, w = __builtin_amdgcn_readfirstlane(tid >> 6), lane = tid & 63, l15 = lane & 15, q4 = lane >> 4;
    const int Lc = prompt ? 64 : 8, nch = prompt ? 32 : 1;
    const int row0 = prompt ? sqi * 2048 : MPROMPT + sqi * 8;
    const bf16_t* PROJ = (const bf16_t*)(p.ws + WS_R1) + (IS_ML ? 2048 : 0) + h * 128;
    bf16_t* AMIX = (bf16_t*)p.out + (size_t)MROWS * DM + (IS_ML ? 512 : 0) + h * 128;
    const float* GATES = (const float*)(p.ws + WS_GATES);
    LAS unsigned char* Qt = L + QT_OFF; LAS unsigned char* Kt = L + KT_OFF; LAS unsigned char* KhT = L + KHT_OFF; LAS unsigned char* VT = L + VT_OFF;
    LAS unsigned char* Sw = L + SW_OFF; LAS unsigned char* ST = L + ST_OFF; LAS unsigned char* rawV = L + RAWV_OFF; LAS float* sm = (LAS float*)(L + SM_OFF);
    constexpr int NV = IS_ML ? 9 : 8;
    const int tt = w & 3, vb = w >> 2;
    const size_t sbase = (size_t)(sqi * 4 + h) * 128 * 128;
    f32x4 sacc[NV];
    float m_prev = 0.f;
#pragma unroll
    for (int vt = 0; vt < NV; ++vt) sacc[vt] = (f32x4){0.f, 0.f, 0.f, 0.f};
    if (!prompt) {
        const float* S0 = IS_ML ? p.in[3] : p.in[2];
#pragma unroll
        for (int vt = 0; vt < 8; ++vt)
#pragma unroll
            for (int j = 0; j < 4; ++j) sacc[vt][j] = S0[sbase + (size_t)(w * 16 + q4 * 4 + j) * 128 + vt * 16 + l15];
        if (IS_ML) { m_prev = p.in[5][sqi * 4 + h];
            if (l15 == 0) {
#pragma unroll
                for (int j = 0; j < 4; ++j) sacc[NV - 1][j] = p.in[4][(size_t)(sqi * 4 + h) * 128 + w * 16 + q4 * 4 + j]; } }
    }
    float gnr[4][4];
    { const float* gn = (IS_ML ? p.in[13] : p.in[10]) + h * 128;
#pragma unroll
        for (int i = 0; i < 4; ++i)
#pragma unroll
            for (int j = 0; j < 4; ++j) gnr[i][j] = gn[(vb * 4 + i) * 16 + q4 * 4 + j]; }
    u32x4 rq[2], rk[2], rv[2];
    auto load_raw = [&](int c) {
#pragma unroll
        for (int i = 0; i < 2; ++i) { const int pc = tid + 512 * i, r = pc >> 4, c8 = pc & 15;
            if (r < Lc) { const bf16_t* src = PROJ + (size_t)(row0 + c * 64 + r) * NPROJ + c8 * 8;
                rq[i] = *(const u32x4*)src; rk[i] = *(const u32x4*)(src + 512); rv[i] = *(const u32x4*)(src + 1024); }
            else { rq[i] = (u32x4){0u, 0u, 0u, 0u}; rk[i] = rq[i]; rv[i] = rq[i]; } }
    };
    load_raw(0);
    LDS_BARRIER();
#pragma unroll
    for (int vt = 0; vt < NV; ++vt) *(LAS u32x2*)(ST + (vt * 16 + l15) * 272 + (w * 16 + q4 * 4) * 2) = pack4(sacc[vt]);
    if (IS_ML) { for (int i = tid; i < 16 * 72; i += 512) *(LAS unsigned short*)(VT + (128 * 72 + i) * 2) = (i < 72) ? (unsigned short)0x3F80 : (unsigned short)0; }
    for (int c = 0; c < nch; ++c) {
#pragma unroll
        for (int i = 0; i < 2; ++i) { const int pc = tid + 512 * i, r = pc >> 4, c8 = pc & 15;
            *(LAS u32x4*)(Qt + r * 272 + c8 * 16) = rq[i]; *(LAS u32x4*)(Kt + r * 272 + c8 * 16) = rk[i]; *(LAS u32x4*)(rawV + r * 256 + c8 * 16) = rv[i]; }
        if (IS_ML && w == 0) {
            const int t = lane; float lf = 0.f, ig = -INFINITY;
            if (t < Lc) { const float* gp = GATES + (size_t)(row0 + c * 64 + t) * 8; ig = gp[h]; lf = gp[4 + h]; }
            float a = lf;
#pragma unroll
            for (int o = 1; o < 64; o <<= 1) { const float x = __shfl_up(a, o); if (lane >= o) a += x; }
            const float g = ig - a; float cm = g;
#pragma unroll
            for (int o = 1; o < 64; o <<= 1) { const float x = __shfl_up(cm, o); if (lane >= o) cm = fmaxf(cm, x); }
            const float M = fmaxf(m_prev, cm), M63 = __shfl(M, 63), a63 = __shfl(a, 63);
            sm[F_SG + t] = g; sm[F_SM + t] = M; sm[F_SWI + t] = __expf(m_prev - M); sm[F_SMT + t] = a + M; sm[F_SWEND + t] = __expf(g - M63);
            if (lane == 0) { sm[F_SCAL + 0] = __expf(m_prev - M63); sm[F_SCAL + 1] = a63 + M63; }
        }
        LDS_BARRIER();
        if (c + 1 < nch) load_raw(c + 1);
        { const int k = tid & 127, part = tid >> 7; unsigned short kh[16];
            if (!IS_ML) {
                float lfv[16], cs[16]; float run = 0.f;
#pragma unroll
                for (int i = 0; i < 16; ++i) { lfv[i] = bf2f(*(const LAS unsigned short*)(Kt + (part * 16 + i) * 272 + k * 2)); run += lfv[i]; cs[i] = run; }
                sm[F_PTOT + part * 128 + k] = run;
                LDS_BARRIER();
                float pre = 0.f, tot = 0.f;
#pragma unroll
                for (int pp = 0; pp < 4; ++pp) { const float x = sm[F_PTOT + pp * 128 + k]; tot += x; if (pp < part) pre += x; }
                if (part == 0) sm[F_DLAST + k] = __expf(tot);
#pragma unroll
                for (int i = 0; i < 16; ++i) { const int s = part * 16 + i; const float b = pre + cs[i], e = __expf(b), r = __builtin_amdgcn_rcpf(e), kk = 1.f - __expf(lfv[i]);
                    LAS unsigned short* qp = (LAS unsigned short*)(Qt + s * 272 + k * 2); *qp = f2bf(bf2f(*qp) * e);
                    *(LAS unsigned short*)(Kt + s * 272 + k * 2) = f2bf(kk * r); kh[i] = f2bf(kk * __expf(tot - b)); }
            } else {
#pragma unroll
                for (int i = 0; i < 16; ++i) { const int s = part * 16 + i; kh[i] = f2bf(bf2f(*(const LAS unsigned short*)(Kt + s * 272 + k * 2)) * sm[F_SWEND + s]); }
            }
            u32x4 w0, w1;
            w0.x = kh[0] | ((unsigned)kh[1] << 16); w0.y = kh[2] | ((unsigned)kh[3] << 16); w0.z = kh[4] | ((unsigned)kh[5] << 16); w0.w = kh[6] | ((unsigned)kh[7] << 16);
            w1.x = kh[8] | ((unsigned)kh[9] << 16); w1.y = kh[10] | ((unsigned)kh[11] << 16); w1.z = kh[12] | ((unsigned)kh[13] << 16); w1.w = kh[14] | ((unsigned)kh[15] << 16);
            *(LAS u32x4*)(KhT + k * 144 + part * 32) = w0; *(LAS u32x4*)(KhT + k * 144 + part * 32 + 16) = w1;
            unsigned short vv[16];
#pragma unroll
            for (int i = 0; i < 16; ++i) vv[i] = *(const LAS unsigned short*)(rawV + (part * 16 + i) * 256 + k * 2);
            w0.x = vv[0] | ((unsigned)vv[1] << 16); w0.y = vv[2] | ((unsigned)vv[3] << 16); w0.z = vv[4] | ((unsigned)vv[5] << 16); w0.w = vv[6] | ((unsigned)vv[7] << 16);
            w1.x = vv[8] | ((unsigned)vv[9] << 16); w1.y = vv[10] | ((unsigned)vv[11] << 16); w1.z = vv[12] | ((unsigned)vv[13] << 16); w1.w = vv[14] | ((unsigned)vv[15] << 16);
            *(LAS u32x4*)(VT + k * 144 + part * 32) = w0; *(LAS u32x4*)(VT + k * 144 + part * 32 + 16) = w1;
        }
        LDS_BARRIER();
        { const int pt = w >> 1;
#pragma unroll
            for (int e = 0; e < 2; ++e) { const int st = 2 * (w & 1) + e; f32x4 pa = (f32x4){0.f, 0.f, 0.f, 0.f};
                if (st <= pt) {
#pragma unroll
                    for (int ks = 0; ks < 4; ++ks) pa = mfma16(ldfrag(Kt, 272, st * 16 + l15, ks * 32 + q4 * 8), ldfrag(Qt, 272, pt * 16 + l15, ks * 32 + q4 * 8), pa); }
                const int t = pt * 16 + l15, s0 = st * 16 + q4 * 4; const float Mt = IS_ML ? sm[F_SM + t] : 0.f;
#pragma unroll
                for (int j = 0; j < 4; ++j) { const int s = s0 + j; float x = pa[j]; if (IS_ML) x *= __expf(sm[F_SG + s] - Mt); pa[j] = (s <= t) ? x : 0.f; }
                *(LAS u32x2*)(Sw + t * 144 + s0 * 2) = pack4(pa); } }
        f32x4 oacc[5];
        { bf16x8 bq[4];
#pragma unroll
            for (int ks = 0; ks < 4; ++ks) bq[ks] = ldfrag(Qt, 272, tt * 16 + l15, ks * 32 + q4 * 8);
            const float wi = IS_ML ? sm[F_SWI + tt * 16 + l15] : 1.f;
#pragma unroll
            for (int i = 0; i < 5; ++i) { oacc[i] = (f32x4){0.f, 0.f, 0.f, 0.f};
                if (i < 4 || (IS_ML && vb == 1)) { const int vt = i < 4 ? vb * 4 + i : 8;
#pragma unroll
                    for (int ks = 0; ks < 4; ++ks) oacc[i] = mfma16(ldfrag(ST, 272, vt * 16 + l15, ks * 32 + q4 * 8), bq[ks], oacc[i]);
                    if (IS_ML) oacc[i] = oacc[i] * wi; } } }
        LDS_BARRIER();
        { bf16x8 bs[2];
#pragma unroll
            for (int ks = 0; ks < 2; ++ks) bs[ks] = ldfrag(Sw, 144, tt * 16 + l15, ks * 32 + q4 * 8);
#pragma unroll
            for (int i = 0; i < 5; ++i) if (i < 4 || (IS_ML && vb == 1)) { const int vt = i < 4 ? vb * 4 + i : 8;
#pragma unroll
                for (int ks = 0; ks < 2; ++ks) oacc[i] = mfma16(ldfrag(VT, 144, vt * 16 + l15, ks * 32 + q4 * 8), bs[ks], oacc[i]); } }
        { bf16x8 ak[2];
#pragma unroll
            for (int ks = 0; ks < 2; ++ks) ak[ks] = ldfrag(KhT, 144, w * 16 + l15, ks * 32 + q4 * 8);
            f32x4 dl;
            if (IS_ML) { const float fe = sm[F_SCAL + 0]; dl = (f32x4){fe, fe, fe, fe}; m_prev = sm[F_SCAL + 1]; }
            else dl = *(const LAS f32x4*)(sm + F_DLAST + w * 16 + q4 * 4);
#pragma unroll
            for (int vt = 0; vt < NV; ++vt) { sacc[vt] = sacc[vt] * dl;
#pragma unroll
                for (int ks = 0; ks < 2; ++ks) sacc[vt] = mfma16(ak[ks], ldfrag(VT, 144, vt * 16 + l15, ks * 32 + q4 * 8), sacc[vt]);
                *(LAS u32x2*)(ST + (vt * 16 + l15) * 272 + (w * 16 + q4 * 4) * 2) = pack4(sacc[vt]); } }
        const int t = tt * 16 + l15;
        if (IS_ML) {
            if (vb == 1 && q4 == 0) sm[F_SDEN + t] = oacc[4][0];
            LDS_BARRIER();
            const float inv = 1.0f / fmaxf(fabsf(sm[F_SDEN + t]), __expf(-sm[F_SMT + t]));
#pragma unroll
            for (int i = 0; i < 4; ++i) oacc[i] = oacc[i] * inv;
        }
        float ss = 0.f;
#pragma unroll
        for (int i = 0; i < 4; ++i) ss += (oacc[i][0] * oacc[i][0] + oacc[i][1] * oacc[i][1]) + (oacc[i][2] * oacc[i][2] + oacc[i][3] * oacc[i][3]);
        ss += __shfl_xor(ss, 16); ss += __shfl_xor(ss, 32);
        if (q4 == 0) sm[F_SSSQ + t * 2 + vb] = ss;
        LDS_BARRIER();
        if (t < Lc) { const float rs = rsqrtf((sm[F_SSSQ + t * 2] + sm[F_SSSQ + t * 2 + 1]) * (1.f / 128.f) + EPS);
            const size_t row = (size_t)row0 + c * 64 + t;
#pragma unroll
            for (int i = 0; i < 4; ++i) { const int v0 = (vb * 4 + i) * 16 + q4 * 4; const u32x2 gt = *(const u32x2*)(PROJ + row * NPROJ + 1536 + v0);
                f32x4 o; o[0] = oacc[i][0] * rs * gnr[i][0] * __uint_as_float(gt.x << 16); o[1] = oacc[i][1] * rs * gnr[i][1] * __uint_as_float(gt.x & 0xffff0000u);
                o[2] = oacc[i][2] * rs * gnr[i][2] * __uint_as_float(gt.y << 16); o[3] = oacc[i][3] * rs * gnr[i][3] * __uint_as_float(gt.y & 0xffff0000u);
                *(u32x2*)(AMIX + row * DM + v0) = pack4(o); } }
    }
    { float* So = p.out + (IS_ML ? (prompt ? O_CP : O_CS) : (prompt ? O_SP : O_SS));
#pragma unroll
        for (int vt = 0; vt < 8; ++vt)
#pragma unroll
            for (int j = 0; j < 4; ++j) So[sbase + (size_t)(w * 16 + q4 * 4 + j) * 128 + vt * 16 + l15] = sacc[vt][j];
        if (IS_ML) { if (l15 == 0) { float* no = p.out + (prompt ? O_NP : O_NS) + (size_t)(sqi * 4 + h) * 128;
#pragma unroll
                for (int j = 0; j < 4; ++j) no[w * 16 + q4 * 4 + j] = sacc[NV - 1][j]; }
            if (tid == 0) p.out[(prompt ? O_MP : O_MS) + sqi * 4 + h] = m_prev; } }
}
__device__ __forceinline__ void mixer_dispatch(const Params& p, LAS unsigned char* L, int it) {
    int g, sqi, h; const bool prompt = it < 64;
    if (prompt) { g = it >> 5; sqi = (it >> 2) & 7; h = it & 3; } else { const int j = it - 64; g = j >> 9; sqi = (j >> 2) & 127; h = j & 3; }
    if (g == 0) mixer_item<false>(p, L, sqi, h, prompt); else mixer_item<true>(p, L, sqi, h, prompt);
}
__device__ __forceinline__ void phase2_chunked(const Params& p, LAS unsigned char* L) {
    const int G = gridDim.x, b = blockIdx.x;
    if (G > 64) { if (b < 64) mixer_dispatch(p, L, b); else for (int it = b; it < 1088; it += G - 64) mixer_dispatch(p, L, it); }
    else for (int it = b; it < 1088; it += G) mixer_dispatch(p, L, it);
}
constexpr size_t WS_SB = WS_X1;
template <bool IS_ML>
__device__ __forceinline__ void prepass_item(const Params& p, LAS unsigned char* L, const int sqi, const int c, const int h, u32x4 (&rq)[2], u32x4 (&rk)[2], u32x4 (&rv)[2], float& gig, float& glf,
                                             const bf16_t* nsrc, const float* ngates) {
    const int tid = threadIdx.x, w = __builtin_amdgcn_readfirstlane(tid >> 6), lane = tid & 63, l15 = lane & 15, q4 = lane >> 4;
    const int row0 = sqi * 2048 + c * 64;
    bf16_t* PROJ = (bf16_t*)(p.ws + WS_R1) + (IS_ML ? 2048 : 0) + h * 128;
    bf16_t* AMIX = (bf16_t*)p.out + (size_t)MROWS * DM + (IS_ML ? 512 : 0) + h * 128;
    float* SB = (float*)(p.ws + WS_SB) + (size_t)((((IS_ML ? 8 : 0) + sqi) * 32 + c) * 4 + h) * 256;
    LAS unsigned char* Qt = L + QT_OFF; LAS unsigned char* Kt = L + KT_OFF; LAS unsigned char* KhT = L + KHT_OFF; LAS unsigned char* VT = L + VT_OFF;
    LAS unsigned char* Sw = L + SW_OFF; LAS unsigned char* rawV = L + RAWV_OFF; LAS float* sm = (LAS float*)(L + SM_OFF);
    const int tt = w & 3, vb = w >> 2;
    LDS_BARRIER();
    if (IS_ML) { for (int i = tid; i < 16 * 72; i += 512) *(LAS unsigned short*)(VT + (128 * 72 + i) * 2) = (i < 72) ? (unsigned short)0x3F80 : (unsigned short)0; }
#pragma unroll
    for (int i = 0; i < 2; ++i) { const int pc = tid + 512 * i, r = pc >> 4, c8 = pc & 15;
        *(LAS u32x4*)(Qt + r * 272 + c8 * 16) = rq[i]; *(LAS u32x4*)(Kt + r * 272 + c8 * 16) = rk[i]; *(LAS u32x4*)(rawV + r * 256 + c8 * 16) = rv[i]; }
    if (IS_ML && w == 0) {
        const int t = lane; const float ig = gig, lf = glf;
        float a = lf;
#pragma unroll
        for (int o = 1; o < 64; o <<= 1) { const float x = __shfl_up(a, o); if (lane >= o) a += x; }
        const float g = ig - a; float cm = g;
#pragma unroll
        for (int o = 1; o < 64; o <<= 1) { const float x = __shfl_up(cm, o); if (lane >= o) cm = fmaxf(cm, x); }
        const float M63 = __shfl(cm, 63);
        sm[F_SG + t] = g; sm[F_SM + t] = cm; sm[F_SWEND + t] = __expf(g - M63);
        SB[64 + t] = cm; SB[128 + t] = a;
    }
    if (nsrc) {
#pragma unroll
        for (int i = 0; i < 2; ++i) { const int pc = tid + 512 * i, r = pc >> 4, c8 = pc & 15; const bf16_t* src = nsrc + (size_t)r * NPROJ + c8 * 8;
            rq[i] = *(const u32x4*)src; rk[i] = *(const u32x4*)(src + 512); rv[i] = *(const u32x4*)(src + 1024); }
        if (ngates && w == 0) { gig = ngates[lane * 8]; glf = ngates[lane * 8 + 4]; } }
    LDS_BARRIER();
    { const int k = tid & 127, part = tid >> 7; unsigned short kh[16];
        if (!IS_ML) {
            float lfv[16], cs[16]; float run = 0.f;
#pragma unroll
            for (int i = 0; i < 16; ++i) { lfv[i] = bf2f(*(const LAS unsigned short*)(Kt + (part * 16 + i) * 272 + k * 2)); run += lfv[i]; cs[i] = run; }
            sm[F_PTOT + part * 128 + k] = run;
            LDS_BARRIER();
            float pre = 0.f, tot = 0.f;
#pragma unroll
            for (int pp = 0; pp < 4; ++pp) { const float x = sm[F_PTOT + pp * 128 + k]; tot += x; if (pp < part) pre += x; }
            if (part == 0) SB[k] = __expf(tot);
#pragma unroll
            for (int i = 0; i < 16; ++i) { const int s = part * 16 + i; const float b = pre + cs[i], e = __expf(b), r = __builtin_amdgcn_rcpf(e), kk = 1.f - __expf(lfv[i]);
                LAS unsigned short* qp = (LAS unsigned short*)(Qt + s * 272 + k * 2); *qp = f2bf(bf2f(*qp) * e);
                *(LAS unsigned short*)(Kt + s * 272 + k * 2) = f2bf(kk * r); kh[i] = f2bf(kk * __expf(tot - b)); }
        } else {
#pragma unroll
            for (int i = 0; i < 16; ++i) { const int s = part * 16 + i; kh[i] = f2bf(bf2f(*(const LAS unsigned short*)(Kt + s * 272 + k * 2)) * sm[F_SWEND + s]); }
        }
        u32x4 w0, w1;
        w0.x = kh[0] | ((unsigned)kh[1] << 16); w0.y = kh[2] | ((unsigned)kh[3] << 16); w0.z = kh[4] | ((unsigned)kh[5] << 16); w0.w = kh[6] | ((unsigned)kh[7] << 16);
        w1.x = kh[8] | ((unsigned)kh[9] << 16); w1.y = kh[10] | ((unsigned)kh[11] << 16); w1.z = kh[12] | ((unsigned)kh[13] << 16); w1.w = kh[14] | ((unsigned)kh[15] << 16);
        *(LAS u32x4*)(KhT + k * 144 + part * 32) = w0; *(LAS u32x4*)(KhT + k * 144 + part * 32 + 16) = w1;
        unsigned short vv[16];
#pragma unroll
        for (int i = 0; i < 16; ++i) vv[i] = *(const LAS unsigned short*)(rawV + (part * 16 + i) * 256 + k * 2);
        w0.x = vv[0] | ((unsigned)vv[1] << 16); w0.y = vv[2] | ((unsigned)vv[3] << 16); w0.z = vv[4] | ((unsigned)vv[5] << 16); w0.w = vv[6] | ((unsigned)vv[7] << 16);
        w1.x = vv[8] | ((unsigned)vv[9] << 16); w1.y = vv[10] | ((unsigned)vv[11] << 16); w1.z = vv[12] | ((unsigned)vv[13] << 16); w1.w = vv[14] | ((unsigned)vv[15] << 16);
        *(LAS u32x4*)(VT + k * 144 + part * 32) = w0; *(LAS u32x4*)(VT + k * 144 + part * 32 + 16) = w1;
    }
    LDS_BARRIER();
    { const int pt = w >> 1;
#pragma unroll
        for (int e = 0; e < 2; ++e) { const int st = 2 * (w & 1) + e; f32x4 pa = (f32x4){0.f, 0.f, 0.f, 0.f};
            if (st <= pt) {
#pragma unroll
                for (int ks = 0; ks < 4; ++ks) pa = mfma16(ldfrag(Kt, 272, st * 16 + l15, ks * 32 + q4 * 8), ldfrag(Qt, 272, pt * 16 + l15, ks * 32 + q4 * 8), pa); }
            const int t = pt * 16 + l15, s0 = st * 16 + q4 * 4; const float Mt = IS_ML ? sm[F_SM + t] : 0.f;
#pragma unroll
            for (int j = 0; j < 4; ++j) { const int s = s0 + j; float x = pa[j]; if (IS_ML) x *= __expf(sm[F_SG + s] - Mt); pa[j] = (s <= t) ? x : 0.f; }
            *(LAS u32x2*)(Sw + t * 144 + s0 * 2) = pack4(pa); } }
#pragma unroll
    for (int i = 0; i < 2; ++i) { const int pc = tid + 512 * i;
        if (!IS_ML) { const int r = pc >> 4, c8 = pc & 15; *(u32x4*)(PROJ + (size_t)(row0 + r) * NPROJ + c8 * 8) = *(const LAS u32x4*)(Qt + r * 272 + c8 * 16); }
        const int k = pc >> 3, s8 = pc & 7; bf16_t* dst = PROJ + (size_t)(row0 + (k >> 1)) * NPROJ + (k & 1) * 64 + s8 * 8;
        *(u32x4*)(dst + 512) = *(const LAS u32x4*)(KhT + k * 144 + s8 * 16); *(u32x4*)(dst + 1024) = *(const LAS u32x4*)(VT + k * 144 + s8 * 16); }
    LDS_BARRIER();
    { bf16x8 bs[2];
#pragma unroll
        for (int ks = 0; ks < 2; ++ks) bs[ks] = ldfrag(Sw, 144, tt * 16 + l15, ks * 32 + q4 * 8);
#pragma unroll
        for (int i = 0; i < 5; ++i) if (i < 4 || (IS_ML && vb == 1)) { const int vt = i < 4 ? vb * 4 + i : 8; f32x4 o = (f32x4){0.f, 0.f, 0.f, 0.f};
#pragma unroll
            for (int ks = 0; ks < 2; ++ks) o = mfma16(ldfrag(VT, 144, vt * 16 + l15, ks * 32 + q4 * 8), bs[ks], o);
            const int t = tt * 16 + l15;
            if (i < 4) *(u32x2*)(AMIX + (size_t)(row0 + t) * DM + vt * 16 + q4 * 4) = pack4(o);
            else if (q4 == 0) SB[t] = o[0]; } }
}
constexpr int C_QT = 0, C_KHT = 17408, C_VT = 35840, C_ST0 = 56576, C_ST1 = 95744, C_SM = 134912;
constexpr int CF_WI = 0, CF_RHO = 64, CF_DEN = 128, CF_EMT = 192, CF_SCAL = 256, CF_SSSQ = 272;
template <bool IS_ML>
__device__ __forceinline__ void chain_run(const Params& p, LAS unsigned char* L, const int sqi, const int h) {
    const int tid = threadIdx.x, w = __builtin_amdgcn_readfirstlane(tid >> 6), lane = tid & 63, l15 = lane & 15, q4 = lane >> 4;
    const int row0 = sqi * 2048;
    const bf16_t* PROJ = (const bf16_t*)(p.ws + WS_R1) + (IS_ML ? 2048 : 0) + h * 128;
    bf16_t* AMIX = (bf16_t*)p.out + (size_t)MROWS * DM + (IS_ML ? 512 : 0) + h * 128;
    const float* SB0 = (const float*)(p.ws + WS_SB) + (size_t)((((IS_ML ? 8 : 0) + sqi) * 32) * 4 + h) * 256;
    LAS unsigned char* Qt = L + C_QT; LAS unsigned char* KhT = L + C_KHT; LAS unsigned char* VT = L + C_VT; LAS float* sm = (LAS float*)(L + C_SM);
    constexpr int NV = IS_ML ? 9 : 8;
    const int tt = w & 3, vb = w >> 2, t = tt * 16 + l15;
    const size_t sbase = (size_t)(sqi * 4 + h) * 128 * 128;
    f32x4 sacc[NV];
#pragma unroll
    for (int vt = 0; vt < NV; ++vt) sacc[vt] = (f32x4){0.f, 0.f, 0.f, 0.f};
    float m_prev = 0.f;
    const float* gn = (IS_ML ? p.in[13] : p.in[10]) + h * 128;
    u32x4 rq[2], rk[2], rv[2]; u32x2 rin[4], rgt[4]; f32x4 dl = (f32x4){0.f, 0.f, 0.f, 0.f}; float s_den = 0.f, s_ml = 0.f, s_a = 0.f;
    auto prefetch_big = [&](int c) {
#pragma unroll
        for (int i = 0; i < 2; ++i) { const int pc = tid + 512 * i; const int r = pc >> 4, c8 = pc & 15;
            rq[i] = *(const u32x4*)(PROJ + (size_t)(row0 + c * 64 + r) * NPROJ + c8 * 8);
            const int k = pc >> 3, s8 = pc & 7; const bf16_t* src = PROJ + (size_t)(row0 + c * 64 + (k >> 1)) * NPROJ + (k & 1) * 64 + s8 * 8;
            rk[i] = *(const u32x4*)(src + 512); rv[i] = *(const u32x4*)(src + 1024); }
    };
    auto prefetch_io = [&](int c) {
        const size_t row = (size_t)row0 + c * 64 + t;
#pragma unroll
        for (int i = 0; i < 4; ++i) { const int v0 = (vb * 4 + i) * 16 + q4 * 4; rin[i] = *(const u32x2*)(AMIX + row * DM + v0); rgt[i] = *(const u32x2*)(PROJ + row * NPROJ + 1536 + v0); }
    };
    auto prefetch_sb = [&](int c, f32x4& dl_, float& d_, float& ml_, float& a_) {
        const float* sb = SB0 + (size_t)c * 1024;
        if (!IS_ML) dl_ = *(const f32x4*)(sb + w * 16 + q4 * 4);
        else if (w == 0) { d_ = sb[lane]; ml_ = sb[64 + lane]; a_ = sb[128 + lane]; }
    };
    prefetch_big(0); prefetch_io(0); prefetch_sb(0, dl, s_den, s_ml, s_a);
    LDS_BARRIER();
#pragma unroll
    for (int vt = 0; vt < NV; ++vt) *(LAS u32x2*)(L + C_ST0 + (vt * 16 + l15) * 272 + (w * 16 + q4 * 4) * 2) = (u32x2){0u, 0u};
    if (IS_ML) { for (int i = tid; i < 16 * 72; i += 512) *(LAS unsigned short*)(VT + (128 * 72 + i) * 2) = (i < 72) ? (unsigned short)0x3F80 : (unsigned short)0; }
    for (int c = 0; c < 32; ++c) {
        LAS unsigned char* STr = L + ((c & 1) ? C_ST1 : C_ST0); LAS unsigned char* STw = L + ((c & 1) ? C_ST0 : C_ST1);
#pragma unroll
        for (int i = 0; i < 2; ++i) { const int pc = tid + 512 * i; const int r = pc >> 4, c8 = pc & 15, k = pc >> 3, s8 = pc & 7;
            *(LAS u32x4*)(Qt + r * 272 + c8 * 16) = rq[i]; *(LAS u32x4*)(KhT + k * 144 + s8 * 16) = rk[i]; *(LAS u32x4*)(VT + k * 144 + s8 * 16) = rv[i]; }
        if (IS_ML && w == 0) {
            const float M = fmaxf(m_prev, s_ml), M63 = __shfl(M, 63), ml63 = __shfl(s_ml, 63), a63 = __shfl(s_a, 63);
            sm[CF_WI + lane] = __expf(m_prev - M); sm[CF_RHO + lane] = __expf(s_ml - M); sm[CF_DEN + lane] = s_den; sm[CF_EMT + lane] = __expf(-(s_a + M));
            if (lane == 0) { sm[CF_SCAL + 0] = __expf(m_prev - M63); sm[CF_SCAL + 1] = __expf(ml63 - M63); sm[CF_SCAL + 2] = a63 + M63; }
        }
        LDS_BARRIER();
        f32x4 ndl = dl; float n_den = 0.f, n_ml = 0.f, n_a = 0.f;
        if (c + 1 < 32) { prefetch_big(c + 1); prefetch_sb(c + 1, ndl, n_den, n_ml, n_a); }
        float wi_t = 1.f, rho_t = 1.f, denl_t = 0.f, emt_t = 0.f, fend = 1.f, sigma = 1.f;
        if (IS_ML) { wi_t = sm[CF_WI + t]; rho_t = sm[CF_RHO + t]; denl_t = sm[CF_DEN + t]; emt_t = sm[CF_EMT + t]; fend = sm[CF_SCAL + 0]; sigma = sm[CF_SCAL + 1]; m_prev = sm[CF_SCAL + 2]; }
        f32x4 oacc[5];
        { bf16x8 bq[4];
#pragma unroll
            for (int ks = 0; ks < 4; ++ks) bq[ks] = ldfrag(Qt, 272, tt * 16 + l15, ks * 32 + q4 * 8);
#pragma unroll
            for (int i = 0; i < 5; ++i) { oacc[i] = (f32x4){0.f, 0.f, 0.f, 0.f};
                if (i < 4 || IS_ML) { const int vt = i < 4 ? vb * 4 + i : 8;
#pragma unroll
                    for (int ks = 0; ks < 4; ++ks) oacc[i] = mfma16(ldfrag(STr, 272, vt * 16 + l15, ks * 32 + q4 * 8), bq[ks], oacc[i]); } } }
        { bf16x8 ak[2];
#pragma unroll
            for (int ks = 0; ks < 2; ++ks) ak[ks] = ldfrag(KhT, 144, w * 16 + l15, ks * 32 + q4 * 8);
#pragma unroll
            for (int vt = 0; vt < NV; ++vt) {
                if (!IS_ML) { sacc[vt] = sacc[vt] * dl;
#pragma unroll
                    for (int ks = 0; ks < 2; ++ks) sacc[vt] = mfma16(ak[ks], ldfrag(VT, 144, vt * 16 + l15, ks * 32 + q4 * 8), sacc[vt]); }
                else { f32x4 uacc = (f32x4){0.f, 0.f, 0.f, 0.f};
#pragma unroll
                    for (int ks = 0; ks < 2; ++ks) uacc = mfma16(ak[ks], ldfrag(VT, 144, vt * 16 + l15, ks * 32 + q4 * 8), uacc);
                    sacc[vt] = sacc[vt] * fend + uacc * sigma; }
                *(LAS u32x2*)(STw + (vt * 16 + l15) * 272 + (w * 16 + q4 * 4) * 2) = pack4(sacc[vt]); } }
        float inv = 1.f;
        if (IS_ML) { const float di = __shfl(oacc[4][0], l15); inv = 1.0f / fmaxf(fabsf(wi_t * di + rho_t * denl_t), emt_t); }
        float ss = 0.f;
#pragma unroll
        for (int i = 0; i < 4; ++i) { f32x4 in; in[0] = __uint_as_float(rin[i].x << 16); in[1] = __uint_as_float(rin[i].x & 0xffff0000u); in[2] = __uint_as_float(rin[i].y << 16); in[3] = __uint_as_float(rin[i].y & 0xffff0000u);
            if (IS_ML) oacc[i] = (oacc[i] * wi_t + in * rho_t) * inv; else oacc[i] = oacc[i] + in;
            ss += (oacc[i][0] * oacc[i][0] + oacc[i][1] * oacc[i][1]) + (oacc[i][2] * oacc[i][2] + oacc[i][3] * oacc[i][3]); }
        ss += __shfl_xor(ss, 16); ss += __shfl_xor(ss, 32);
        LAS float* sq = sm + CF_SSSQ + (c & 1) * 128;
        if (q4 == 0) sq[t * 2 + vb] = ss;
        LDS_BARRIER();
        { const float rs = rsqrtf((sq[t * 2] + sq[t * 2 + 1]) * (1.f / 128.f) + EPS); const size_t row = (size_t)row0 + c * 64 + t;
#pragma unroll
            for (int i = 0; i < 4; ++i) { const int v0 = (vb * 4 + i) * 16 + q4 * 4; const u32x2 gt = rgt[i];
                const f32x4 gv = *(const f32x4*)(gn + v0);
                f32x4 o; o[0] = oacc[i][0] * rs * gv[0] * __uint_as_float(gt.x << 16); o[1] = oacc[i][1] * rs * gv[1] * __uint_as_float(gt.x & 0xffff0000u);
                o[2] = oacc[i][2] * rs * gv[2] * __uint_as_float(gt.y << 16); o[3] = oacc[i][3] * rs * gv[3] * __uint_as_float(gt.y & 0xffff0000u);
                *(u32x2*)(AMIX + row * DM + v0) = pack4(o); } }
        if (c + 1 < 32) prefetch_io(c + 1);
        dl = ndl; s_den = n_den; s_ml = n_ml; s_a = n_a;
    }
    { float* So = p.out + (IS_ML ? O_CP : O_SP);
#pragma unroll
        for (int vt = 0; vt < 8; ++vt)
#pragma unroll
            for (int j = 0; j < 4; ++j) So[sbase + (size_t)(w * 16 + q4 * 4 + j) * 128 + vt * 16 + l15] = sacc[vt][j];
        if (IS_ML) { if (l15 == 0) { float* no = p.out + O_NP + (size_t)(sqi * 4 + h) * 128;
#pragma unroll
                for (int j = 0; j < 4; ++j) no[w * 16 + q4 * 4 + j] = sacc[NV - 1][j]; }
            if (tid == 0) p.out[O_MP + sqi * 4 + h] = m_prev; } }
}
#ifndef SAMPLE_TWICE
#define SAMPLE_TWICE 0
#endif
#ifndef SAMPLE_TWICE
#define SAMPLE_TWICE 0
#endif
#ifndef NS_A
#define NS_A 256
#endif
__device__ __forceinline__ void sample_dispatch(const Params& p, LAS unsigned char* L, int j) {
    const int g = j >> 9, sqi = (j >> 2) & 127, h = j & 3;
    if (g == 0) mixer_item<false>(p, L, sqi, h, false); else mixer_item<true>(p, L, sqi, h, false);
}
__device__ __forceinline__ void phase2a(const Params& p, LAS unsigned char* L) {
    const int tid = threadIdx.x, lane = tid & 63, w = tid >> 6;
    u32x4 rq[2], rk[2], rv[2]; float gig = 0.f, glf = 0.f;
    auto slot = [&](int it) -> const bf16_t* { const int g = it >> 10, sqi = (it >> 7) & 7, c = (it >> 2) & 31, h = it & 3; return (const bf16_t*)(p.ws + WS_R1) + (size_t)(sqi * 2048 + c * 64) * NPROJ + (g ? 2048 : 0) + h * 128; };
    auto gptr = [&](int it) -> const float* { const int g = it >> 10, sqi = (it >> 7) & 7, c = (it >> 2) & 31, h = it & 3; return g ? (const float*)(p.ws + WS_GATES) + (size_t)(sqi * 2048 + c * 64) * 8 + h : nullptr; };
    int it = blockIdx.x;
    if (it < 2048) { const bf16_t* s0 = slot(it);
#pragma unroll
        for (int i = 0; i < 2; ++i) { const int pc = tid + 512 * i, r = pc >> 4, c8 = pc & 15; const bf16_t* src = s0 + (size_t)r * NPROJ + c8 * 8;
            rq[i] = *(const u32x4*)src; rk[i] = *(const u32x4*)(src + 512); rv[i] = *(const u32x4*)(src + 1024); }
        const float* g0 = gptr(it); if (g0 && w == 0) { gig = g0[lane * 8]; glf = g0[lane * 8 + 4]; } }
    for (; it < 2048; it += gridDim.x) { const int g = it >> 10, sqi = (it >> 7) & 7, c = (it >> 2) & 31, h = it & 3; const int nx = it + gridDim.x;
        const bf16_t* ns = nx < 2048 ? slot(nx) : nullptr; const float* ng = nx < 2048 ? gptr(nx) : nullptr;
        if (g == 0) prepass_item<false>(p, L, sqi, c, h, rq, rk, rv, gig, glf, ns, ng); else prepass_item<true>(p, L, sqi, c, h, rq, rk, rv, gig, glf, ns, ng); }
}
__device__ __forceinline__ void phase2a_samples(const Params& p, LAS unsigned char* L) {
    for (int it = 2048 + blockIdx.x; it < 2048 + NS_A; it += gridDim.x) { sample_dispatch(p, L, it - 2048); if (SAMPLE_TWICE) sample_dispatch(p, L, it - 2048); }
}
__device__ __forceinline__ void phase2b(const Params& p, LAS unsigned char* L) {
    const int G = gridDim.x, b = blockIdx.x;
    if (G > 64) {
        if (b < 64) { const int g = b >> 5, sqi = (b >> 2) & 7, h = b & 3; if (g == 0) chain_run<false>(p, L, sqi, h); else chain_run<true>(p, L, sqi, h); }
        else for (int j = NS_A + (b - 64); j < 1024; j += G - 64) sample_dispatch(p, L, j);
    } else {
        for (int it = b; it < 64 + 1024 - NS_A; it += G) {
            if (it < 64) { const int g = it >> 5, sqi = (it >> 2) & 7, h = it & 3; if (g == 0) chain_run<false>(p, L, sqi, h); else chain_run<true>(p, L, sqi, h); }
            else sample_dispatch(p, L, NS_A + it - 64); }
    }
}
__device__ __forceinline__ void phase2_naive(const Params& p, unsigned char* shm) {
    float* sq = (float*)shm; float* sd = sq + 128; float* si = sd + 128; float* sv = si + 128; float* part = sv + 128; float* denp = part + 512; float* red = denp + 4;
    const int tid = threadIdx.x, v = tid & 127, kq = tid >> 7;
    const bf16_t* PROJ = (const bf16_t*)(p.ws + WS_R1); bf16_t* AMIX = (bf16_t*)p.out + (size_t)MROWS * DM; const float* GATES = (const float*)(p.ws + WS_GATES);
    for (int it = blockIdx.x; it < 1088; it += gridDim.x) {
        int g, sqi, h, T, row0; const bool prompt = it < 64;
        if (prompt) { g = it >> 5; sqi = (it >> 2) & 7; h = it & 3; T = 2048; row0 = sqi * 2048; }
        else { const int j = it - 64; g = j >> 9; sqi = (j >> 2) & 127; h = j & 3; T = 8; row0 = MPROMPT + sqi * 8; }
        float S[32], nst[32]; float mst = 0.f;
        const size_t sbase = ((size_t)(sqi * 4 + h) * 128) * 128;
#pragma unroll
        for (int i = 0; i < 32; ++i) { S[i] = 0.f; nst[i] = 0.f; }
        if (!prompt) { const float* S0 = g == 0 ? p.in[2] : p.in[3];
#pragma unroll
            for (int i = 0; i < 32; ++i) S[i] = S0[sbase + (size_t)(kq * 32 + i) * 128 + v];
            if (g == 1) { mst = p.in[5][sqi * 4 + h];
#pragma unroll
                for (int i = 0; i < 32; ++i) nst[i] = p.in[4][(size_t)(sqi * 4 + h) * 128 + kq * 32 + i]; } }
        const float* gn = (g == 0 ? p.in[10] : p.in[13]) + h * 128;
        for (int t = 0; t < T; ++t) {
            const size_t row = (size_t)row0 + t; const bf16_t* pr = PROJ + row * NPROJ + g * 2048 + h * 128;
            float m_new = 0.f;
            if (g == 0) {
                if (tid < 128) sq[tid] = bf2f(pr[tid]);
                else if (tid < 256) { const float f = __expf(bf2f(pr[512 + tid - 128])); sd[tid - 128] = f; si[tid - 128] = 1.f - f; }
                else if (tid < 384) sv[tid - 256] = bf2f(pr[1024 + tid - 256]);
            } else {
                const float ig = GATES[row * 8 + h], lf = GATES[row * 8 + 4 + h];
                m_new = fmaxf(lf + mst, ig); const float fd = __expf(lf + mst - m_new), ii = __expf(ig - m_new);
                if (tid < 128) sq[tid] = bf2f(pr[tid]);
                else if (tid < 256) { sd[tid - 128] = fd; si[tid - 128] = ii * bf2f(pr[512 + tid - 128]); }
                else if (tid < 384) sv[tid - 256] = bf2f(pr[1024 + tid - 256]);
            }
            __syncthreads();
            const float vv = sv[v]; float acc = 0.f, dacc = 0.f;
#pragma unroll
            for (int i = 0; i < 32; ++i) { const int k = kq * 32 + i; const float d = sd[k], ik = si[k], q = sq[k]; S[i] = d * S[i] + ik * vv; acc += q * S[i]; nst[i] = d * nst[i] + ik; dacc += q * nst[i]; }
            part[kq * 128 + v] = acc; if (v == 0) denp[kq] = dacc;
            __syncthreads();
            float o = 0.f;
            if (tid < 128) { o = (part[tid] + part[128 + tid]) + (part[256 + tid] + part[384 + tid]);
                if (g == 1) { const float den = (denp[0] + denp[1]) + (denp[2] + denp[3]); o = o / fmaxf(fabsf(den), __expf(-m_new)); }
                const float ss = wave_sum(o * o); if ((tid & 63) == 0) red[tid >> 6] = ss; }
            __syncthreads();
            if (tid < 128) { const float tot = red[0] + red[1]; const float gate = bf2f(pr[1536 + tid]);
                AMIX[row * DM + g * 512 + h * 128 + tid] = f2bf(o * rsqrtf(tot * (1.f / 128.f) + EPS) * gn[tid] * gate); }
            mst = m_new;
            __syncthreads();
        }
        float* So = p.out + (g == 0 ? (prompt ? O_SP : O_SS) : (prompt ? O_CP : O_CS));
#pragma unroll
        for (int i = 0; i < 32; ++i) So[sbase + (size_t)(kq * 32 + i) * 128 + v] = S[i];
        if (g == 1 && v == 0) { float* no = p.out + (prompt ? O_NP : O_NS) + (size_t)(sqi * 4 + h) * 128;
#pragma unroll
            for (int i = 0; i < 32; ++i) no[kq * 32 + i] = nst[i];
            if (kq == 0) p.out[(prompt ? O_MP : O_MS) + sqi * 4 + h] = mst; }
    }
}
__device__ __forceinline__ void phase5(const Params& p) {
    const float* UHL = (const float*)(p.ws + WS_UHL); const float* UHF = (const float*)(p.ws + WS_UHF); bf16_t* ACT = (bf16_t*)(p.ws + WS_R1 + R1_ACT);
    const float* cw = p.in[18]; const float* cbp = p.in[19];
    constexpr int NQ = DFF / 4;
    for (int i = blockIdx.x * 512 + threadIdx.x; i < 256 * 2 * NQ; i += gridDim.x * 512) {
        const int cq = i % NQ, j = (i / NQ) & 1, gi = i / (2 * NQ), c = 4 * cq; const int row = gi * 64 + j;
        const bool first = (gi & 31) == 0;
        const f32x4 z = (f32x4){0.f, 0.f, 0.f, 0.f};
        const f32x4 l0 = first ? z : *(const f32x4*)(UHL + (size_t)((gi - 1) * 2 + 0) * DFF + c), l1 = first ? z : *(const f32x4*)(UHL + (size_t)((gi - 1) * 2 + 1) * DFF + c);
        const f32x4 u0 = *(const f32x4*)(UHF + (size_t)((gi * 2 + 0) * 2) * DFF + c);
        const f32x4 uu = *(const f32x4*)(UHF + (size_t)((gi * 2 + j) * 2) * DFF + c), vv = *(const f32x4*)(UHF + (size_t)((gi * 2 + j) * 2 + 1) * DFF + c);
        const f32x4 p2 = j == 0 ? l0 : l1, p1 = j == 0 ? l1 : u0;
        const f32x4 w0 = *(const f32x4*)(cw + c), w1 = *(const f32x4*)(cw + DFF + c), w2 = *(const f32x4*)(cw + 2 * DFF + c), cb = *(const f32x4*)(cbp + c);
        float a[4];
#pragma unroll
        for (int e = 0; e < 4; ++e) a[e] = gelu_tanh(cb[e] + w0[e] * p2[e] + w1[e] * p1[e] + w2[e] * uu[e]) * vv[e];
        *(u32x2*)(ACT + (size_t)row * DFF + c) = (u32x2){cvt_pk_bf16(a[0], a[1]), cvt_pk_bf16(a[2], a[3])};
    }
}
__device__ __forceinline__ void phase7(const Params& p) {
    const float* ssq3 = (const float*)(p.ws + WS_SSQ3); const float* gf = p.in[21]; float* Y = p.out;
    const int wave = threadIdx.x >> 6, lane = threadIdx.x & 63;
    f32x4 g[4];
#pragma unroll
    for (int j = 0; j < 4; ++j) g[j] = *(const f32x4*)(gf + 4 * lane + 256 * j);
    for (int row = blockIdx.x * 8 + wave; row < MROWS; row += gridDim.x * 8) {
        const float rs = rsqrtf(ssq3[row] * (1.f / DM) + EPS);
#pragma unroll
        for (int j = 0; j < 4; ++j) { f32x4* q = (f32x4*)(Y + (size_t)row * DM + 4 * lane + 256 * j); *q = *q * rs * g[j]; }
    }
}
#define RUN(ph) (((PHMASK >> (ph)) & 1) && ph_lo <= (ph) && (ph) <= ph_hi)
#define SYNC(ph) do { if (ph_lo <= (ph) && (ph) < ph_hi) grid.sync(); } while (0)
#define TWICE(ph, body) do { body; if ((REPMASK >> (ph)) & 1) { grid.sync(); body; } } while (0)
__device__ __forceinline__ void run_p1(const Params& p, PG8_LAS unsigned char* lds) { bf16_t* H = (bf16_t*)p.out; bf16_t* PROJ = (bf16_t*)(p.ws + WS_R1);
    pg8::StaticOrder S; S.init(MROWS, NIN, gridDim.x, blockIdx.x); pg8::Gemm g{H, (const bf16_t*)(p.ws + WS_WIN), MROWS, NIN, DM};
    EpiInProj E{PROJ, p.in[9], (float*)(p.ws + WS_GATES), p.in[11], p.in[12]}; pg8::gemm_phase(lds, g, S, E); }
__device__ __forceinline__ void run_p3(const Params& p, PG8_LAS unsigned char* lds) { bf16_t* AMIX = (bf16_t*)p.out + (size_t)MROWS * DM; bf16_t* X1B = (bf16_t*)(p.ws + WS_R1 + R1_X1B); float* X1 = (float*)(p.ws + WS_X1);
    pg8::StaticOrder S; S.init(MROWS, DM, gridDim.x, blockIdx.x); pg8::Gemm g{AMIX, (const bf16_t*)(p.ws + WS_WOUT), MROWS, DM, DM};
    EpiResid E{p.in[0], p.in[1], X1, X1B, (float*)(p.ws + WS_SSQ2)}; pg8::gemm_phase(lds, g, S, E); }
__device__ __forceinline__ void run_p4(const Params& p, PG8_LAS unsigned char* lds) { bf16_t* X1B = (bf16_t*)(p.ws + WS_R1 + R1_X1B); bf16_t* ACT = (bf16_t*)(p.ws + WS_R1 + R1_ACT);
    pg8::StaticOrder S; S.init(MROWS, NGV, gridDim.x, blockIdx.x); pg8::Gemm g{X1B, (const bf16_t*)(p.ws + WS_WGV), MROWS, NGV, DM};
    EpiGateVal E{ACT, (const float*)(p.ws + WS_SSQ2), p.in[18], p.in[19], p.in[6], (float*)(p.ws + WS_UHL), (float*)(p.ws + WS_UHF), p.out + O_VP, p.out + O_VS}; pg8::gemm_phase(lds, g, S, E); }
__device__ __forceinline__ void run_p6(const Params& p, PG8_LAS unsigned char* lds) { bf16_t* ACT = (bf16_t*)(p.ws + WS_R1 + R1_ACT); float* X1 = (float*)(p.ws + WS_X1);
    pg8::StaticOrder S; S.init(MROWS, DM, gridDim.x, blockIdx.x); pg8::Gemm g{ACT, (const bf16_t*)(p.ws + WS_WD), MROWS, DM, DFF};
    EpiResid E{X1, X1 + (size_t)MPROMPT * DM, p.out, nullptr, (float*)(p.ws + WS_SSQ3)}; pg8::gemm_phase(lds, g, S, E); }
__global__ __launch_bounds__(512, 2) void fwd_kernel(Params p, int ph_lo, int ph_hi) {
    extern __shared__ __attribute__((aligned(16))) unsigned char shm[];
    PG8_LAS unsigned char* lds = (PG8_LAS unsigned char*)shm;
    cg::grid_group grid = cg::this_grid();
    if (RUN(0)) TWICE(0, phase0(p, shm));
    SYNC(0);
    if (RUN(1)) TWICE(1, run_p1(p, lds));
    SYNC(1);
#if NAIVE_MIXER
    if (RUN(2)) phase2_naive(p, shm);
#else
    if (RUN(2)) { phase2a(p, lds); phase2a_samples(p, lds); grid.sync(); phase2b(p, lds); }
#endif
    SYNC(2);
    if (RUN(3)) run_p3(p, lds);
    SYNC(3);
    if (RUN(4)) TWICE(4, run_p4(p, lds));
    SYNC(4);
    if (RUN(5)) TWICE(5, phase5(p));
    SYNC(5);
    if (RUN(6)) run_p6(p, lds);
    SYNC(6);
    if (RUN(7)) phase7(p);
}
extern "C" void kernel_launch(void* const* d_in, const int* in_sizes, int n_in, void* d_out, int out_size, void* d_ws, size_t ws_size, hipStream_t stream) {
    static int grid = 0;
    if (grid == 0) {
        if (n_in != 22 || ws_size < WS_END) { fprintf(stderr, "kernel_launch: unexpected n_in %d / ws_size %zu (need %zu)\n", n_in, ws_size, (size_t)WS_END); grid = -1; return; }
        int dev = 0, cus = 0, per_cu = 0;
        hipGetDevice(&dev); hipDeviceGetAttribute(&cus, hipDeviceAttributeMultiprocessorCount, dev);
        if (hipFuncSetAttribute((const void*)fwd_kernel, hipFuncAttributeMaxDynamicSharedMemorySize, LDS_BYTES) != hipSuccess) { fprintf(stderr, "kernel_launch: hipFuncSetAttribute failed\n"); grid = -1; return; }
        if (hipOccupancyMaxActiveBlocksPerMultiprocessor(&per_cu, (const void*)fwd_kernel, 512, LDS_BYTES) != hipSuccess || per_cu < 1) { fprintf(stderr, "kernel_launch: occupancy query says %d blocks per CU\n", per_cu); per_cu = 1; }
        (void)hipGetLastError();
        grid = cus;
        fprintf(stderr, "kernel_launch: cus %d per_cu %d grid %d ws %zu\n", cus, per_cu, grid, ws_size);
    }
    if (grid < 0) return;
    Params p{};
    for (int i = 0; i < 22; ++i) p.in[i] = (const float*)d_in[i];
    p.out = (float*)d_out; p.ws = (unsigned char*)d_ws;
#if ONE_LAUNCH
    int lo = 0, hi = 7; void* args[] = {&p, &lo, &hi};
    hipError_t e = hipLaunchCooperativeKernel((const void*)fwd_kernel, dim3(grid), dim3(512), args, LDS_BYTES, stream);
    if (e != hipSuccess) fprintf(stderr, "cooperative launch failed: %s (grid %d)\n", hipGetErrorString(e), grid);
#else
    for (int ph = 0; ph < 8; ++ph) hipLaunchKernelGGL(fwd_kernel, dim3(grid), dim3(512), LDS_BYTES, stream, p, ph, ph);
#endif
}
```

```cpp
#include <hip/hip_runtime.h>
#include <hip/hip_cooperative_groups.h>
#include <cstdio>
#include <cstdint>
namespace cg = cooperative_groups;
#ifndef ONE_LAUNCH
#define ONE_LAUNCH 1
#endif
#ifndef PHMASK
#define PHMASK 255
#endif
#ifndef NAIVE_MIXER
#define NAIVE_MIXER 0
#endif
#ifndef REPMASK
#define REPMASK 0
#endif
#ifndef EXTRA_SYNCS
#define EXTRA_SYNCS 0
#endif
namespace pg8 {
#define PG8_LAS __attribute__((address_space(3)))
typedef unsigned short bf16_t;
typedef short bf16x8 __attribute__((ext_vector_type(8)));
typedef float f32x4 __attribute__((ext_vector_type(4)));
typedef unsigned u32x4 __attribute__((ext_vector_type(4)));
constexpr int BM = 256, BK = 64, HALF = 128, HTB = HALF * BK * 2  , STAGE_BYTES = 8 * HTB, NXCD = 8, WGM = 8;

__host__ __device__ __forceinline__ int lds_byte(int r, int c) { const int st = (r >> 4) * 2 + (c >> 5), rr = r & 15, cc = c & 31, ob = rr * 64 + cc * 2; return st * 1024 + (ob ^ (((ob >> 9) & 1) << 5)); }
__host__ __device__ __forceinline__ void stage_rc(int b, int& R, int& C) { const int st = b / 1024, sb = b % 1024, swz = sb ^ (((sb >> 9) & 1) << 5); R = (st >> 1) * 16 + swz / 64; C = (st & 1) * 32 + (swz % 64) / 2; }
__host__ __device__ __forceinline__ int perm32(int rho) { const int n = rho >> 4, i = rho & 15; return 8 * (i >> 2) + 4 * n + (i & 3); }

struct Unit { int pm, pn; };
struct Gemm { const bf16_t* A; const bf16_t* Bt; int M, N, K; };

struct StaticOrder {
    int nM, nN, nwg, G, c;
    __host__ __device__ void init(int M, int N, int G_, int c_) { nM = M / BM; nN = N / BM; nwg = nM * nN; G = G_; c = c_; }
    __host__ __device__ bool next(int i, Unit& u) const {
        const long L = (long)i * G + c; if (L >= nwg) return false;
        int wgid = (int)L; { const int q = nwg / NXCD, r = nwg % NXCD, xcd = wgid % NXCD, off = wgid / NXCD; wgid = (xcd < r ? xcd * (q + 1) : r * (q + 1) + (xcd - r) * q) + off; }
        const int nig = WGM * nN, gid = wgid / nig, fm = gid * WGM, gsz = (nM - fm) < WGM ? (nM - fm) : WGM;
        u.pm = fm + ((wgid % nig) % gsz); u.pn = (wgid % nig) / gsz; return true;
    }
    __device__ __forceinline__ void a_ready(const Unit&) const {}
    __device__ __forceinline__ void done(const Unit&) const {}
};

typedef float f32x2_t __attribute__((ext_vector_type(2)));
typedef __bf16 bf16x2_t __attribute__((ext_vector_type(2)));
__device__ __forceinline__ unsigned cvt_pk_bf16(float lo, float hi) { const f32x2_t v = {lo, hi}; return __builtin_bit_cast(unsigned, __builtin_convertvector(v, bf16x2_t)); }
template <class Epi, class Sched>
__device__ __forceinline__ void gemm_phase(PG8_LAS unsigned char* lds, const Gemm g, const Sched& S, const Epi& E) {
    const int tid = threadIdx.x, wid = __builtin_amdgcn_readfirstlane(tid >> 6), lane = tid & 63, wr = wid >> 2, wc = wid & 3, fr = lane & 15, fq = lane >> 4;
    const int K = g.K, nt = K / BK;
    unsigned voffA[2], voffB[2];
#pragma unroll
    for (int i = 0; i < 2; ++i) { int R, C; stage_rc(tid * 16 + i * 8192, R, C); const int Rb = Epi::PERM ? ((R & ~31) + perm32(R & 31)) : R;
        voffA[i] = (unsigned)(R * K + C) * 2u; voffB[i] = (unsigned)(Rb * K + C) * 2u; }
    const size_t kstep = (size_t)(BK * 2);
    const size_t hstep = (size_t)HALF * K * 2;
    const size_t tstep = 2 * hstep;
    const unsigned ldsw = (unsigned)wid * 1024u;
    const int aoff = lds_byte(wr * 64 + fr, fq * 8), boff = lds_byte(wc * 32 + fr, fq * 8);
#define PG8_SA(b, h) (((b) * 2 + (h)) * HTB)
#define PG8_SB(b, h) ((4 + (b) * 2 + (h)) * HTB)
#define PG8_STAGE(bufoff, gbase, voff) do { _Pragma("unroll") for (int _i = 0; _i < 2; ++_i) \
        __builtin_amdgcn_global_load_lds((const unsigned*)((const char*)(gbase) + (voff)[_i]), (PG8_LAS unsigned*)(lds + (bufoff) + ldsw + _i * 8192), 16, 0, 0); } while (0)
#define PG8_LDA(dst, b, h) do { _Pragma("unroll") for (int m = 0; m < 4; ++m) _Pragma("unroll") for (int k = 0; k < 2; ++k) dst[m][k] = *(const PG8_LAS bf16x8*)(lds + PG8_SA(b, h) + aoff + m * 2048 + k * 1024); } while (0)
#define PG8_LDB(dst, b, h) do { _Pragma("unroll") for (int n = 0; n < 2; ++n) _Pragma("unroll") for (int k = 0; k < 2; ++k) dst[n][k] = *(const PG8_LAS bf16x8*)(lds + PG8_SB(b, h) + boff + n * 2048 + k * 1024); } while (0)
#define PG8_MMA(ai, bj, At, Bt) do { __builtin_amdgcn_s_setprio(1); _Pragma("unroll") for (int m = 0; m < 4; ++m) _Pragma("unroll") for (int n = 0; n < 2; ++n) _Pragma("unroll") for (int k = 0; k < 2; ++k) \
        acc[ai][bj][m][n] = __builtin_amdgcn_mfma_f32_16x16x32_bf16(Bt[n][k], At[m][k], acc[ai][bj][m][n], 0, 0, 0); __builtin_amdgcn_s_setprio(0); } while (0)
#define PG8_WAIT_V(n) asm volatile("s_waitcnt vmcnt(" #n ")" ::: "memory")
#define PG8_WAIT_L(n) asm volatile("s_waitcnt lgkmcnt(" #n ")" ::: "memory")
#define PG8_BAR __builtin_amdgcn_s_barrier()
#define PG8_SCHED __builtin_amdgcn_sched_barrier(0)
    Unit cur, nxt; int ui = 0;
    if (!S.next(0, cur)) return;
    f32x4 acc[2][2][4][2];
#pragma unroll
    for (int a = 0; a < 2; ++a)
#pragma unroll
        for (int b = 0; b < 2; ++b)
#pragma unroll
            for (int m = 0; m < 4; ++m)
#pragma unroll
                for (int n = 0; n < 2; ++n) acc[a][b][m][n] = (f32x4){0.f, 0.f, 0.f, 0.f};
    bf16x8 At[4][2], B0[2][2], B1[2][2];
    const char* cA = (const char*)g.A + (size_t)cur.pm * tstep; const char* cB = (const char*)g.Bt + (size_t)cur.pn * tstep;
    S.a_ready(cur);
    PG8_STAGE(PG8_SB(0, 0), cB, voffB); PG8_STAGE(PG8_SA(0, 0), cA, voffA); PG8_STAGE(PG8_SB(0, 1), cB + hstep, voffB); PG8_STAGE(PG8_SA(0, 1), cA + hstep, voffA);
    if (wr == 1) PG8_BAR;
    PG8_WAIT_V(4); PG8_BAR;
    PG8_STAGE(PG8_SB(1, 0), cB + kstep, voffB); PG8_STAGE(PG8_SA(1, 0), cA + kstep, voffA); PG8_STAGE(PG8_SB(1, 1), cB + hstep + kstep, voffB);
    PG8_WAIT_V(6); PG8_BAR;
    for (;;) {
        const bool has_next = S.next(ui + 1, nxt);
        const char* nA = has_next ? (const char*)g.A + (size_t)nxt.pm * tstep : cA; const char* nB = has_next ? (const char*)g.Bt + (size_t)nxt.pn * tstep : cB;
        for (int t = 0; t < nt; t += 2) {
            const bool last = (t == nt - 2);
            const char* a1 = cA + (size_t)(t + 1) * kstep;
            const char* a2 = last ? nA : cA + (size_t)(t + 2) * kstep; const char* b2 = last ? nB : cB + (size_t)(t + 2) * kstep;
            const char* a3 = a2 + kstep; const char* b3 = b2 + kstep;
            if (last && has_next) S.a_ready(nxt);
            PG8_LDB(B0, 0, 0); PG8_SCHED; PG8_LDA(At, 0, 0); PG8_STAGE(PG8_SA(1, 1), a1 + hstep, voffA);
            PG8_WAIT_L(8); PG8_BAR; PG8_WAIT_L(0); PG8_MMA(0, 0, At, B0); PG8_BAR; PG8_SCHED;
            PG8_LDB(B1, 0, 1); PG8_STAGE(PG8_SB(0, 0), b2, voffB);
            PG8_BAR; PG8_WAIT_L(0); PG8_MMA(0, 1, At, B1); PG8_BAR;
            PG8_LDA(At, 0, 1); PG8_STAGE(PG8_SA(0, 0), a2, voffA);
            PG8_BAR; PG8_WAIT_L(0); PG8_MMA(1, 0, At, B0); PG8_BAR; PG8_SCHED;
            PG8_STAGE(PG8_SB(0, 1), b2 + hstep, voffB);
            PG8_WAIT_V(6); PG8_BAR; PG8_MMA(1, 1, At, B1); PG8_BAR;
            PG8_LDB(B0, 1, 0); PG8_SCHED; PG8_LDA(At, 1, 0); PG8_STAGE(PG8_SA(0, 1), a2 + hstep, voffA);
            PG8_WAIT_L(8); PG8_BAR; PG8_WAIT_L(0); PG8_MMA(0, 0, At, B0); PG8_BAR; PG8_SCHED;
            PG8_LDB(B1, 1, 1); PG8_STAGE(PG8_SB(1, 0), b3, voffB);
            PG8_BAR; PG8_WAIT_L(0); PG8_MMA(0, 1, At, B1); PG8_BAR;
            PG8_LDA(At, 1, 1); PG8_STAGE(PG8_SA(1, 0), a3, voffA);
            PG8_BAR; PG8_WAIT_L(0); PG8_MMA(1, 0, At, B0); PG8_BAR; PG8_SCHED;
            PG8_STAGE(PG8_SB(1, 1), b3 + hstep, voffB);
            PG8_WAIT_V(6); PG8_BAR; PG8_MMA(1, 1, At, B1); PG8_BAR;
        }
        if constexpr (!Epi::AFTER_DRAIN) { E(acc, cur, wr, wc, fr, fq); S.done(cur); }
        if (!has_next) break;
#pragma unroll
        for (int a = 0; a < 2; ++a)
#pragma unroll
            for (int b = 0; b < 2; ++b)
#pragma unroll
                for (int m = 0; m < 4; ++m)
#pragma unroll
                    for (int n = 0; n < 2; ++n) acc[a][b][m][n] = (f32x4){0.f, 0.f, 0.f, 0.f};
        cur = nxt; cA = nA; cB = nB; ++ui;
    }
    PG8_WAIT_V(0);
    if (wr == 0) PG8_BAR;
    PG8_BAR;
    if constexpr (Epi::AFTER_DRAIN) { E.fused(acc, cur, wr, wc, fr, fq, lds, wid, lane); S.done(cur); }
#undef PG8_SA
#undef PG8_SB
#undef PG8_STAGE
#undef PG8_LDA
#undef PG8_LDB
#undef PG8_MMA
#undef PG8_WAIT_V
#undef PG8_WAIT_L
#undef PG8_BAR
#undef PG8_SCHED
}

}
#define XB_TMO      128
#define XB_XCNT(j)  (256  + 64 * (j))
#define XB_XSUB(j)  (1280 + 64 * (j))
#define XB_XGEN(j)  (2304 + 64 * (j))
#define XB_TOP      3328
#define XB_TOPGEN   3392
#define XCD_BAR_WORDS 3456
#define XB_SPIN_CAP (1u << 18)
#ifndef LAS
#define LAS __attribute__((address_space(3)))
#endif

__device__ __forceinline__ unsigned xb_ld(unsigned* p)              { return __hip_atomic_load(p, __ATOMIC_RELAXED, __HIP_MEMORY_SCOPE_AGENT); }
__device__ __forceinline__ unsigned xb_add(unsigned* p, unsigned v) { return __hip_atomic_fetch_add(p, v, __ATOMIC_RELAXED, __HIP_MEMORY_SCOPE_AGENT); }
__device__ __forceinline__ unsigned xb_xcc_id() { return (unsigned)__builtin_amdgcn_s_getreg((3 << 11) | 20) & 0xFu; }
#define XB_SPIN(cond, bar) do { unsigned _sp = 0; while (cond) { __builtin_amdgcn_s_sleep(1); \
    if ((++_sp & 255u) == 0u) { if (xb_ld(&(bar)[XB_TMO])) break; if (_sp > XB_SPIN_CAP) { atomicAdd(&(bar)[XB_TMO], 1u); break; } } } } while (0)

struct XcdBarrier {
    unsigned* bar; unsigned x;
    volatile LAS unsigned* st;
};

__device__ __forceinline__ XcdBarrier xcd_barrier_post(unsigned* bar, volatile LAS unsigned* st) {
    XcdBarrier b; b.bar = bar; b.x = xb_xcc_id(); b.st = st;
    if (threadIdx.x == 0) (void)xb_add(&bar[XB_XCNT(b.x)], 1u);
    return b;
}
__device__ __forceinline__ void xcd_barrier_complete(unsigned* bar, unsigned x, unsigned& nloc, unsigned& nx) {
    const unsigned G = gridDim.x * gridDim.y * gridDim.z;
    unsigned sum, cnt, mine, sp = 0u;
    for (;;) {
        sum = 0u; cnt = 0u; mine = 0u;
#pragma unroll
        for (unsigned j = 0; j < 16; ++j) { const unsigned c = xb_ld(&bar[XB_XCNT(j)]); sum += c; cnt += (c > 0u) ? 1u : 0u; mine = (j == x) ? c : mine; }
        if (sum == G) break;
        __builtin_amdgcn_s_sleep(1);
        if ((++sp & 255u) == 0u) { if (xb_ld(&bar[XB_TMO])) break; if (sp > XB_SPIN_CAP) { atomicAdd(&bar[XB_TMO], 1u); break; } }
    }
    nloc = mine > 0u ? mine : 1u; nx = cnt > 0u ? cnt : 1u;
}

__device__ __forceinline__ void xcd_barrier(const XcdBarrier& b) {
    asm volatile("s_waitcnt vmcnt(0)" ::: "memory");
    __syncthreads();
    if (threadIdx.x == 0) {
        unsigned* bar = b.bar;
        __builtin_amdgcn_s_waitcnt(0);
        unsigned nloc = b.st[0], nx = b.st[1];
        if (nloc == 0u) { xcd_barrier_complete(bar, b.x, nloc, nx); b.st[0] = nloc; b.st[1] = nx; }
        const unsigned old = xb_add(&bar[XB_XSUB(b.x)], 1u);
        const unsigned gen = old / nloc;
        if (old + 1u == (gen + 1u) * nloc) {
            __builtin_amdgcn_fence(__ATOMIC_RELEASE, "agent");
            asm volatile("s_waitcnt vmcnt(0)" ::: "memory");
            const unsigned og = xb_add(&bar[XB_TOP], 1u);
            const unsigned tg = og / nx;
            if (og + 1u == (tg + 1u) * nx) xb_add(&bar[XB_TOPGEN], 1u);
            else XB_SPIN(xb_ld(&bar[XB_TOPGEN]) == tg, bar);
            __builtin_amdgcn_fence(__ATOMIC_ACQUIRE, "agent");
            xb_add(&bar[XB_XGEN(b.x)], 1u);
            asm volatile("s_waitcnt vmcnt(0)" ::: "memory");
        } else {
            XB_SPIN(xb_ld(&bar[XB_XGEN(b.x)]) == gen, bar);
            __builtin_amdgcn_fence(__ATOMIC_ACQUIRE, "agent");
            asm volatile("s_waitcnt vmcnt(0)" ::: "memory");
        }
    }
    __syncthreads();
}

using pg8::bf16_t; using pg8::f32x4; using pg8::u32x4; using pg8::Unit; using pg8::cvt_pk_bf16;
typedef unsigned u32x2 __attribute__((ext_vector_type(2)));
constexpr int DM = 1024, MROWS = 17408, MPROMPT = 16384, NPROJ = 4096, INCOLS = 4104, DFF = 2816, NGV = 5632;
constexpr float EPS = 1e-6f;
constexpr size_t O_Y = 0, O_SP = 17825792, O_SS = 18350080, O_CP = 26738688, O_CS = 27262976, O_NP = 35651584, O_NS = 35655680,
                 O_MP = 35721216, O_MS = 35721248, O_VP = 35721760, O_VS = 35766816;
constexpr int NIN = 4352;
constexpr size_t WS_CTL = 0, WS_WIN = 4096, WS_WOUT = WS_WIN + (size_t)NIN * 1024 * 2, WS_WGV = WS_WOUT + 1024 * 1024 * 2, WS_WD = WS_WGV + 5632 * 1024 * 2,
                 WS_GATES = WS_WD + 1024 * 2816 * 2, WS_SSQ2 = WS_GATES + 17408 * 32, WS_SSQ3 = WS_SSQ2 + 17408 * 4, WS_UHL = WS_SSQ3 + 17408 * 4, WS_UHF = WS_UHL + 256 * 2 * 2816 * 4,
                 WS_X1 = WS_UHF + 256 * 4 * 2816 * 4, WS_R1 = WS_X1 + (size_t)17408 * 1024 * 4, WS_BAR = WS_R1 + (size_t)17408 * 4096 * 2, WS_END = WS_BAR + 16384;
static_assert(WS_END <= 268435456, "workspace budget");
constexpr size_t R1_X1B = 1048576, R1_ACT = 36700160 + 1048576;
constexpr int LDS_BYTES = 160 * 1024 - 2048;

struct Params { const float* in[22]; float* out; unsigned char* ws; };

__device__ __forceinline__ float bf2f(unsigned short b) { return __uint_as_float(((unsigned)b) << 16); }
__device__ __forceinline__ unsigned short f2bf(float f) { unsigned u = __float_as_uint(f); u += 0x7fffu + ((u >> 16) & 1u); return (unsigned short)(u >> 16); }
__device__ __forceinline__ float wave_sum(float v) {
#pragma unroll
    for (int o = 1; o < 64; o <<= 1) v += __shfl_xor(v, o);
    return v;
}
__device__ __forceinline__ float sigmoidf_(float x) { return __builtin_amdgcn_rcpf(1.0f + __expf(-x)); }

__device__ __forceinline__ void p0_transpose_item(const float* W, int ldw, int K, bf16_t* WT, int drow0, int k0, int n0, int nmax, const float* kscale, float* scr, int lane) {
    const int ncol = min(n0 + (lane & 31), nmax);
    float v[32];
#pragma unroll
    for (int i = 0; i < 32; ++i) v[i] = W[(size_t)(k0 + 2 * i + (lane >> 5)) * ldw + ncol];
    if (kscale) {
#pragma unroll
        for (int i = 0; i < 32; ++i) v[i] *= kscale[k0 + 2 * i + (lane >> 5)]; }
#pragma unroll
    for (int i = 0; i < 32; ++i) scr[(2 * i + (lane >> 5)) * 33 + (lane & 31)] = v[i];
    asm volatile("s_waitcnt lgkmcnt(0)" ::: "memory");
    const int c = lane & 7;
#pragma unroll
    for (int j = 0; j < 4; ++j) { const int n = (lane >> 3) + 8 * j; const float* s = scr + (8 * c) * 33 + n;
        u32x4 o; o.x = cvt_pk_bf16(s[0 * 33], s[1 * 33]); o.y = cvt_pk_bf16(s[2 * 33], s[3 * 33]); o.z = cvt_pk_bf16(s[4 * 33], s[5 * 33]); o.w = cvt_pk_bf16(s[6 * 33], s[7 * 33]);
        *(u32x4*)(WT + (size_t)(drow0 + n) * K + k0 + 8 * c) = o; }
    asm volatile("s_waitcnt lgkmcnt(0)" ::: "memory");
}

__device__ __forceinline__ void phase0(const Params& p, unsigned char* shm) {
    const int tid = threadIdx.x, wave = tid >> 6, lane = tid & 63;
    float* scr = (float*)(shm + wave * 8704);
    const int gw = blockIdx.x * 8 + wave, NGW = gridDim.x * 8;
    bf16_t* WinT = (bf16_t*)(p.ws + WS_WIN); bf16_t* WoutT = (bf16_t*)(p.ws + WS_WOUT); bf16_t* WgvT = (bf16_t*)(p.ws + WS_WGV); bf16_t* WdT = (bf16_t*)(p.ws + WS_WD);
    { float* z = (float*)(p.ws + WS_SSQ2); for (int i = blockIdx.x * 512 + tid; i < 2 * MROWS; i += gridDim.x * 512) z[i] = 0.f; }
    if (blockIdx.x == 0 && tid < 64) ((unsigned*)(p.ws + WS_CTL))[tid] = 0u;
    bf16_t* H = (bf16_t*)p.out;
    {   f32x4 g1[4];
#pragma unroll
        for (int j = 0; j < 4; ++j) g1[j] = *(const f32x4*)(p.in[7] + 4 * lane + 256 * j);
        int row = gw; f32x4 v[4];
        if (row < MROWS) { const float* xr = row < MPROMPT ? p.in[0] + (size_t)row * DM : p.in[1] + (size_t)(row - MPROMPT) * DM;
#pragma unroll
            for (int j = 0; j < 4; ++j) v[j] = *(const f32x4*)(xr + 4 * lane + 256 * j); }
        while (row < MROWS) {
            const int nrow = row + NGW; f32x4 nv[4];
#pragma unroll
            for (int j = 0; j < 4; ++j) nv[j] = (f32x4){0.f, 0.f, 0.f, 0.f};
            if (nrow < MROWS) { const float* xr = nrow < MPROMPT ? p.in[0] + (size_t)nrow * DM : p.in[1] + (size_t)(nrow - MPROMPT) * DM;
#pragma unroll
                for (int j = 0; j < 4; ++j) nv[j] = *(const f32x4*)(xr + 4 * lane + 256 * j); }
            float s = 0.f;
#pragma unroll
            for (int j = 0; j < 4; ++j) s += (v[j].x * v[j].x + v[j].y * v[j].y) + (v[j].z * v[j].z + v[j].w * v[j].w);
            const float rs = rsqrtf(wave_sum(s) * (1.f / DM) + EPS);
#pragma unroll
            for (int j = 0; j < 4; ++j) { const f32x4 o = v[j] * rs * g1[j];
                *(u32x2*)(H + (size_t)row * DM + 4 * lane + 256 * j) = (u32x2){cvt_pk_bf16(o.x, o.y), cvt_pk_bf16(o.z, o.w)}; }
#pragma unroll
            for (int j = 0; j < 4; ++j) v[j] = nv[j];
            row = nrow;
        }
    }
    constexpr int I_IN = 16 * 129, I_OUT = 16 * 32, I_G = 16 * 88, I_D = 44 * 32, NIT = I_IN + I_OUT + 2 * I_G + I_D;
    for (int it = gw; it < NIT; it += NGW) {
        int r = it;
        if (r < I_IN) { const int kb = r / 129, nb = r % 129; p0_transpose_item(p.in[8], INCOLS, DM, WinT, 32 * nb, 64 * kb, 32 * nb, INCOLS - 1, nullptr, scr, lane); continue; } r -= I_IN;
        if (r < I_OUT) { const int kb = r / 32, nb = r % 32; p0_transpose_item(p.in[14], DM, DM, WoutT, 32 * nb, 64 * kb, 32 * nb, DM - 1, nullptr, scr, lane); continue; } r -= I_OUT;
        if (r < I_G) { const int kb = r / 88, nb = r % 88, n0 = 32 * nb; p0_transpose_item(p.in[16], DFF, DM, WgvT, 256 * (n0 >> 7) + (n0 & 127), 64 * kb, n0, DFF - 1, p.in[15], scr, lane); continue; } r -= I_G;
        if (r < I_G) { const int kb = r / 88, nb = r % 88, n0 = 32 * nb; p0_transpose_item(p.in[17], DFF, DM, WgvT, 256 * (n0 >> 7) + 128 + (n0 & 127), 64 * kb, n0, DFF - 1, p.in[15], scr, lane); continue; } r -= I_G;
        { const int kb = r / 32, nb = r % 32; p0_transpose_item(p.in[20], DM, DFF, WdT, 32 * nb, 64 * kb, 32 * nb, DM - 1, nullptr, scr, lane); }
    }
}
struct EpiInProj {
    static constexpr bool PERM = true, AFTER_DRAIN = false;
    bf16_t* O; const float* lbl; float* gates; const float* b_ig; const float* b_fg;
    __device__ __forceinline__ void operator()(const f32x4 (&acc)[2][2][4][2], const Unit& u, int wr, int wc, int fr, int fq) const {
        const int seg = u.pn >> 1, row0 = u.pm * 256 + wr * 64 + fr, col0 = u.pn * 256 + wc * 32 + 8 * fq;
        if (seg == 8) {
            if (wc == 0 && fq == 0) {
                float bi[4], bf_[4];
#pragma unroll
                for (int e = 0; e < 4; ++e) { bi[e] = b_ig[e]; bf_[e] = b_fg[e]; }
#pragma unroll
                for (int ai = 0; ai < 2; ++ai)
#pragma unroll
                    for (int m = 0; m < 4; ++m) { float* gp = gates + (size_t)(row0 + ai * 128 + m * 16) * 8; f32x4 a = acc[ai][0][m][0], b = acc[ai][0][m][1];
#pragma unroll
                        for (int e = 0; e < 4; ++e) { a[e] += bi[e]; const float z = b[e] + bf_[e]; b[e] = z > 0.f ? -log1pf(__expf(-z)) : z - log1pf(__expf(z)); }
                        *(f32x4*)gp = a; *(f32x4*)(gp + 4) = b; }
            }
            return;
        }
        float lb[2][8];
        if (seg == 1) {
#pragma unroll
            for (int bj = 0; bj < 2; ++bj)
#pragma unroll
                for (int e = 0; e < 8; ++e) { const int c = col0 + bj * 128 + e - 512; lb[bj][e] = __builtin_amdgcn_rcpf(1.0f + __expf(lbl[512 + c] - lbl[c])); }
        }
#pragma unroll
        for (int ai = 0; ai < 2; ++ai)
#pragma unroll
            for (int m = 0; m < 4; ++m) { bf16_t* rowp = O + (size_t)(row0 + ai * 128 + m * 16) * NPROJ + col0;
#pragma unroll
                for (int bj = 0; bj < 2; ++bj) { float v[8];
#pragma unroll
                    for (int e = 0; e < 8; ++e) v[e] = acc[ai][bj][m][e >> 2][e & 3];
                    if (seg == 1) {
#pragma unroll
                        for (int e = 0; e < 8; ++e) v[e] = __logf(lb[bj][e] + (1.0f - lb[bj][e]) * sigmoidf_(v[e]));
                    } else if (seg == 3) {
#pragma unroll
                        for (int e = 0; e < 8; ++e) v[e] = v[e] * sigmoidf_(v[e]);
                    } else if (seg == 5) {
#pragma unroll
                        for (int e = 0; e < 8; ++e) v[e] = v[e] * 0.08838834764831845f;
                    } else if (seg == 7) {
#pragma unroll
                        for (int e = 0; e < 8; ++e) v[e] = sigmoidf_(v[e]);
                    }
                    u32x4 w; w.x = cvt_pk_bf16(v[0], v[1]); w.y = cvt_pk_bf16(v[2], v[3]); w.z = cvt_pk_bf16(v[4], v[5]); w.w = cvt_pk_bf16(v[6], v[7]);
                    *(u32x4*)(rowp + bj * 128) = w; } }
    }
};
struct EpiResid {
    static constexpr bool PERM = true, AFTER_DRAIN = false;
    const float* base_p; const float* base_s;
    float* out; bf16_t* outb; float* ssq;
    __device__ __forceinline__ void operator()(const f32x4 (&acc)[2][2][4][2], const Unit& u, int wr, int wc, int fr, int fq) const {
        const int row0 = u.pm * 256 + wr * 64 + fr, col0 = u.pn * 256 + wc * 32 + 8 * fq;
        const float* base = u.pm < 64 ? base_p : base_s - (size_t)MPROMPT * DM;
#pragma unroll
        for (int ai = 0; ai < 2; ++ai)
#pragma unroll
            for (int m = 0; m < 4; ++m) { const int row = row0 + ai * 128 + m * 16; const size_t off = (size_t)row * DM + col0; float ss = 0.f;
#pragma unroll
                for (int bj = 0; bj < 2; ++bj) { const f32x4 xa = *(const f32x4*)(base + off + bj * 128), xb = *(const f32x4*)(base + off + bj * 128 + 4);
                    const f32x4 v0 = acc[ai][bj][m][0] + xa, v1 = acc[ai][bj][m][1] + xb;
                    *(f32x4*)(out + off + bj * 128) = v0; *(f32x4*)(out + off + bj * 128 + 4) = v1;
                    if (outb) { u32x4 w; w.x = cvt_pk_bf16(v0[0], v0[1]); w.y = cvt_pk_bf16(v0[2], v0[3]); w.z = cvt_pk_bf16(v1[0], v1[1]); w.w = cvt_pk_bf16(v1[2], v1[3]); *(u32x4*)(outb + off + bj * 128) = w; }
                    ss += (v0[0] * v0[0] + v0[1] * v0[1]) + (v0[2] * v0[2] + v0[3] * v0[3]) + (v1[0] * v1[0] + v1[1] * v1[1]) + (v1[2] * v1[2] + v1[3] * v1[3]); }
                ss += __shfl_xor(ss, 16); ss += __shfl_xor(ss, 32);
                if (fq == 0) atomicAdd(ssq + row, ss); }
    }
};
__device__ __forceinline__ float gelu_tanh(float x) { const float z = 0.7978845608028654f * (x + 0.044715f * x * x * x); return x * __builtin_amdgcn_rcpf(1.0f + __expf(-2.0f * z)); }
__device__ __forceinline__ float rot16(float x, int lane, int n) { return __shfl(x, (lane & ~15) | ((lane - n) & 15)); }
struct EpiGateVal {
    static constexpr bool PERM = true, AFTER_DRAIN = false;
    bf16_t* ACT; const float* ssq2; const float* conv_w; const float* conv_b; const float* state_conv; float* UHL; float* UHF; float* out_vp; float* out_vs;
    __device__ __forceinline__ void operator()(const f32x4 (&acc)[2][2][4][2], const Unit& u, int wr, int wc, int fr, int fq) const {
        const int lane = threadIdx.x & 63;
        const int c0 = u.pn * 128 + wc * 32 + 8 * fq;
        float w0[8], w1[8], w2[8], cb[8];
#pragma unroll
        for (int e = 0; e < 8; ++e) { w0[e] = conv_w[c0 + e]; w1[e] = conv_w[DFF + c0 + e]; w2[e] = conv_w[2 * DFF + c0 + e]; cb[e] = conv_b[c0 + e]; }
        const bool sample = u.pm >= 64;
#pragma unroll
        for (int ai = 0; ai < 2; ++ai) {
            float r1p[8], r2p[8];
#pragma unroll
            for (int e = 0; e < 8; ++e) { r1p[e] = 0.f; r2p[e] = 0.f; }
#pragma unroll
            for (int m = 0; m < 4; ++m) { const int row = u.pm * 256 + ai * 128 + wr * 64 + m * 16 + fr;
                const float rs = rsqrtf(ssq2[row] * (1.f / DM) + EPS);
                float uu[8], vv[8], r1[8], r2[8];
#pragma unroll
                for (int e = 0; e < 8; ++e) { uu[e] = acc[ai][0][m][e >> 2][e & 3] * rs; vv[e] = acc[ai][1][m][e >> 2][e & 3] * rs; }
#pragma unroll
                for (int e = 0; e < 8; ++e) { r1[e] = rot16(uu[e], lane, 1); r2[e] = rot16(uu[e], lane, 2); }
                float p1[8], p2[8]; bool valid = true;
                if (!sample) {
#pragma unroll
                    for (int e = 0; e < 8; ++e) { p1[e] = fr >= 1 ? r1[e] : r1p[e]; p2[e] = fr >= 2 ? r2[e] : r2p[e]; }
                    if (m == 0 && fr < 2) { valid = false; const int gi = row >> 6; float* d = UHF + ((size_t)(gi * 2 + fr) * 2) * DFF + c0;
                        *(f32x4*)d = (f32x4){uu[0], uu[1], uu[2], uu[3]}; *(f32x4*)(d + 4) = (f32x4){uu[4], uu[5], uu[6], uu[7]};
                        *(f32x4*)(d + DFF) = (f32x4){vv[0], vv[1], vv[2], vv[3]}; *(f32x4*)(d + DFF + 4) = (f32x4){vv[4], vv[5], vv[6], vv[7]}; }
                    if (m == 3 && fr >= 14) { const int gi = row >> 6; float* d = UHL + (size_t)(gi * 2 + (fr - 14)) * DFF + c0;
                        *(f32x4*)d = (f32x4){uu[0], uu[1], uu[2], uu[3]}; *(f32x4*)(d + 4) = (f32x4){uu[4], uu[5], uu[6], uu[7]};
                        if ((row & 2047) >= 2046) { float* o = out_vp + (size_t)((row >> 11) * 2 + (fr - 14)) * DFF + c0;
                            *(f32x4*)o = (f32x4){uu[0], uu[1], uu[2], uu[3]}; *(f32x4*)(o + 4) = (f32x4){uu[4], uu[5], uu[6], uu[7]}; } }
                } else {
                    const int pos = fr & 7, b = (row - MPROMPT) >> 3; const float* sc = state_conv + (size_t)b * 2 * DFF + c0;
                    float b0[8], b1[8];
#pragma unroll
                    for (int e = 0; e < 8; ++e) { b0[e] = 0.f; b1[e] = 0.f; }
                    if (pos < 2) {
#pragma unroll
                        for (int e = 0; e < 8; ++e) { b0[e] = sc[e]; b1[e] = sc[DFF + e]; } }
#pragma unroll
                    for (int e = 0; e < 8; ++e) { p1[e] = pos >= 1 ? r1[e] : b1[e]; p2[e] = pos >= 2 ? r2[e] : (pos == 1 ? b1[e] : b0[e]); }
                    if (pos >= 6) { float* o = out_vs + (size_t)(b * 2 + (pos - 6)) * DFF + c0;
                        *(f32x4*)o = (f32x4){uu[0], uu[1], uu[2], uu[3]}; *(f32x4*)(o + 4) = (f32x4){uu[4], uu[5], uu[6], uu[7]}; }
                }
                if (valid) { float a[8];
#pragma unroll
                    for (int e = 0; e < 8; ++e) a[e] = gelu_tanh(cb[e] + w0[e] * p2[e] + w1[e] * p1[e] + w2[e] * uu[e]) * vv[e];
                    u32x4 w; w.x = cvt_pk_bf16(a[0], a[1]); w.y = cvt_pk_bf16(a[2], a[3]); w.z = cvt_pk_bf16(a[4], a[5]); w.w = cvt_pk_bf16(a[6], a[7]);
                    *(u32x4*)(ACT + (size_t)row * DFF + c0) = w; }
#pragma unroll
                for (int e = 0; e < 8; ++e) { r1p[e] = r1[e]; r2p[e] = r2[e]; }
            }
        }
    }
};
#ifndef LAS
#define LAS __attribute__((address_space(3)))
#endif
#define LDS_BARRIER() do { asm volatile("s_waitcnt lgkmcnt(0)" ::: "memory"); __builtin_amdgcn_s_barrier(); asm volatile("" ::: "memory"); } while (0)
typedef short bf16x8 __attribute__((ext_vector_type(8)));
constexpr int QT_OFF = 0, KT_OFF = 17408, KHT_OFF = 34816, VT_OFF = 53248, SW_OFF = 73984, ST_OFF = 83200, RAWV_OFF = 122368, SM_OFF = 138752;
constexpr int F_DLAST = 0, F_PTOT = 128, F_SG = 640, F_SM = 704, F_SWI = 768, F_SMT = 832, F_SWEND = 896, F_SDEN = 960, F_SSSQ = 1024, F_SCAL = 1152;
__device__ __forceinline__ bf16x8 ldfrag(const LAS unsigned char* base, int stride_b, int row, int kcol) { return *(const LAS bf16x8*)(base + row * stride_b + kcol * 2); }
__device__ __forceinline__ f32x4 mfma16(bf16x8 a, bf16x8 b, f32x4 c) { return __builtin_amdgcn_mfma_f32_16x16x32_bf16(a, b, c, 0, 0, 0); }
__device__ __forceinline__ u32x2 pack4(f32x4 v) { return (u32x2){cvt_pk_bf16(v[0], v[1]), cvt_pk_bf16(v[2], v[3])}; }

template <bool IS_ML>
__device__ __forceinline__ void mixer_item(const Params& p, LAS unsigned char* L, const int sqi, const int h, const bool prompt) {
    const int tid = threadIdx.x, w = __builtin_amdgcn_readfirstlane(tid >> 6), lane = tid & 63, l15 = lane & 15, q4 = lane >> 4;
    const int Lc = prompt ? 64 : 8, nch = prompt ? 32 : 1;
    const int row0 = prompt ? sqi * 2048 : MPROMPT + sqi * 8;
    const bf16_t* PROJ = (const bf16_t*)(p.ws + WS_R1) + (IS_ML ? 2048 : 0) + h * 128;
    bf16_t* AMIX = (bf16_t*)p.out + (size_t)MROWS * DM + (IS_ML ? 512 : 0) + h * 128;
    const float* GATES = (const float*)(p.ws + WS_GATES);
    LAS unsigned char* Qt = L + QT_OFF; LAS unsigned char* Kt = L + KT_OFF; LAS unsigned char* KhT = L + KHT_OFF; LAS unsigned char* VT = L + VT_OFF;
    LAS unsigned char* Sw = L + SW_OFF; LAS unsigned char* ST = L + ST_OFF; LAS unsigned char* rawV = L + RAWV_OFF; LAS float* sm = (LAS float*)(L + SM_OFF);
    constexpr int NV = IS_ML ? 9 : 8;
    const int tt = w & 3, vb = w >> 2;
    const size_t sbase = (size_t)(sqi * 4 + h) * 128 * 128;
    f32x4 sacc[NV];
    float m_prev = 0.f;
#pragma unroll
    for (int vt = 0; vt < NV; ++vt) sacc[vt] = (f32x4){0.f, 0.f, 0.f, 0.f};
    if (!prompt) {
        const float* S0 = IS_ML ? p.in[3] : p.in[2];
#pragma unroll
        for (int vt = 0; vt < 8; ++vt)
#pragma unroll
            for (int j = 0; j < 4; ++j) sacc[vt][j] = S0[sbase + (size_t)(w * 16 + q4 * 4 + j) * 128 + vt * 16 + l15];
        if (IS_ML) { m_prev = p.in[5][sqi * 4 + h];
            if (l15 == 0) {
#pragma unroll
                for (int j = 0; j < 4; ++j) sacc[NV - 1][j] = p.in[4][(size_t)(sqi * 4 + h) * 128 + w * 16 + q4 * 4 + j]; } }
    }
    float gnr[4][4];
    { const float* gn = (IS_ML ? p.in[13] : p.in[10]) + h * 128;
#pragma unroll
        for (int i = 0; i < 4; ++i)
#pragma unroll
            for (int j = 0; j < 4; ++j) gnr[i][j] = gn[(vb * 4 + i) * 16 + q4 * 4 + j]; }
    u32x4 rq[2], rk[2], rv[2];
    auto load_raw = [&](int c) {
#pragma unroll
        for (int i = 0; i < 2; ++i) { const int pc = tid + 512 * i, r = pc >> 4, c8 = pc & 15;
            if (r < Lc) { const bf16_t* src = PROJ + (size_t)(row0 + c * 64 + r) * NPROJ + c8 * 8;
                rq[i] = *(const u32x4*)src; rk[i] = *(const u32x4*)(src + 512); rv[i] = *(const u32x4*)(src + 1024); }
            else { rq[i] = (u32x4){0u, 0u, 0u, 0u}; rk[i] = rq[i]; rv[i] = rq[i]; } }
    };
    load_raw(0);
    LDS_BARRIER();
#pragma unroll
    for (int vt = 0; vt < NV; ++vt) *(LAS u32x2*)(ST + (vt * 16 + l15) * 272 + (w * 16 + q4 * 4) * 2) = pack4(sacc[vt]);
    if (IS_ML) { for (int i = tid; i < 16 * 72; i += 512) *(LAS unsigned short*)(VT + (128 * 72 + i) * 2) = (i < 72) ? (unsigned short)0x3F80 : (unsigned short)0; }
    for (int c = 0; c < nch; ++c) {
#pragma unroll
        for (int i = 0; i < 2; ++i) { const int pc = tid + 512 * i, r = pc >> 4, c8 = pc & 15;
            *(LAS u32x4*)(Qt + r * 272 + c8 * 16) = rq[i]; *(LAS u32x4*)(Kt + r * 272 + c8 * 16) = rk[i]; *(LAS u32x4*)(rawV + r * 256 + c8 * 16) = rv[i]; }
        if (IS_ML && w == 0) {
            const int t = lane; float lf = 0.f, ig = -INFINITY;
            if (t < Lc) { const float* gp = GATES + (size_t)(row0 + c * 64 + t) * 8; ig = gp[h]; lf = gp[4 + h]; }
            float a = lf;
#pragma unroll
            for (int o = 1; o < 64; o <<= 1) { const float x = __shfl_up(a, o); if (lane >= o) a += x; }
            const float g = ig - a; float cm = g;
#pragma unroll
            for (int o = 1; o < 64; o <<= 1) { const float x = __shfl_up(cm, o); if (lane >= o) cm = fmaxf(cm, x); }
            const float M = fmaxf(m_prev, cm), M63 = __shfl(M, 63), a63 = __shfl(a, 63);
            sm[F_SG + t] = g; sm[F_SM + t] = M; sm[F_SWI + t] = __expf(m_prev - M); sm[F_SMT + t] = a + M; sm[F_SWEND + t] = __expf(g - M63);
            if (lane == 0) { sm[F_SCAL + 0] = __expf(m_prev - M63); sm[F_SCAL + 1] = a63 + M63; }
        }
        LDS_BARRIER();
        if (c + 1 < nch) load_raw(c + 1);
        { const int k = tid & 127, part = tid >> 7; unsigned short kh[16];
            if (!IS_ML) {
                float lfv[16], cs[16]; float run = 0.f;
#pragma unroll
                for (int i = 0; i < 16; ++i) { lfv[i] = bf2f(*(const LAS unsigned short*)(Kt + (part * 16 + i) * 272 + k * 2)); run += lfv[i]; cs[i] = run; }
                sm[F_PTOT + part * 128 + k] = run;
                LDS_BARRIER();
                float pre = 0.f, tot = 0.f;
#pragma unroll
                for (int pp = 0; pp < 4; ++pp) { const float x = sm[F_PTOT + pp * 128 + k]; tot += x; if (pp < part) pre += x; }
                if (part == 0) sm[F_DLAST + k] = __expf(tot);
#pragma unroll
                for (int i = 0; i < 16; ++i) { const int s = part * 16 + i; const float b = pre + cs[i], e = __expf(b), r = __builtin_amdgcn_rcpf(e), kk = 1.f - __expf(lfv[i]);
                    LAS unsigned short* qp = (LAS unsigned short*)(Qt + s * 272 + k * 2); *qp = f2bf(bf2f(*qp) * e);
                    *(LAS unsigned short*)(Kt + s * 272 + k * 2) = f2bf(kk * r); kh[i] = f2bf(kk * __expf(tot - b)); }
            } else {
#pragma unroll
                for (int i = 0; i < 16; ++i) { const int s = part * 16 + i; kh[i] = f2bf(bf2f(*(const LAS unsigned short*)(Kt + s * 272 + k * 2)) * sm[F_SWEND + s]); }
            }
            u32x4 w0, w1;
            w0.x = kh[0] | ((unsigned)kh[1] << 16); w0.y = kh[2] | ((unsigned)kh[3] << 16); w0.z = kh[4] | ((unsigned)kh[5] << 16); w0.w = kh[6] | ((unsigned)kh[7] << 16);
            w1.x = kh[8] | ((unsigned)kh[9] << 16); w1.y = kh[10] | ((unsigned)kh[11] << 16); w1.z = kh[12] | ((unsigned)kh[13] << 16); w1.w = kh[14] | ((unsigned)kh[15] << 16);
            *(LAS u32x4*)(KhT + k * 144 + part * 32) = w0; *(LAS u32x4*)(KhT + k * 144 + part * 32 + 16) = w1;
            unsigned short vv[16];
#pragma unroll
            for (int i = 0; i < 16; ++i) vv[i] = *(const LAS unsigned short*)(rawV + (part * 16 + i) * 256 + k * 2);
            w0.x = vv[0] | ((unsigned)vv[1] << 16); w0.y = vv[2] | ((unsigned)vv[3] << 16); w0.z = vv[4] | ((unsigned)vv[5] << 16); w0.w = vv[6] | ((unsigned)vv[7] << 16);
            w1.x = vv[8] | ((unsigned)vv[9] << 16); w1.y = vv[10] | ((unsigned)vv[11] << 16); w1.z = vv[12] | ((unsigned)vv[13] << 16); w1.w = vv[14] | ((unsigned)vv[15] << 16);
            *(LAS u32x4*)(VT + k * 144 + part * 32) = w0; *(LAS u32x4*)(VT + k * 144 + part * 32 + 16) = w1;
        }
        LDS_BARRIER();
        { const int pt = w >> 1;
#pragma unroll
            for (int e = 0; e < 2; ++e) { const int st = 2 * (w & 1) + e; f32x4 pa = (f32x4){0.f, 0.f, 0.f, 0.f};
                if (st <= pt) {
#pragma unroll
                    for (int ks = 0; ks < 4; ++ks) pa = mfma16(ldfrag(Kt, 272, st * 16 + l15, ks * 32 + q4 * 8), ldfrag(Qt, 272, pt * 16 + l15, ks * 32 + q4 * 8), pa); }
                const int t = pt * 16 + l15, s0 = st * 16 + q4 * 4; const float Mt = IS_ML ? sm[F_SM + t] : 0.f;
#pragma unroll
                for (int j = 0; j < 4; ++j) { const int s = s0 + j; float x = pa[j]; if (IS_ML) x *= __expf(sm[F_SG + s] - Mt); pa[j] = (s <= t) ? x : 0.f; }
                *(LAS u32x2*)(Sw + t * 144 + s0 * 2) = pack4(pa); } }
        f32x4 oacc[5];
        { bf16x8 bq[4];
#pragma unroll
            for (int ks = 0; ks < 4; ++ks) bq[ks] = ldfrag(Qt, 272, tt * 16 + l15, ks * 32 + q4 * 8);
            const float wi = IS_ML ? sm[F_SWI + tt * 16 + l15] : 1.f;
#pragma unroll
            for (int i = 0; i < 5; ++i) { oacc[i] = (f32x4){0.f, 0.f, 0.f, 0.f};
                if (i < 4 || (IS_ML && vb == 1)) { const int vt = i < 4 ? vb * 4 + i : 8;
#pragma unroll
                    for (int ks = 0; ks < 4; ++ks) oacc[i] = mfma16(ldfrag(ST, 272, vt * 16 + l15, ks * 32 + q4 * 8), bq[ks], oacc[i]);
                    if (IS_ML) oacc[i] = oacc[i] * wi; } } }
        LDS_BARRIER();
        { bf16x8 bs[2];
#pragma unroll
            for (int ks = 0; ks < 2; ++ks) bs[ks] = ldfrag(Sw, 144, tt * 16 + l15, ks * 32 + q4 * 8);
#pragma unroll
            for (int i = 0; i < 5; ++i) if (i < 4 || (IS_ML && vb == 1)) { const int vt = i < 4 ? vb * 4 + i : 8;
#pragma unroll
                for (int ks = 0; ks < 2; ++ks) oacc[i] = mfma16(ldfrag(VT, 144, vt * 16 + l15, ks * 32 + q4 * 8), bs[ks], oacc[i]); } }
        { bf16x8 ak[2];
#pragma unroll
            for (int ks = 0; ks < 2; ++ks) ak[ks] = ldfrag(KhT, 144, w * 16 + l15, ks * 32 + q4 * 8);
            f32x4 dl;
            if (IS_ML) { const float fe = sm[F_SCAL + 0]; dl = (f32x4){fe, fe, fe, fe}; m_prev = sm[F_SCAL + 1]; }
            else dl = *(const LAS f32x4*)(sm + F_DLAST + w * 16 + q4 * 4);
#pragma unroll
            for (int vt = 0; vt < NV; ++vt) { sacc[vt] = sacc[vt] * dl;
#pragma unroll
                for (int ks = 0; ks < 2; ++ks) sacc[vt] = mfma16(ak[ks], ldfrag(VT, 144, vt * 16 + l15, ks * 32 + q4 * 8), sacc[vt]);
                *(LAS u32x2*)(ST + (vt * 16 + l15) * 272 + (w * 16 + q4 * 4) * 2) = pack4(sacc[vt]); } }
        const int t = tt * 16 + l15;
        if (IS_ML) {
            if (vb == 1 && q4 == 0) sm[F_SDEN + t] = oacc[4][0];
            LDS_BARRIER();
            const float inv = 1.0f / fmaxf(fabsf(sm[F_SDEN + t]), __expf(-sm[F_SMT + t]));
#pragma unroll
            for (int i = 0; i < 4; ++i) oacc[i] = oacc[i] * inv;
        }
        float ss = 0.f;
#pragma unroll
        for (int i = 0; i < 4; ++i) ss += (oacc[i][0] * oacc[i][0] + oacc[i][1] * oacc[i][1]) + (oacc[i][2] * oacc[i][2] + oacc[i][3] * oacc[i][3]);
        ss += __shfl_xor(ss, 16); ss += __shfl_xor(ss, 32);
        if (q4 == 0) sm[F_SSSQ + t * 2 + vb] = ss;
        LDS_BARRIER();
        if (t < Lc) { const float rs = rsqrtf((sm[F_SSSQ + t * 2] + sm[F_SSSQ + t * 2 + 1]) * (1.f / 128.f) + EPS);
            const size_t row = (size_t)row0 + c * 64 + t;
#pragma unroll
            for (int i = 0; i < 4; ++i) { const int v0 = (vb * 4 + i) * 16 + q4 * 4; const u32x2 gt = *(const u32x2*)(PROJ + row * NPROJ + 1536 + v0);
                f32x4 o; o[0] = oacc[i][0] * rs * gnr[i][0] * __uint_as_float(gt.x << 16); o[1] = oacc[i][1] * rs * gnr[i][1] * __uint_as_float(gt.x & 0xffff0000u);
                o[2] = oacc[i][2] * rs * gnr[i][2] * __uint_as_float(gt.y << 16); o[3] = oacc[i][3] * rs * gnr[i][3] * __uint_as_float(gt.y & 0xffff0000u);
                *(u32x2*)(AMIX + row * DM + v0) = pack4(o); } }
    }
    { float* So = p.out + (IS_ML ? (prompt ? O_CP : O_CS) : (prompt ? O_SP : O_SS));
#pragma unroll
        for (int vt = 0; vt < 8; ++vt)
#pragma unroll
            for (int j = 0; j < 4; ++j) So[sbase + (size_t)(w * 16 + q4 * 4 + j) * 128 + vt * 16 + l15] = sacc[vt][j];
        if (IS_ML) { if (l15 == 0) { float* no = p.out + (prompt ? O_NP : O_NS) + (size_t)(sqi * 4 + h) * 128;
#pragma unroll
                for (int j = 0; j < 4; ++j) no[w * 16 + q4 * 4 + j] = sacc[NV - 1][j]; }
            if (tid == 0) p.out[(prompt ? O_MP : O_MS) + sqi * 4 + h] = m_prev; } }
}
__device__ __forceinline__ void mixer_dispatch(const Params& p, LAS unsigned char* L, int it) {
    int g, sqi, h; const bool prompt = it < 64;
    if (prompt) { g = it >> 5; sqi = (it >> 2) & 7; h = it & 3; } else { const int j = it - 64; g = j >> 9; sqi = (j >> 2) & 127; h = j & 3; }
    if (g == 0) mixer_item<false>(p, L, sqi, h, prompt); else mixer_item<true>(p, L, sqi, h, prompt);
}
__device__ __forceinline__ void phase2_chunked(const Params& p, LAS unsigned char* L) {
    const int G = gridDim.x, b = blockIdx.x;
    if (G > 64) { if (b < 64) mixer_dispatch(p, L, b); else for (int it = b; it < 1088; it += G - 64) mixer_dispatch(p, L, it); }
    else for (int it = b; it < 1088; it += G) mixer_dispatch(p, L, it);
}
constexpr size_t WS_SB = WS_X1;
template <bool IS_ML>
__device__ __forceinline__ void prepass_item(const Params& p, LAS unsigned char* L, const int sqi, const int c, const int h, u32x4 (&rq)[2], u32x4 (&rk)[2], u32x4 (&rv)[2], float& gig, float& glf,
                                             const bf16_t* nsrc, const float* ngates) {
    const int tid = threadIdx.x, w = __builtin_amdgcn_readfirstlane(tid >> 6), lane = tid & 63, l15 = lane & 15, q4 = lane >> 4;
    const int row0 = sqi * 2048 + c * 64;
    bf16_t* PROJ = (bf16_t*)(p.ws + WS_R1) + (IS_ML ? 2048 : 0) + h * 128;
    bf16_t* AMIX = (bf16_t*)p.out + (size_t)MROWS * DM + (IS_ML ? 512 : 0) + h * 128;
    float* SB = (float*)(p.ws + WS_SB) + (size_t)((((IS_ML ? 8 : 0) + sqi) * 32 + c) * 4 + h) * 256;
    LAS unsigned char* Qt = L + QT_OFF; LAS unsigned char* Kt = L + KT_OFF; LAS unsigned char* KhT = L + KHT_OFF; LAS unsigned char* VT = L + VT_OFF;
    LAS unsigned char* Sw = L + SW_OFF; LAS unsigned char* rawV = L + RAWV_OFF; LAS float* sm = (LAS float*)(L + SM_OFF);
    const int tt = w & 3, vb = w >> 2;
    LDS_BARRIER();
    if (IS_ML) { for (int i = tid; i < 16 * 72; i += 512) *(LAS unsigned short*)(VT + (128 * 72 + i) * 2) = (i < 72) ? (unsigned short)0x3F80 : (unsigned short)0; }
#pragma unroll
    for (int i = 0; i < 2; ++i) { const int pc = tid + 512 * i, r = pc >> 4, c8 = pc & 15;
        *(LAS u32x4*)(Qt + r * 272 + c8 * 16) = rq[i]; *(LAS u32x4*)(Kt + r * 272 + c8 * 16) = rk[i]; *(LAS u32x4*)(rawV + r * 256 + c8 * 16) = rv[i]; }
    if (IS_ML && w == 0) {
        const int t = lane; const float ig = gig, lf = glf;
        float a = lf;
#pragma unroll
        for (int o = 1; o < 64; o <<= 1) { const float x = __shfl_up(a, o); if (lane >= o) a += x; }
        const float g = ig - a; float cm = g;
#pragma unroll
        for (int o = 1; o < 64; o <<= 1) { const float x = __shfl_up(cm, o); if (lane >= o) cm = fmaxf(cm, x); }
        const float M63 = __shfl(cm, 63);
        sm[F_SG + t] = g; sm[F_SM + t] = cm; sm[F_SWEND + t] = __expf(g - M63);
        SB[64 + t] = cm; SB[128 + t] = a;
    }
    if (nsrc) {
#pragma unroll
        for (int i = 0; i < 2; ++i) { const int pc = tid + 512 * i, r = pc >> 4, c8 = pc & 15; const bf16_t* src = nsrc + (size_t)r * NPROJ + c8 * 8;
            rq[i] = *(const u32x4*)src; rk[i] = *(const u32x4*)(src + 512); rv[i] = *(const u32x4*)(src + 1024); }
        if (ngates && w == 0) { gig = ngates[lane * 8]; glf = ngates[lane * 8 + 4]; } }
    LDS_BARRIER();
    { const int k = tid & 127, part = tid >> 7; unsigned short kh[16];
        if (!IS_ML) {
            float lfv[16], cs[16]; float run = 0.f;
#pragma unroll
            for (int i = 0; i < 16; ++i) { lfv[i] = bf2f(*(const LAS unsigned short*)(Kt + (part * 16 + i) * 272 + k * 2)); run += lfv[i]; cs[i] = run; }
            sm[F_PTOT + part * 128 + k] = run;
            LDS_BARRIER();
            float pre = 0.f, tot = 0.f;
#pragma unroll
            for (int pp = 0; pp < 4; ++pp) { const float x = sm[F_PTOT + pp * 128 + k]; tot += x; if (pp < part) pre += x; }
            if (part == 0) SB[k] = __expf(tot);
#pragma unroll
            for (int i = 0; i < 16; ++i) { const int s = part * 16 + i; const float b = pre + cs[i], e = __expf(b), r = __builtin_amdgcn_rcpf(e), kk = 1.f - __expf(lfv[i]);
                LAS unsigned short* qp = (LAS unsigned short*)(Qt + s * 272 + k * 2); *qp = f2bf(bf2f(*qp) * e);
                *(LAS unsigned short*)(Kt + s * 272 + k * 2) = f2bf(kk * r); kh[i] = f2bf(kk * __expf(tot - b)); }
        } else {
#pragma unroll
            for (int i = 0; i < 16; ++i) { const int s = part * 16 + i; kh[i] = f2bf(bf2f(*(const LAS unsigned short*)(Kt + s * 272 + k * 2)) * sm[F_SWEND + s]); }
        }
        u32x4 w0, w1;
        w0.x = kh[0] | ((unsigned)kh[1] << 16); w0.y = kh[2] | ((unsigned)kh[3] << 16); w0.z = kh[4] | ((unsigned)kh[5] << 16); w0.w = kh[6] | ((unsigned)kh[7] << 16);
        w1.x = kh[8] | ((unsigned)kh[9] << 16); w1.y = kh[10] | ((unsigned)kh[11] << 16); w1.z = kh[12] | ((unsigned)kh[13] << 16); w1.w = kh[14] | ((unsigned)kh[15] << 16);
        *(LAS u32x4*)(KhT + k * 144 + part * 32) = w0; *(LAS u32x4*)(KhT + k * 144 + part * 32 + 16) = w1;
        unsigned short vv[16];
#pragma unroll
        for (int i = 0; i < 16; ++i) vv[i] = *(const LAS unsigned short*)(rawV + (part * 16 + i) * 256 + k * 2);
        w0.x = vv[0] | ((unsigned)vv[1] << 16); w0.y = vv[2] | ((unsigned)vv[3] << 16); w0.z = vv[4] | ((unsigned)vv[5] << 16); w0.w = vv[6] | ((unsigned)vv[7] << 16);
        w1.x = vv[8] | ((unsigned)vv[9] << 16); w1.y = vv[10] | ((unsigned)vv[11] << 16); w1.z = vv[12] | ((unsigned)vv[13] << 16); w1.w = vv[14] | ((unsigned)vv[15] << 16);
        *(LAS u32x4*)(VT + k * 144 + part * 32) = w0; *(LAS u32x4*)(VT + k * 144 + part * 32 + 16) = w1;
    }
    LDS_BARRIER();
    { const int pt = w >> 1;
#pragma unroll
        for (int e = 0; e < 2; ++e) { const int st = 2 * (w & 1) + e; f32x4 pa = (f32x4){0.f, 0.f, 0.f, 0.f};
            if (st <= pt) {
#pragma unroll
                for (int ks = 0; ks < 4; ++ks) pa = mfma16(ldfrag(Kt, 272, st * 16 + l15, ks * 32 + q4 * 8), ldfrag(Qt, 272, pt * 16 + l15, ks * 32 + q4 * 8), pa); }
            const int t = pt * 16 + l15, s0 = st * 16 + q4 * 4; const float Mt = IS_ML ? sm[F_SM + t] : 0.f;
#pragma unroll
            for (int j = 0; j < 4; ++j) { const int s = s0 + j; float x = pa[j]; if (IS_ML) x *= __expf(sm[F_SG + s] - Mt); pa[j] = (s <= t) ? x : 0.f; }
            *(LAS u32x2*)(Sw + t * 144 + s0 * 2) = pack4(pa); } }
#pragma unroll
    for (int i = 0; i < 2; ++i) { const int pc = tid + 512 * i;
        if (!IS_ML) { const int r = pc >> 4, c8 = pc & 15; *(u32x4*)(PROJ + (size_t)(row0 + r) * NPROJ + c8 * 8) = *(const LAS u32x4*)(Qt + r * 272 + c8 * 16); }
        const int k = pc >> 3, s8 = pc & 7; bf16_t* dst = PROJ + (size_t)(row0 + (k >> 1)) * NPROJ + (k & 1) * 64 + s8 * 8;
        *(u32x4*)(dst + 512) = *(const LAS u32x4*)(KhT + k * 144 + s8 * 16); *(u32x4*)(dst + 1024) = *(const LAS u32x4*)(VT + k * 144 + s8 * 16); }
    LDS_BARRIER();
    { bf16x8 bs[2];
#pragma unroll
        for (int ks = 0; ks < 2; ++ks) bs[ks] = ldfrag(Sw, 144, tt * 16 + l15, ks * 32 + q4 * 8);
#pragma unroll
        for (int i = 0; i < 5; ++i) if (i < 4 || (IS_ML && vb == 1)) { const int vt = i < 4 ? vb * 4 + i : 8; f32x4 o = (f32x4){0.f, 0.f, 0.f, 0.f};
#pragma unroll
            for (int ks = 0; ks < 2; ++ks) o = mfma16(ldfrag(VT, 144, vt * 16 + l15, ks * 32 + q4 * 8), bs[ks], o);
            const int t = tt * 16 + l15;
            if (i < 4) *(u32x2*)(AMIX + (size_t)(row0 + t) * DM + vt * 16 + q4 * 4) = pack4(o);
            else if (q4 == 0) SB[t] = o[0]; } }
}
constexpr int C_QT = 0, C_KHT = 17408, C_VT = 35840, C_ST0 = 56576, C_ST1 = 95744, C_SM = 134912;
constexpr int CF_WI = 0, CF_RHO = 64, CF_DEN = 128, CF_EMT = 192, CF_SCAL = 256, CF_SSSQ = 272;
template <bool IS_ML>
__device__ __forceinline__ void chain_run(const Params& p, LAS unsigned char* L, const int sqi, const int h, const bool write_out = true) {
    const int tid = threadIdx.x, w = __builtin_amdgcn_readfirstlane(tid >> 6), lane = tid & 63, l15 = lane & 15, q4 = lane >> 4;
    const int row0 = sqi * 2048;
    const bf16_t* PROJ = (const bf16_t*)(p.ws + WS_R1) + (IS_ML ? 2048 : 0) + h * 128;
    bf16_t* AMIX = (bf16_t*)p.out + (size_t)MROWS * DM + (IS_ML ? 512 : 0) + h * 128;
    const float* SB0 = (const float*)(p.ws + WS_SB) + (size_t)((((IS_ML ? 8 : 0) + sqi) * 32) * 4 + h) * 256;
    LAS unsigned char* Qt = L + C_QT; LAS unsigned char* KhT = L + C_KHT; LAS unsigned char* VT = L + C_VT; LAS float* sm = (LAS float*)(L + C_SM);
    constexpr int NV = IS_ML ? 9 : 8;
    const int tt = w & 3, vb = w >> 2, t = tt * 16 + l15;
    const size_t sbase = (size_t)(sqi * 4 + h) * 128 * 128;
    f32x4 sacc[NV];
#pragma unroll
    for (int vt = 0; vt < NV; ++vt) sacc[vt] = (f32x4){0.f, 0.f, 0.f, 0.f};
    float m_prev = 0.f;
    const float* gn = (IS_ML ? p.in[13] : p.in[10]) + h * 128;
    u32x4 rq[2], rk[2], rv[2]; u32x2 rin[4], rgt[4]; f32x4 dl = (f32x4){0.f, 0.f, 0.f, 0.f}; float s_den = 0.f, s_ml = 0.f, s_a = 0.f;
    auto prefetch_big = [&](int c) {
#pragma unroll
        for (int i = 0; i < 2; ++i) { const int pc = tid + 512 * i; const int r = pc >> 4, c8 = pc & 15;
            rq[i] = *(const u32x4*)(PROJ + (size_t)(row0 + c * 64 + r) * NPROJ + c8 * 8);
            const int k = pc >> 3, s8 = pc & 7; const bf16_t* src = PROJ + (size_t)(row0 + c * 64 + (k >> 1)) * NPROJ + (k & 1) * 64 + s8 * 8;
            rk[i] = *(const u32x4*)(src + 512); rv[i] = *(const u32x4*)(src + 1024); }
    };
    auto prefetch_io = [&](int c) {
        const size_t row = (size_t)row0 + c * 64 + t;
#pragma unroll
        for (int i = 0; i < 4; ++i) { const int v0 = (vb * 4 + i) * 16 + q4 * 4; rin[i] = *(const u32x2*)(AMIX + row * DM + v0); rgt[i] = *(const u32x2*)(PROJ + row * NPROJ + 1536 + v0); }
    };
    auto prefetch_sb = [&](int c, f32x4& dl_, float& d_, float& ml_, float& a_) {
        const float* sb = SB0 + (size_t)c * 1024;
        if (!IS_ML) dl_ = *(const f32x4*)(sb + w * 16 + q4 * 4);
        else if (w == 0) { d_ = sb[lane]; ml_ = sb[64 + lane]; a_ = sb[128 + lane]; }
    };
    prefetch_big(0); prefetch_io(0); prefetch_sb(0, dl, s_den, s_ml, s_a);
    LDS_BARRIER();
#pragma unroll
    for (int vt = 0; vt < NV; ++vt) *(LAS u32x2*)(L + C_ST0 + (vt * 16 + l15) * 272 + (w * 16 + q4 * 4) * 2) = (u32x2){0u, 0u};
    if (IS_ML) { for (int i = tid; i < 16 * 72; i += 512) *(LAS unsigned short*)(VT + (128 * 72 + i) * 2) = (i < 72) ? (unsigned short)0x3F80 : (unsigned short)0; }
    for (int c = 0; c < 32; ++c) {
        LAS unsigned char* STr = L + ((c & 1) ? C_ST1 : C_ST0); LAS unsigned char* STw = L + ((c & 1) ? C_ST0 : C_ST1);
#pragma unroll
        for (int i = 0; i < 2; ++i) { const int pc = tid + 512 * i; const int r = pc >> 4, c8 = pc & 15, k = pc >> 3, s8 = pc & 7;
            *(LAS u32x4*)(Qt + r * 272 + c8 * 16) = rq[i]; *(LAS u32x4*)(KhT + k * 144 + s8 * 16) = rk[i]; *(LAS u32x4*)(VT + k * 144 + s8 * 16) = rv[i]; }
        if (IS_ML && w == 0) {
            const float M = fmaxf(m_prev, s_ml), M63 = __shfl(M, 63), ml63 = __shfl(s_ml, 63), a63 = __shfl(s_a, 63);
            sm[CF_WI + lane] = __expf(m_prev - M); sm[CF_RHO + lane] = __expf(s_ml - M); sm[CF_DEN + lane] = s_den; sm[CF_EMT + lane] = __expf(-(s_a + M));
            if (lane == 0) { sm[CF_SCAL + 0] = __expf(m_prev - M63); sm[CF_SCAL + 1] = __expf(ml63 - M63); sm[CF_SCAL + 2] = a63 + M63; }
        }
        LDS_BARRIER();
        f32x4 ndl = dl; float n_den = 0.f, n_ml = 0.f, n_a = 0.f;
        if (c + 1 < 32) { prefetch_big(c + 1); prefetch_sb(c + 1, ndl, n_den, n_ml, n_a); }
        float wi_t = 1.f, rho_t = 1.f, denl_t = 0.f, emt_t = 0.f, fend = 1.f, sigma = 1.f;
        if (IS_ML) { wi_t = sm[CF_WI + t]; rho_t = sm[CF_RHO + t]; denl_t = sm[CF_DEN + t]; emt_t = sm[CF_EMT + t]; fend = sm[CF_SCAL + 0]; sigma = sm[CF_SCAL + 1]; m_prev = sm[CF_SCAL + 2]; }
        f32x4 oacc[5];
        { bf16x8 bq[4];
#pragma unroll
            for (int ks = 0; ks < 4; ++ks) bq[ks] = ldfrag(Qt, 272, tt * 16 + l15, ks * 32 + q4 * 8);
#pragma unroll
            for (int i = 0; i < 5; ++i) { oacc[i] = (f32x4){0.f, 0.f, 0.f, 0.f};
                if (i < 4 || IS_ML) { const int vt = i < 4 ? vb * 4 + i : 8;
#pragma unroll
                    for (int ks = 0; ks < 4; ++ks) oacc[i] = mfma16(ldfrag(STr, 272, vt * 16 + l15, ks * 32 + q4 * 8), bq[ks], oacc[i]); } } }
        { bf16x8 ak[2];
#pragma unroll
            for (int ks = 0; ks < 2; ++ks) ak[ks] = ldfrag(KhT, 144, w * 16 + l15, ks * 32 + q4 * 8);
#pragma unroll
            for (int vt = 0; vt < NV; ++vt) {
                if (!IS_ML) { sacc[vt] = sacc[vt] * dl;
#pragma unroll
                    for (int ks = 0; ks < 2; ++ks) sacc[vt] = mfma16(ak[ks], ldfrag(VT, 144, vt * 16 + l15, ks * 32 + q4 * 8), sacc[vt]); }
                else { f32x4 uacc = (f32x4){0.f, 0.f, 0.f, 0.f};
#pragma unroll
                    for (int ks = 0; ks < 2; ++ks) uacc = mfma16(ak[ks], ldfrag(VT, 144, vt * 16 + l15, ks * 32 + q4 * 8), uacc);
                    sacc[vt] = sacc[vt] * fend + uacc * sigma; }
                *(LAS u32x2*)(STw + (vt * 16 + l15) * 272 + (w * 16 + q4 * 4) * 2) = pack4(sacc[vt]); } }
        float inv = 1.f;
        if (IS_ML) { const float di = __shfl(oacc[4][0], l15); inv = 1.0f / fmaxf(fabsf(wi_t * di + rho_t * denl_t), emt_t); }
        float ss = 0.f;
#pragma unroll
        for (int i = 0; i < 4; ++i) { f32x4 in; in[0] = __uint_as_float(rin[i].x << 16); in[1] = __uint_as_float(rin[i].x & 0xffff0000u); in[2] = __uint_as_float(rin[i].y << 16); in[3] = __uint_as_float(rin[i].y & 0xffff0000u);
            if (IS_ML) oacc[i] = (oacc[i] * wi_t + in * rho_t) * inv; else oacc[i] = oacc[i] + in;
            ss += (oacc[i][0] * oacc[i][0] + oacc[i][1] * oacc[i][1]) + (oacc[i][2] * oacc[i][2] + oacc[i][3] * oacc[i][3]); }
        ss += __shfl_xor(ss, 16); ss += __shfl_xor(ss, 32);
        LAS float* sq = sm + CF_SSSQ + (c & 1) * 128;
        if (q4 == 0) sq[t * 2 + vb] = ss;
        LDS_BARRIER();
        { const float rs = rsqrtf((sq[t * 2] + sq[t * 2 + 1]) * (1.f / 128.f) + EPS); const size_t row = (size_t)row0 + c * 64 + t;
#pragma unroll
            for (int i = 0; i < 4; ++i) { const int v0 = (vb * 4 + i) * 16 + q4 * 4; const u32x2 gt = rgt[i];
                const f32x4 gv = *(const f32x4*)(gn + v0);
                f32x4 o; o[0] = oacc[i][0] * rs * gv[0] * __uint_as_float(gt.x << 16); o[1] = oacc[i][1] * rs * gv[1] * __uint_as_float(gt.x & 0xffff0000u);
                o[2] = oacc[i][2] * rs * gv[2] * __uint_as_float(gt.y << 16); o[3] = oacc[i][3] * rs * gv[3] * __uint_as_float(gt.y & 0xffff0000u);
                if (write_out) *(u32x2*)(AMIX + row * DM + v0) = pack4(o); } }
        if (c + 1 < 32) prefetch_io(c + 1);
        dl = ndl; s_den = n_den; s_ml = n_ml; s_a = n_a;
    }
    { float* So = p.out + (IS_ML ? O_CP : O_SP);
#pragma unroll
        for (int vt = 0; vt < 8; ++vt)
#pragma unroll
            for (int j = 0; j < 4; ++j) So[sbase + (size_t)(w * 16 + q4 * 4 + j) * 128 + vt * 16 + l15] = sacc[vt][j];
        if (IS_ML) { if (l15 == 0) { float* no = p.out + O_NP + (size_t)(sqi * 4 + h) * 128;
#pragma unroll
                for (int j = 0; j < 4; ++j) no[w * 16 + q4 * 4 + j] = sacc[NV - 1][j]; }
            if (tid == 0) p.out[O_MP + sqi * 4 + h] = m_prev; } }
}
#ifndef SAMPLE_TWICE
#define SAMPLE_TWICE 0
#endif
#ifndef SAMPLE_TWICE
#define SAMPLE_TWICE 0
#endif
#ifndef CHAIN_TWICE
#define CHAIN_TWICE 0
#endif
#ifndef NS_A
#define NS_A 256
#endif
__device__ __forceinline__ void sample_dispatch(const Params& p, LAS unsigned char* L, int j) {
    const int g = j >> 9, sqi = (j >> 2) & 127, h = j & 3;
    if (g == 0) mixer_item<false>(p, L, sqi, h, false); else mixer_item<true>(p, L, sqi, h, false);
}
__device__ __forceinline__ void phase2a(const Params& p, LAS unsigned char* L) {
    const int tid = threadIdx.x, lane = tid & 63, w = tid >> 6;
    u32x4 rq[2], rk[2], rv[2]; float gig = 0.f, glf = 0.f;
    auto slot = [&](int it) -> const bf16_t* { const int g = it >> 10, sqi = (it >> 7) & 7, c = (it >> 2) & 31, h = it & 3; return (const bf16_t*)(p.ws + WS_R1) + (size_t)(sqi * 2048 + c * 64) * NPROJ + (g ? 2048 : 0) + h * 128; };
    auto gptr = [&](int it) -> const float* { const int g = it >> 10, sqi = (it >> 7) & 7, c = (it >> 2) & 31, h = it & 3; return g ? (const float*)(p.ws + WS_GATES) + (size_t)(sqi * 2048 + c * 64) * 8 + h : nullptr; };
    int it = blockIdx.x;
    if (it < 2048) { const bf16_t* s0 = slot(it);
#pragma unroll
        for (int i = 0; i < 2; ++i) { const int pc = tid + 512 * i, r = pc >> 4, c8 = pc & 15; const bf16_t* src = s0 + (size_t)r * NPROJ + c8 * 8;
            rq[i] = *(const u32x4*)src; rk[i] = *(const u32x4*)(src + 512); rv[i] = *(const u32x4*)(src + 1024); }
        const float* g0 = gptr(it); if (g0 && w == 0) { gig = g0[lane * 8]; glf = g0[lane * 8 + 4]; } }
    for (; it < 2048; it += gridDim.x) { const int g = it >> 10, sqi = (it >> 7) & 7, c = (it >> 2) & 31, h = it & 3; const int nx = it + gridDim.x;
        const bf16_t* ns = nx < 2048 ? slot(nx) : nullptr; const float* ng = nx < 2048 ? gptr(nx) : nullptr;
        if (g == 0) prepass_item<false>(p, L, sqi, c, h, rq, rk, rv, gig, glf, ns, ng); else prepass_item<true>(p, L, sqi, c, h, rq, rk, rv, gig, glf, ns, ng); }
}
__device__ __forceinline__ void phase2a_samples(const Params& p, LAS unsigned char* L) {
    for (int it = 2048 + blockIdx.x; it < 2048 + NS_A; it += gridDim.x) { sample_dispatch(p, L, it - 2048); if (SAMPLE_TWICE) sample_dispatch(p, L, it - 2048); }
}
__device__ __forceinline__ void phase2b(const Params& p, LAS unsigned char* L) {
    const int G = gridDim.x, b = blockIdx.x;
    if (G > 64) {
        if (b < 64) { const int g = b >> 5, sqi = (b >> 2) & 7, h = b & 3; if (g == 0) chain_run<false>(p, L, sqi, h); else chain_run<true>(p, L, sqi, h);
            if (CHAIN_TWICE) { if (g == 0) chain_run<false>(p, L, sqi, h, false); else chain_run<true>(p, L, sqi, h, false); } }
        else for (int j = NS_A + (b - 64); j < 1024; j += G - 64) sample_dispatch(p, L, j);
    } else {
        for (int it = b; it < 64 + 1024 - NS_A; it += G) {
            if (it < 64) { const int g = it >> 5, sqi = (it >> 2) & 7, h = it & 3; if (g == 0) chain_run<false>(p, L, sqi, h); else chain_run<true>(p, L, sqi, h); }
            else sample_dispatch(p, L, NS_A + it - 64); }
    }
}
__device__ __forceinline__ void phase2_naive(const Params& p, unsigned char* shm) {
    float* sq = (float*)shm; float* sd = sq + 128; float* si = sd + 128; float* sv = si + 128; float* part = sv + 128; float* denp = part + 512; float* red = denp + 4;
    const int tid = threadIdx.x, v = tid & 127, kq = tid >> 7;
    const bf16_t* PROJ = (const bf16_t*)(p.ws + WS_R1); bf16_t* AMIX = (bf16_t*)p.out + (size_t)MROWS * DM; const float* GATES = (const float*)(p.ws + WS_GATES);
    for (int it = blockIdx.x; it < 1088; it += gridDim.x) {
        int g, sqi, h, T, row0; const bool prompt = it < 64;
        if (prompt) { g = it >> 5; sqi = (it >> 2) & 7; h = it & 3; T = 2048; row0 = sqi * 2048; }
        else { const int j = it - 64; g = j >> 9; sqi = (j >> 2) & 127; h = j & 3; T = 8; row0 = MPROMPT + sqi * 8; }
        float S[32], nst[32]; float mst = 0.f;
        const size_t sbase = ((size_t)(sqi * 4 + h) * 128) * 128;
#pragma unroll
        for (int i = 0; i < 32; ++i) { S[i] = 0.f; nst[i] = 0.f; }
        if (!prompt) { const float* S0 = g == 0 ? p.in[2] : p.in[3];
#pragma unroll
            for (int i = 0; i < 32; ++i) S[i] = S0[sbase + (size_t)(kq * 32 + i) * 128 + v];
            if (g == 1) { mst = p.in[5][sqi * 4 + h];
#pragma unroll
                for (int i = 0; i < 32; ++i) nst[i] = p.in[4][(size_t)(sqi * 4 + h) * 128 + kq * 32 + i]; } }
        const float* gn = (g == 0 ? p.in[10] : p.in[13]) + h * 128;
        for (int t = 0; t < T; ++t) {
            const size_t row = (size_t)row0 + t; const bf16_t* pr = PROJ + row * NPROJ + g * 2048 + h * 128;
            float m_new = 0.f;
            if (g == 0) {
                if (tid < 128) sq[tid] = bf2f(pr[tid]);
                else if (tid < 256) { const float f = __expf(bf2f(pr[512 + tid - 128])); sd[tid - 128] = f; si[tid - 128] = 1.f - f; }
                else if (tid < 384) sv[tid - 256] = bf2f(pr[1024 + tid - 256]);
            } else {
                const float ig = GATES[row * 8 + h], lf = GATES[row * 8 + 4 + h];
                m_new = fmaxf(lf + mst, ig); const float fd = __expf(lf + mst - m_new), ii = __expf(ig - m_new);
                if (tid < 128) sq[tid] = bf2f(pr[tid]);
                else if (tid < 256) { sd[tid - 128] = fd; si[tid - 128] = ii * bf2f(pr[512 + tid - 128]); }
                else if (tid < 384) sv[tid - 256] = bf2f(pr[1024 + tid - 256]);
            }
            __syncthreads();
            const float vv = sv[v]; float acc = 0.f, dacc = 0.f;
#pragma unroll
            for (int i = 0; i < 32; ++i) { const int k = kq * 32 + i; const float d = sd[k], ik = si[k], q = sq[k]; S[i] = d * S[i] + ik * vv; acc += q * S[i]; nst[i] = d * nst[i] + ik; dacc += q * nst[i]; }
            part[kq * 128 + v] = acc; if (v == 0) denp[kq] = dacc;
            __syncthreads();
            float o = 0.f;
            if (tid < 128) { o = (part[tid] + part[128 + tid]) + (part[256 + tid] + part[384 + tid]);
                if (g == 1) { const float den = (denp[0] + denp[1]) + (denp[2] + denp[3]); o = o / fmaxf(fabsf(den), __expf(-m_new)); }
                const float ss = wave_sum(o * o); if ((tid & 63) == 0) red[tid >> 6] = ss; }
            __syncthreads();
            if (tid < 128) { const float tot = red[0] + red[1]; const float gate = bf2f(pr[1536 + tid]);
                AMIX[row * DM + g * 512 + h * 128 + tid] = f2bf(o * rsqrtf(tot * (1.f / 128.f) + EPS) * gn[tid] * gate); }
            mst = m_new;
            __syncthreads();
        }
        float* So = p.out + (g == 0 ? (prompt ? O_SP : O_SS) : (prompt ? O_CP : O_CS));
#pragma unroll
        for (int i = 0; i < 32; ++i) So[sbase + (size_t)(kq * 32 + i) * 128 + v] = S[i];
        if (g == 1 && v == 0) { float* no = p.out + (prompt ? O_NP : O_NS) + (size_t)(sqi * 4 + h) * 128;
#pragma unroll
            for (int i = 0; i < 32; ++i) no[kq * 32 + i] = nst[i];
            if (kq == 0) p.out[(prompt ? O_MP : O_MS) + sqi * 4 + h] = mst; }
    }
}
__device__ __forceinline__ void phase5(const Params& p) {
    const float* UHL = (const float*)(p.ws + WS_UHL); const float* UHF = (const float*)(p.ws + WS_UHF); bf16_t* ACT = (bf16_t*)(p.ws + WS_R1 + R1_ACT);
    const float* cw = p.in[18]; const float* cbp = p.in[19];
    constexpr int NQ = DFF / 4;
    for (int i = blockIdx.x * 512 + threadIdx.x; i < 256 * 2 * NQ; i += gridDim.x * 512) {
        const int cq = i % NQ, j = (i / NQ) & 1, gi = i / (2 * NQ), c = 4 * cq; const int row = gi * 64 + j;
        const bool first = (gi & 31) == 0;
        const f32x4 z = (f32x4){0.f, 0.f, 0.f, 0.f};
        const f32x4 l0 = first ? z : *(const f32x4*)(UHL + (size_t)((gi - 1) * 2 + 0) * DFF + c), l1 = first ? z : *(const f32x4*)(UHL + (size_t)((gi - 1) * 2 + 1) * DFF + c);
        const f32x4 u0 = *(const f32x4*)(UHF + (size_t)((gi * 2 + 0) * 2) * DFF + c);
        const f32x4 uu = *(const f32x4*)(UHF + (size_t)((gi * 2 + j) * 2) * DFF + c), vv = *(const f32x4*)(UHF + (size_t)((gi * 2 + j) * 2 + 1) * DFF + c);
        const f32x4 p2 = j == 0 ? l0 : l1, p1 = j == 0 ? l1 : u0;
        const f32x4 w0 = *(const f32x4*)(cw + c), w1 = *(const f32x4*)(cw + DFF + c), w2 = *(const f32x4*)(cw + 2 * DFF + c), cb = *(const f32x4*)(cbp + c);
        float a[4];
#pragma unroll
        for (int e = 0; e < 4; ++e) a[e] = gelu_tanh(cb[e] + w0[e] * p2[e] + w1[e] * p1[e] + w2[e] * uu[e]) * vv[e];
        *(u32x2*)(ACT + (size_t)row * DFF + c) = (u32x2){cvt_pk_bf16(a[0], a[1]), cvt_pk_bf16(a[2], a[3])};
    }
}
__device__ __forceinline__ void phase7(const Params& p) {
    const float* ssq3 = (const float*)(p.ws + WS_SSQ3); const float* gf = p.in[21]; float* Y = p.out;
    const int wave = threadIdx.x >> 6, lane = threadIdx.x & 63;
    f32x4 g[4];
#pragma unroll
    for (int j = 0; j < 4; ++j) g[j] = *(const f32x4*)(gf + 4 * lane + 256 * j);
    for (int row = blockIdx.x * 8 + wave; row < MROWS; row += gridDim.x * 8) {
        const float rs = rsqrtf(ssq3[row] * (1.f / DM) + EPS);
#pragma unroll
        for (int j = 0; j < 4; ++j) { f32x4* q = (f32x4*)(Y + (size_t)row * DM + 4 * lane + 256 * j); *q = *q * rs * g[j]; }
    }
}
#define RUN(ph) (((PHMASK >> (ph)) & 1) && ph_lo <= (ph) && (ph) <= ph_hi)
#define SYNC(ph) do { if (ph_lo <= (ph) && (ph) < ph_hi) { if ((ph) == 0) grid.sync(); else xcd_barrier(xb); } } while (0)
#define TWICE(ph, body) do { body; if ((REPMASK >> (ph)) & 1) { grid.sync(); body; } } while (0)
__device__ __forceinline__ void run_p1(const Params& p, PG8_LAS unsigned char* lds) { bf16_t* H = (bf16_t*)p.out; bf16_t* PROJ = (bf16_t*)(p.ws + WS_R1);
    pg8::StaticOrder S; S.init(MROWS, NIN, gridDim.x, blockIdx.x); pg8::Gemm g{H, (const bf16_t*)(p.ws + WS_WIN), MROWS, NIN, DM};
    EpiInProj E{PROJ, p.in[9], (float*)(p.ws + WS_GATES), p.in[11], p.in[12]}; pg8::gemm_phase(lds, g, S, E); }
__device__ __forceinline__ void run_p3(const Params& p, PG8_LAS unsigned char* lds) { bf16_t* AMIX = (bf16_t*)p.out + (size_t)MROWS * DM; bf16_t* X1B = (bf16_t*)(p.ws + WS_R1 + R1_X1B); float* X1 = (float*)(p.ws + WS_X1);
    pg8::StaticOrder S; S.init(MROWS, DM, gridDim.x, blockIdx.x); pg8::Gemm g{AMIX, (const bf16_t*)(p.ws + WS_WOUT), MROWS, DM, DM};
    EpiResid E{p.in[0], p.in[1], X1, X1B, (float*)(p.ws + WS_SSQ2)}; pg8::gemm_phase(lds, g, S, E); }
__device__ __forceinline__ void run_p4(const Params& p, PG8_LAS unsigned char* lds) { bf16_t* X1B = (bf16_t*)(p.ws + WS_R1 + R1_X1B); bf16_t* ACT = (bf16_t*)(p.ws + WS_R1 + R1_ACT);
    pg8::StaticOrder S; S.init(MROWS, NGV, gridDim.x, blockIdx.x); pg8::Gemm g{X1B, (const bf16_t*)(p.ws + WS_WGV), MROWS, NGV, DM};
    EpiGateVal E{ACT, (const float*)(p.ws + WS_SSQ2), p.in[18], p.in[19], p.in[6], (float*)(p.ws + WS_UHL), (float*)(p.ws + WS_UHF), p.out + O_VP, p.out + O_VS}; pg8::gemm_phase(lds, g, S, E); }
__device__ __forceinline__ void run_p6(const Params& p, PG8_LAS unsigned char* lds) { bf16_t* ACT = (bf16_t*)(p.ws + WS_R1 + R1_ACT); float* X1 = (float*)(p.ws + WS_X1);
    pg8::StaticOrder S; S.init(MROWS, DM, gridDim.x, blockIdx.x); pg8::Gemm g{ACT, (const bf16_t*)(p.ws + WS_WD), MROWS, DM, DFF};
    EpiResid E{X1, X1 + (size_t)MPROMPT * DM, p.out, nullptr, (float*)(p.ws + WS_SSQ3)}; pg8::gemm_phase(lds, g, S, E); }
__global__ __launch_bounds__(512, 2) void fwd_kernel(Params p, int ph_lo, int ph_hi) {
    extern __shared__ __attribute__((aligned(16))) unsigned char shm[];
    PG8_LAS unsigned char* lds = (PG8_LAS unsigned char*)shm;
    cg::grid_group grid = cg::this_grid();
    volatile LAS unsigned* xst = (volatile LAS unsigned*)(lds + LDS_BYTES - 16);
    if (threadIdx.x == 0) { xst[0] = 0u; xst[1] = 0u; }
    __syncthreads();
    XcdBarrier xb = xcd_barrier_post((unsigned*)(p.ws + WS_BAR), xst);
    if (RUN(0)) TWICE(0, phase0(p, shm));
    SYNC(0);
    if (RUN(1)) TWICE(1, run_p1(p, lds));
    SYNC(1);
#if NAIVE_MIXER
    if (RUN(2)) phase2_naive(p, shm);
#else
    if (RUN(2)) { phase2a(p, lds); phase2a_samples(p, lds); xcd_barrier(xb); phase2b(p, lds); }
#endif
    SYNC(2);
    if (RUN(3)) run_p3(p, lds);
    SYNC(3);
    if (RUN(4)) TWICE(4, run_p4(p, lds));
    SYNC(4);
    if (RUN(5)) TWICE(5, phase5(p));
    SYNC(5);
    if (RUN(6)) run_p6(p, lds);
    SYNC(6);
    if (RUN(7)) phase7(p);
#if EXTRA_SYNCS
    for (int i = 0; i < EXTRA_SYNCS; ++i) xcd_barrier(xb);
#endif
}
extern "C" void kernel_launch(void* const* d_in, const int* in_sizes, int n_in, void* d_out, int out_size, void* d_ws, size_t ws_size, hipStream_t stream) {
    static int grid = 0;
    if (grid == 0) {
        if (n_in != 22 || ws_size < WS_END) { fprintf(stderr, "kernel_launch: unexpected n_in %d / ws_size %zu (need %zu)\n", n_in, ws_size, (size_t)WS_END); grid = -1; return; }
        int dev = 0, cus = 0, per_cu = 0;
        hipGetDevice(&dev); hipDeviceGetAttribute(&cus, hipDeviceAttributeMultiprocessorCount, dev);
        if (hipFuncSetAttribute((const void*)fwd_kernel, hipFuncAttributeMaxDynamicSharedMemorySize, LDS_BYTES) != hipSuccess) { fprintf(stderr, "kernel_launch: hipFuncSetAttribute failed\n"); grid = -1; return; }
        if (hipOccupancyMaxActiveBlocksPerMultiprocessor(&per_cu, (const void*)fwd_kernel, 512, LDS_BYTES) != hipSuccess || per_cu < 1) { fprintf(stderr, "kernel_launch: occupancy query says %d blocks per CU\n", per_cu); per_cu = 1; }
        (void)hipGetLastError();
        grid = cus;
        fprintf(stderr, "kernel_launch: cus %d per_cu %d grid %d ws %zu\n", cus, per_cu, grid, ws_size);
    }
    if (grid < 0) return;
    Params p{};
    for (int i = 0; i < 22; ++i) p.in[i] = (const float*)d_in[i];
    p.out = (float*)d_out; p.ws = (unsigned char*)d_ws;
    if (hipMemsetAsync((char*)d_ws + WS_BAR, 0, 16384, stream) != hipSuccess) { fprintf(stderr, "kernel_launch: memset of the barrier words failed\n"); return; }
#if ONE_LAUNCH
    int lo = 0, hi = 7; void* args[] = {&p, &lo, &hi};
    hipError_t e = hipLaunchCooperativeKernel((const void*)fwd_kernel, dim3(grid), dim3(512), args, LDS_BYTES, stream);
    if (e != hipSuccess) fprintf(stderr, "cooperative launch failed: %s (grid %d)\n", hipGetErrorString(e), grid);
#else
    for (int ph = 0; ph < 8; ++ph) hipLaunchKernelGGL(fwd_kernel, dim3(grid), dim3(512), LDS_BYTES, stream, p, ph, ph);
#endif
}
```

```cpp
#include <hip/hip_runtime.h>
#include <hip/hip_cooperative_groups.h>
#include <cstdio>
#include <cstdint>
namespace cg = cooperative_groups;
#ifndef ONE_LAUNCH
#define ONE_LAUNCH 1
#endif
#ifndef PHMASK
#define PHMASK 255
#endif
#ifndef NAIVE_MIXER
#define NAIVE_MIXER 0
#endif
#ifndef REPMASK
#define REPMASK 0
#endif
#ifndef EXTRA_SYNCS
#define EXTRA_SYNCS 0
#endif
namespace pg8 {
#define PG8_LAS __attribute__((address_space(3)))
typedef unsigned short bf16_t;
typedef short bf16x8 __attribute__((ext_vector_type(8)));
typedef float f32x4 __attribute__((ext_vector_type(4)));
typedef unsigned u32x4 __attribute__((ext_vector_type(4)));
constexpr int BM = 256, BK = 64, HALF = 128, HTB = HALF * BK * 2  , STAGE_BYTES = 8 * HTB, NXCD = 8, WGM = 8;

__host__ __device__ __forceinline__ int lds_byte(int r, int c) { const int st = (r >> 4) * 2 + (c >> 5), rr = r & 15, cc = c & 31, ob = rr * 64 + cc * 2; return st * 1024 + (ob ^ (((ob >> 9) & 1) << 5)); }
__host__ __device__ __forceinline__ void stage_rc(int b, int& R, int& C) { const int st = b / 1024, sb = b % 1024, swz = sb ^ (((sb >> 9) & 1) << 5); R = (st >> 1) * 16 + swz / 64; C = (st & 1) * 32 + (swz % 64) / 2; }
__host__ __device__ __forceinline__ int perm32(int rho) { const int n = rho >> 4, i = rho & 15; return 8 * (i >> 2) + 4 * n + (i & 3); }

struct Unit { int pm, pn, k0, nt; };
struct Gemm { const bf16_t* A; const bf16_t* Bt; int M, N, K; };

struct StaticOrder {
    int nM, nN, nwg, G, c, ntK;
    __host__ __device__ void init(int M, int N, int G_, int c_, int K_ = 1024) { nM = M / BM; nN = N / BM; nwg = nM * nN; G = G_; c = c_; ntK = K_ / BK; }
    __host__ __device__ bool next(int i, Unit& u) const {
        const long L = (long)i * G + c; if (L >= nwg) return false;
        int wgid = (int)L; { const int q = nwg / NXCD, r = nwg % NXCD, xcd = wgid % NXCD, off = wgid / NXCD; wgid = (xcd < r ? xcd * (q + 1) : r * (q + 1) + (xcd - r) * q) + off; }
        const int nig = WGM * nN, gid = wgid / nig, fm = gid * WGM, gsz = (nM - fm) < WGM ? (nM - fm) : WGM;
        u.pm = fm + ((wgid % nig) % gsz); u.pn = (wgid % nig) / gsz; u.k0 = 0; u.nt = ntK; return true;
    }
    __device__ __forceinline__ void a_ready(const Unit&) const {}
    __device__ __forceinline__ void done(const Unit&) const {}
};

typedef float f32x2_t __attribute__((ext_vector_type(2)));
typedef __bf16 bf16x2_t __attribute__((ext_vector_type(2)));
__device__ __forceinline__ unsigned cvt_pk_bf16(float lo, float hi) { const f32x2_t v = {lo, hi}; return __builtin_bit_cast(unsigned, __builtin_convertvector(v, bf16x2_t)); }
template <class Epi, class Sched>
__device__ __forceinline__ void gemm_phase(PG8_LAS unsigned char* lds, const Gemm g, const Sched& S, const Epi& E) {
    const int tid = threadIdx.x, wid = __builtin_amdgcn_readfirstlane(tid >> 6), lane = tid & 63, wr = wid >> 2, wc = wid & 3, fr = lane & 15, fq = lane >> 4;
    const int K = g.K;
    unsigned voffA[2], voffB[2];
#pragma unroll
    for (int i = 0; i < 2; ++i) { int R, C; stage_rc(tid * 16 + i * 8192, R, C); const int Rb = Epi::PERM ? ((R & ~31) + perm32(R & 31)) : R;
        voffA[i] = (unsigned)(R * K + C) * 2u; voffB[i] = (unsigned)(Rb * K + C) * 2u; }
    const size_t kstep = (size_t)(BK * 2);
    const size_t hstep = (size_t)HALF * K * 2;
    const size_t tstep = 2 * hstep;
    const unsigned ldsw = (unsigned)wid * 1024u;
    const int aoff = lds_byte(wr * 64 + fr, fq * 8), boff = lds_byte(wc * 32 + fr, fq * 8);
#define PG8_SA(b, h) (((b) * 2 + (h)) * HTB)
#define PG8_SB(b, h) ((4 + (b) * 2 + (h)) * HTB)
#define PG8_STAGE(bufoff, gbase, voff) do { _Pragma("unroll") for (int _i = 0; _i < 2; ++_i) \
        __builtin_amdgcn_global_load_lds((const unsigned*)((const char*)(gbase) + (voff)[_i]), (PG8_LAS unsigned*)(lds + (bufoff) + ldsw + _i * 8192), 16, 0, 0); } while (0)
#define PG8_LDA(dst, b, h) do { _Pragma("unroll") for (int m = 0; m < 4; ++m) _Pragma("unroll") for (int k = 0; k < 2; ++k) dst[m][k] = *(const PG8_LAS bf16x8*)(lds + PG8_SA(b, h) + aoff + m * 2048 + k * 1024); } while (0)
#define PG8_LDB(dst, b, h) do { _Pragma("unroll") for (int n = 0; n < 2; ++n) _Pragma("unroll") for (int k = 0; k < 2; ++k) dst[n][k] = *(const PG8_LAS bf16x8*)(lds + PG8_SB(b, h) + boff + n * 2048 + k * 1024); } while (0)
#define PG8_MMA(ai, bj, At, Bt) do { __builtin_amdgcn_s_setprio(1); _Pragma("unroll") for (int m = 0; m < 4; ++m) _Pragma("unroll") for (int n = 0; n < 2; ++n) _Pragma("unroll") for (int k = 0; k < 2; ++k) \
        acc[ai][bj][m][n] = __builtin_amdgcn_mfma_f32_16x16x32_bf16(Bt[n][k], At[m][k], acc[ai][bj][m][n], 0, 0, 0); __builtin_amdgcn_s_setprio(0); } while (0)
#define PG8_WAIT_V(n) asm volatile("s_waitcnt vmcnt(" #n ")" ::: "memory")
#define PG8_WAIT_L(n) asm volatile("s_waitcnt lgkmcnt(" #n ")" ::: "memory")
#define PG8_BAR __builtin_amdgcn_s_barrier()
#define PG8_SCHED __builtin_amdgcn_sched_barrier(0)
    Unit cur, nxt; int ui = 0;
    if (!S.next(0, cur)) return;
    f32x4 acc[2][2][4][2];
#pragma unroll
    for (int a = 0; a < 2; ++a)
#pragma unroll
        for (int b = 0; b < 2; ++b)
#pragma unroll
            for (int m = 0; m < 4; ++m)
#pragma unroll
                for (int n = 0; n < 2; ++n) acc[a][b][m][n] = (f32x4){0.f, 0.f, 0.f, 0.f};
    bf16x8 At[4][2], B0[2][2], B1[2][2];
    const char* cA = (const char*)g.A + (size_t)cur.pm * tstep + (size_t)cur.k0 * 2; const char* cB = (const char*)g.Bt + (size_t)cur.pn * tstep + (size_t)cur.k0 * 2;
    S.a_ready(cur);
    PG8_STAGE(PG8_SB(0, 0), cB, voffB); PG8_STAGE(PG8_SA(0, 0), cA, voffA); PG8_STAGE(PG8_SB(0, 1), cB + hstep, voffB); PG8_STAGE(PG8_SA(0, 1), cA + hstep, voffA);
    if (wr == 1) PG8_BAR;
    PG8_WAIT_V(4); PG8_BAR;
    PG8_STAGE(PG8_SB(1, 0), cB + kstep, voffB); PG8_STAGE(PG8_SA(1, 0), cA + kstep, voffA); PG8_STAGE(PG8_SB(1, 1), cB + hstep + kstep, voffB);
    PG8_WAIT_V(6); PG8_BAR;
    for (;;) {
        const bool has_next = S.next(ui + 1, nxt);
        const char* nA = has_next ? (const char*)g.A + (size_t)nxt.pm * tstep + (size_t)nxt.k0 * 2 : cA; const char* nB = has_next ? (const char*)g.Bt + (size_t)nxt.pn * tstep + (size_t)nxt.k0 * 2 : cB;
        const int nt = cur.nt;
        for (int t = 0; t < nt; t += 2) {
            const bool last = (t == nt - 2);
            const char* a1 = cA + (size_t)(t + 1) * kstep;
            const char* a2 = last ? nA : cA + (size_t)(t + 2) * kstep; const char* b2 = last ? nB : cB + (size_t)(t + 2) * kstep;
            const char* a3 = a2 + kstep; const char* b3 = b2 + kstep;
            if (last && has_next) S.a_ready(nxt);
            PG8_LDB(B0, 0, 0); PG8_SCHED; PG8_LDA(At, 0, 0); PG8_STAGE(PG8_SA(1, 1), a1 + hstep, voffA);
            PG8_WAIT_L(8); PG8_BAR; PG8_WAIT_L(0); PG8_MMA(0, 0, At, B0); PG8_BAR; PG8_SCHED;
            PG8_LDB(B1, 0, 1); PG8_STAGE(PG8_SB(0, 0), b2, voffB);
            PG8_BAR; PG8_WAIT_L(0); PG8_MMA(0, 1, At, B1); PG8_BAR;
            PG8_LDA(At, 0, 1); PG8_STAGE(PG8_SA(0, 0), a2, voffA);
            PG8_BAR; PG8_WAIT_L(0); PG8_MMA(1, 0, At, B0); PG8_BAR; PG8_SCHED;
            PG8_STAGE(PG8_SB(0, 1), b2 + hstep, voffB);
            PG8_WAIT_V(6); PG8_BAR; PG8_MMA(1, 1, At, B1); PG8_BAR;
            PG8_LDB(B0, 1, 0); PG8_SCHED; PG8_LDA(At, 1, 0); PG8_STAGE(PG8_SA(0, 1), a2 + hstep, voffA);
            PG8_WAIT_L(8); PG8_BAR; PG8_WAIT_L(0); PG8_MMA(0, 0, At, B0); PG8_BAR; PG8_SCHED;
            PG8_LDB(B1, 1, 1); PG8_STAGE(PG8_SB(1, 0), b3, voffB);
            PG8_BAR; PG8_WAIT_L(0); PG8_MMA(0, 1, At, B1); PG8_BAR;
            PG8_LDA(At, 1, 1); PG8_STAGE(PG8_SA(1, 0), a3, voffA);
            PG8_BAR; PG8_WAIT_L(0); PG8_MMA(1, 0, At, B0); PG8_BAR; PG8_SCHED;
            PG8_STAGE(PG8_SB(1, 1), b3 + hstep, voffB);
            PG8_WAIT_V(6); PG8_BAR; PG8_MMA(1, 1, At, B1); PG8_BAR;
        }
        if constexpr (!Epi::AFTER_DRAIN) { E(acc, cur, wr, wc, fr, fq); S.done(cur); }
        if (!has_next) break;
#pragma unroll
        for (int a = 0; a < 2; ++a)
#pragma unroll
            for (int b = 0; b < 2; ++b)
#pragma unroll
                for (int m = 0; m < 4; ++m)
#pragma unroll
                    for (int n = 0; n < 2; ++n) acc[a][b][m][n] = (f32x4){0.f, 0.f, 0.f, 0.f};
        cur = nxt; cA = nA; cB = nB; ++ui;
    }
    PG8_WAIT_V(0);
    if (wr == 0) PG8_BAR;
    PG8_BAR;
    if constexpr (Epi::AFTER_DRAIN) { E.fused(acc, cur, wr, wc, fr, fq, lds, wid, lane); S.done(cur); }
#undef PG8_SA
#undef PG8_SB
#undef PG8_STAGE
#undef PG8_LDA
#undef PG8_LDB
#undef PG8_MMA
#undef PG8_WAIT_V
#undef PG8_WAIT_L
#undef PG8_BAR
#undef PG8_SCHED
}

}
#define XB_TMO      128
#define XB_XCNT(j)  (256  + 64 * (j))
#define XB_XSUB(j)  (1280 + 64 * (j))
#define XB_XGEN(j)  (2304 + 64 * (j))
#define XB_TOP      3328
#define XB_TOPGEN   3392
#define XCD_BAR_WORDS 3456
#define XB_SPIN_CAP (1u << 18)
#ifndef LAS
#define LAS __attribute__((address_space(3)))
#endif

__device__ __forceinline__ unsigned xb_ld(unsigned* p)              { return __hip_atomic_load(p, __ATOMIC_RELAXED, __HIP_MEMORY_SCOPE_AGENT); }
__device__ __forceinline__ unsigned xb_add(unsigned* p, unsigned v) { return __hip_atomic_fetch_add(p, v, __ATOMIC_RELAXED, __HIP_MEMORY_SCOPE_AGENT); }
__device__ __forceinline__ unsigned xb_xcc_id() { return (unsigned)__builtin_amdgcn_s_getreg((3 << 11) | 20) & 0xFu; }
#define XB_SPIN(cond, bar) do { unsigned _sp = 0; while (cond) { __builtin_amdgcn_s_sleep(1); \
    if ((++_sp & 255u) == 0u) { if (xb_ld(&(bar)[XB_TMO])) break; if (_sp > XB_SPIN_CAP) { atomicAdd(&(bar)[XB_TMO], 1u); break; } } } } while (0)

struct XcdBarrier {
    unsigned* bar; unsigned x;
    volatile LAS unsigned* st;
};

__device__ __forceinline__ XcdBarrier xcd_barrier_post(unsigned* bar, volatile LAS unsigned* st) {
    XcdBarrier b; b.bar = bar; b.x = xb_xcc_id(); b.st = st;
    if (threadIdx.x == 0) (void)xb_add(&bar[XB_XCNT(b.x)], 1u);
    return b;
}
__device__ __forceinline__ void xcd_barrier_complete(unsigned* bar, unsigned x, unsigned& nloc, unsigned& nx) {
    const unsigned G = gridDim.x * gridDim.y * gridDim.z;
    unsigned sum, cnt, mine, sp = 0u;
    for (;;) {
        sum = 0u; cnt = 0u; mine = 0u;
#pragma unroll
        for (unsigned j = 0; j < 16; ++j) { const unsigned c = xb_ld(&bar[XB_XCNT(j)]); sum += c; cnt += (c > 0u) ? 1u : 0u; mine = (j == x) ? c : mine; }
        if (sum == G) break;
        __builtin_amdgcn_s_sleep(1);
        if ((++sp & 255u) == 0u) { if (xb_ld(&bar[XB_TMO])) break; if (sp > XB_SPIN_CAP) { atomicAdd(&bar[XB_TMO], 1u); break; } }
    }
    nloc = mine > 0u ? mine : 1u; nx = cnt > 0u ? cnt : 1u;
}

__device__ __forceinline__ void xcd_barrier(const XcdBarrier& b) {
    asm volatile("s_waitcnt vmcnt(0)" ::: "memory");
    __syncthreads();
    if (threadIdx.x == 0) {
        unsigned* bar = b.bar;
        __builtin_amdgcn_s_waitcnt(0);
        unsigned nloc = b.st[0], nx = b.st[1];
        if (nloc == 0u) { xcd_barrier_complete(bar, b.x, nloc, nx); b.st[0] = nloc; b.st[1] = nx; }
        const unsigned old = xb_add(&bar[XB_XSUB(b.x)], 1u);
        const unsigned gen = old / nloc;
        if (old + 1u == (gen + 1u) * nloc) {
            __builtin_amdgcn_fence(__ATOMIC_RELEASE, "agent");
            asm volatile("s_waitcnt vmcnt(0)" ::: "memory");
            const unsigned og = xb_add(&bar[XB_TOP], 1u);
            const unsigned tg = og / nx;
            if (og + 1u == (tg + 1u) * nx) xb_add(&bar[XB_TOPGEN], 1u);
            else XB_SPIN(xb_ld(&bar[XB_TOPGEN]) == tg, bar);
            __builtin_amdgcn_fence(__ATOMIC_ACQUIRE, "agent");
            xb_add(&bar[XB_XGEN(b.x)], 1u);
            asm volatile("s_waitcnt vmcnt(0)" ::: "memory");
        } else {
            XB_SPIN(xb_ld(&bar[XB_XGEN(b.x)]) == gen, bar);
            __builtin_amdgcn_fence(__ATOMIC_ACQUIRE, "agent");
            asm volatile("s_waitcnt vmcnt(0)" ::: "memory");
        }
    }
    __syncthreads();
}

using pg8::bf16_t; using pg8::f32x4; using pg8::u32x4; using pg8::Unit; using pg8::cvt_pk_bf16;
typedef unsigned u32x2 __attribute__((ext_vector_type(2)));
constexpr int DM = 1024, MROWS = 17408, MPROMPT = 16384, NPROJ = 4096, INCOLS = 4104, DFF = 2816, NGV = 5632;
constexpr float EPS = 1e-6f;
constexpr size_t O_Y = 0, O_SP = 17825792, O_SS = 18350080, O_CP = 26738688, O_CS = 27262976, O_NP = 35651584, O_NS = 35655680,
                 O_MP = 35721216, O_MS = 35721248, O_VP = 35721760, O_VS = 35766816;
constexpr int NIN = 4352;
constexpr size_t WS_CTL = 0, WS_WIN = 4096, WS_WOUT = WS_WIN + (size_t)NIN * 1024 * 2, WS_WGV = WS_WOUT + 1024 * 1024 * 2, WS_WD = WS_WGV + 5632 * 1024 * 2,
                 WS_GATES = WS_WD + 1024 * 2816 * 2, WS_SSQ2 = WS_GATES + 17408 * 32, WS_SSQ3 = WS_SSQ2 + 17408 * 4, WS_UHL = WS_SSQ3 + 17408 * 4, WS_UHF = WS_UHL + 256 * 2 * 2816 * 4,
                 WS_X1 = WS_UHF + 256 * 4 * 2816 * 4, WS_R1 = WS_X1 + (size_t)17408 * 1024 * 4, WS_BAR = WS_R1 + (size_t)17408 * 4096 * 2, WS_END = WS_BAR + 16384;
static_assert(WS_END <= 268435456, "workspace budget");
constexpr size_t R1_X1B = 1048576, R1_ACT = 36700160 + 1048576;
constexpr int LDS_BYTES = 160 * 1024 - 2048;

struct Params { const float* in[22]; float* out; unsigned char* ws; };

__device__ __forceinline__ float bf2f(unsigned short b) { return __uint_as_float(((unsigned)b) << 16); }
__device__ __forceinline__ unsigned short f2bf(float f) { unsigned u = __float_as_uint(f); u += 0x7fffu + ((u >> 16) & 1u); return (unsigned short)(u >> 16); }
__device__ __forceinline__ float wave_sum(float v) {
#pragma unroll
    for (int o = 1; o < 64; o <<= 1) v += __shfl_xor(v, o);
    return v;
}
__device__ __forceinline__ float sigmoidf_(float x) { return __builtin_amdgcn_rcpf(1.0f + __expf(-x)); }

__device__ __forceinline__ void p0_transpose_item(const float* W, int ldw, int K, bf16_t* WT, int drow0, int k0, int n0, int nmax, const float* kscale, float* scr, int lane) {
    const int ncol = min(n0 + (lane & 31), nmax);
    float v[32];
#pragma unroll
    for (int i = 0; i < 32; ++i) v[i] = W[(size_t)(k0 + 2 * i + (lane >> 5)) * ldw + ncol];
    if (kscale) {
#pragma unroll
        for (int i = 0; i < 32; ++i) v[i] *= kscale[k0 + 2 * i + (lane >> 5)]; }
#pragma unroll
    for (int i = 0; i < 32; ++i) scr[(2 * i + (lane >> 5)) * 33 + (lane & 31)] = v[i];
    asm volatile("s_waitcnt lgkmcnt(0)" ::: "memory");
    const int c = lane & 7;
#pragma unroll
    for (int j = 0; j < 4; ++j) { const int n = (lane >> 3) + 8 * j; const float* s = scr + (8 * c) * 33 + n;
        u32x4 o; o.x = cvt_pk_bf16(s[0 * 33], s[1 * 33]); o.y = cvt_pk_bf16(s[2 * 33], s[3 * 33]); o.z = cvt_pk_bf16(s[4 * 33], s[5 * 33]); o.w = cvt_pk_bf16(s[6 * 33], s[7 * 33]);
        *(u32x4*)(WT + (size_t)(drow0 + n) * K + k0 + 8 * c) = o; }
    asm volatile("s_waitcnt lgkmcnt(0)" ::: "memory");
}

__device__ __forceinline__ void phase0(const Params& p, unsigned char* shm) {
    const int tid = threadIdx.x, wave = tid >> 6, lane = tid & 63;
    float* scr = (float*)(shm + wave * 8704);
    const int gw = blockIdx.x * 8 + wave, NGW = gridDim.x * 8;
    bf16_t* WinT = (bf16_t*)(p.ws + WS_WIN); bf16_t* WoutT = (bf16_t*)(p.ws + WS_WOUT); bf16_t* WgvT = (bf16_t*)(p.ws + WS_WGV); bf16_t* WdT = (bf16_t*)(p.ws + WS_WD);
    { float* z = (float*)(p.ws + WS_SSQ2); for (int i = blockIdx.x * 512 + tid; i < 2 * MROWS; i += gridDim.x * 512) z[i] = 0.f; }
    if (blockIdx.x == 0 && tid < 64) ((unsigned*)(p.ws + WS_CTL))[tid] = 0u;
    bf16_t* H = (bf16_t*)p.out;
    {   f32x4 g1[4];
#pragma unroll
        for (int j = 0; j < 4; ++j) g1[j] = *(const f32x4*)(p.in[7] + 4 * lane + 256 * j);
        int row = gw; f32x4 v[4];
        if (row < MROWS) { const float* xr = row < MPROMPT ? p.in[0] + (size_t)row * DM : p.in[1] + (size_t)(row - MPROMPT) * DM;
#pragma unroll
            for (int j = 0; j < 4; ++j) v[j] = *(const f32x4*)(xr + 4 * lane + 256 * j); }
        while (row < MROWS) {
            const int nrow = row + NGW; f32x4 nv[4];
#pragma unroll
            for (int j = 0; j < 4; ++j) nv[j] = (f32x4){0.f, 0.f, 0.f, 0.f};
            if (nrow < MROWS) { const float* xr = nrow < MPROMPT ? p.in[0] + (size_t)nrow * DM : p.in[1] + (size_t)(nrow - MPROMPT) * DM;
#pragma unroll
                for (int j = 0; j < 4; ++j) nv[j] = *(const f32x4*)(xr + 4 * lane + 256 * j); }
            float s = 0.f;
#pragma unroll
            for (int j = 0; j < 4; ++j) s += (v[j].x * v[j].x + v[j].y * v[j].y) + (v[j].z * v[j].z + v[j].w * v[j].w);
            const float rs = rsqrtf(wave_sum(s) * (1.f / DM) + EPS);
#pragma unroll
            for (int j = 0; j < 4; ++j) { const f32x4 o = v[j] * rs * g1[j];
                *(u32x2*)(H + (size_t)row * DM + 4 * lane + 256 * j) = (u32x2){cvt_pk_bf16(o.x, o.y), cvt_pk_bf16(o.z, o.w)}; }
#pragma unroll
            for (int j = 0; j < 4; ++j) v[j] = nv[j];
            row = nrow;
        }
    }
    constexpr int I_IN = 16 * 129, I_OUT = 16 * 32, I_G = 16 * 88, I_D = 44 * 32, NIT = I_IN + I_OUT + 2 * I_G + I_D;
    for (int it = gw; it < NIT; it += NGW) {
        int r = it;
        if (r < I_IN) { const int kb = r / 129, nb = r % 129; p0_transpose_item(p.in[8], INCOLS, DM, WinT, 32 * nb, 64 * kb, 32 * nb, INCOLS - 1, nullptr, scr, lane); continue; } r -= I_IN;
        if (r < I_OUT) { const int kb = r / 32, nb = r % 32; p0_transpose_item(p.in[14], DM, DM, WoutT, 32 * nb, 64 * kb, 32 * nb, DM - 1, nullptr, scr, lane); continue; } r -= I_OUT;
        if (r < I_G) { const int kb = r / 88, nb = r % 88, n0 = 32 * nb; p0_transpose_item(p.in[16], DFF, DM, WgvT, 256 * (n0 >> 7) + (n0 & 127), 64 * kb, n0, DFF - 1, p.in[15], scr, lane); continue; } r -= I_G;
        if (r < I_G) { const int kb = r / 88, nb = r % 88, n0 = 32 * nb; p0_transpose_item(p.in[17], DFF, DM, WgvT, 256 * (n0 >> 7) + 128 + (n0 & 127), 64 * kb, n0, DFF - 1, p.in[15], scr, lane); continue; } r -= I_G;
        { const int kb = r / 32, nb = r % 32; p0_transpose_item(p.in[20], DM, DFF, WdT, 32 * nb, 64 * kb, 32 * nb, DM - 1, nullptr, scr, lane); }
    }
}
struct EpiInProj {
    static constexpr bool PERM = true, AFTER_DRAIN = false;
    bf16_t* O; const float* lbl; float* gates; const float* b_ig; const float* b_fg;
    __device__ __forceinline__ void operator()(const f32x4 (&acc)[2][2][4][2], const Unit& u, int wr, int wc, int fr, int fq) const {
        const int seg = u.pn >> 1, row0 = u.pm * 256 + wr * 64 + fr, col0 = u.pn * 256 + wc * 32 + 8 * fq;
        if (seg == 8) {
            if (wc == 0 && fq == 0) {
                float bi[4], bf_[4];
#pragma unroll
                for (int e = 0; e < 4; ++e) { bi[e] = b_ig[e]; bf_[e] = b_fg[e]; }
#pragma unroll
                for (int ai = 0; ai < 2; ++ai)
#pragma unroll
                    for (int m = 0; m < 4; ++m) { float* gp = gates + (size_t)(row0 + ai * 128 + m * 16) * 8; f32x4 a = acc[ai][0][m][0], b = acc[ai][0][m][1];
#pragma unroll
                        for (int e = 0; e < 4; ++e) { a[e] += bi[e]; const float z = b[e] + bf_[e]; b[e] = z > 0.f ? -log1pf(__expf(-z)) : z - log1pf(__expf(z)); }
                        *(f32x4*)gp = a; *(f32x4*)(gp + 4) = b; }
            }
            return;
        }
        float lb[2][8];
        if (seg == 1) {
#pragma unroll
            for (int bj = 0; bj < 2; ++bj)
#pragma unroll
                for (int e = 0; e < 8; ++e) { const int c = col0 + bj * 128 + e - 512; lb[bj][e] = __builtin_amdgcn_rcpf(1.0f + __expf(lbl[512 + c] - lbl[c])); }
        }
#pragma unroll
        for (int ai = 0; ai < 2; ++ai)
#pragma unroll
            for (int m = 0; m < 4; ++m) { bf16_t* rowp = O + (size_t)(row0 + ai * 128 + m * 16) * NPROJ + col0;
#pragma unroll
                for (int bj = 0; bj < 2; ++bj) { float v[8];
#pragma unroll
                    for (int e = 0; e < 8; ++e) v[e] = acc[ai][bj][m][e >> 2][e & 3];
                    if (seg == 1) {
#pragma unroll
                        for (int e = 0; e < 8; ++e) v[e] = __logf(lb[bj][e] + (1.0f - lb[bj][e]) * sigmoidf_(v[e]));
                    } else if (seg == 3) {
#pragma unroll
                        for (int e = 0; e < 8; ++e) v[e] = v[e] * sigmoidf_(v[e]);
                    } else if (seg == 5) {
#pragma unroll
                        for (int e = 0; e < 8; ++e) v[e] = v[e] * 0.08838834764831845f;
                    } else if (seg == 7) {
#pragma unroll
                        for (int e = 0; e < 8; ++e) v[e] = sigmoidf_(v[e]);
                    }
                    u32x4 w; w.x = cvt_pk_bf16(v[0], v[1]); w.y = cvt_pk_bf16(v[2], v[3]); w.z = cvt_pk_bf16(v[4], v[5]); w.w = cvt_pk_bf16(v[6], v[7]);
                    *(u32x4*)(rowp + bj * 128) = w; } }
    }
};
struct EpiResid {
    static constexpr bool PERM = true, AFTER_DRAIN = false;
    const float* base_p; const float* base_s;
    float* out; bf16_t* outb; float* ssq; float* part;
    __device__ __forceinline__ void operator()(const f32x4 (&acc)[2][2][4][2], const Unit& u, int wr, int wc, int fr, int fq) const {
        const int row0 = u.pm * 256 + wr * 64 + fr, col0 = u.pn * 256 + wc * 32 + 8 * fq;
        if (part && u.pm >= 64) { float* pp = part + (size_t)(u.k0 / 384) * (1024 * DM) - (size_t)MPROMPT * DM;
#pragma unroll
            for (int ai = 0; ai < 2; ++ai)
#pragma unroll
                for (int m = 0; m < 4; ++m) { const size_t off = (size_t)(row0 + ai * 128 + m * 16) * DM + col0;
#pragma unroll
                    for (int bj = 0; bj < 2; ++bj) { *(f32x4*)(pp + off + bj * 128) = acc[ai][bj][m][0]; *(f32x4*)(pp + off + bj * 128 + 4) = acc[ai][bj][m][1]; } }
            return; }
        const float* base = u.pm < 64 ? base_p : base_s - (size_t)MPROMPT * DM;
#pragma unroll
        for (int ai = 0; ai < 2; ++ai)
#pragma unroll
            for (int m = 0; m < 4; ++m) { const int row = row0 + ai * 128 + m * 16; const size_t off = (size_t)row * DM + col0; float ss = 0.f;
#pragma unroll
                for (int bj = 0; bj < 2; ++bj) { const f32x4 xa = *(const f32x4*)(base + off + bj * 128), xb = *(const f32x4*)(base + off + bj * 128 + 4);
                    const f32x4 v0 = acc[ai][bj][m][0] + xa, v1 = acc[ai][bj][m][1] + xb;
                    *(f32x4*)(out + off + bj * 128) = v0; *(f32x4*)(out + off + bj * 128 + 4) = v1;
                    if (outb) { u32x4 w; w.x = cvt_pk_bf16(v0[0], v0[1]); w.y = cvt_pk_bf16(v0[2], v0[3]); w.z = cvt_pk_bf16(v1[0], v1[1]); w.w = cvt_pk_bf16(v1[2], v1[3]); *(u32x4*)(outb + off + bj * 128) = w; }
                    ss += (v0[0] * v0[0] + v0[1] * v0[1]) + (v0[2] * v0[2] + v0[3] * v0[3]) + (v1[0] * v1[0] + v1[1] * v1[1]) + (v1[2] * v1[2] + v1[3] * v1[3]); }
                if (ssq) { ss += __shfl_xor(ss, 16); ss += __shfl_xor(ss, 32); if (fq == 0) atomicAdd(ssq + row, ss); } }
    }
};
__device__ __forceinline__ float gelu_tanh(float x) { const float z = 0.7978845608028654f * (x + 0.044715f * x * x * x); return x * __builtin_amdgcn_rcpf(1.0f + __expf(-2.0f * z)); }
__device__ __forceinline__ float rot16(float x, int lane, int n) { return __shfl(x, (lane & ~15) | ((lane - n) & 15)); }
struct EpiGateVal {
    static constexpr bool PERM = true, AFTER_DRAIN = false;
    bf16_t* ACT; const float* ssq2; const float* conv_w; const float* conv_b; const float* state_conv; float* UHL; float* UHF; float* out_vp; float* out_vs;
    __device__ __forceinline__ void operator()(const f32x4 (&acc)[2][2][4][2], const Unit& u, int wr, int wc, int fr, int fq) const {
        const int lane = threadIdx.x & 63;
        const int c0 = u.pn * 128 + wc * 32 + 8 * fq;
        float w0[8], w1[8], w2[8], cb[8];
#pragma unroll
        for (int e = 0; e < 8; ++e) { w0[e] = conv_w[c0 + e]; w1[e] = conv_w[DFF + c0 + e]; w2[e] = conv_w[2 * DFF + c0 + e]; cb[e] = conv_b[c0 + e]; }
        const bool sample = u.pm >= 64;
#pragma unroll
        for (int ai = 0; ai < 2; ++ai) {
            float r1p[8], r2p[8];
#pragma unroll
            for (int e = 0; e < 8; ++e) { r1p[e] = 0.f; r2p[e] = 0.f; }
#pragma unroll
            for (int m = 0; m < 4; ++m) { const int row = u.pm * 256 + ai * 128 + wr * 64 + m * 16 + fr;
                const float rs = rsqrtf(ssq2[row] * (1.f / DM) + EPS);
                float uu[8], vv[8], r1[8], r2[8];
#pragma unroll
                for (int e = 0; e < 8; ++e) { uu[e] = acc[ai][0][m][e >> 2][e & 3] * rs; vv[e] = acc[ai][1][m][e >> 2][e & 3] * rs; }
#pragma unroll
                for (int e = 0; e < 8; ++e) { r1[e] = rot16(uu[e], lane, 1); r2[e] = rot16(uu[e], lane, 2); }
                float p1[8], p2[8]; bool valid = true;
                if (!sample) {
#pragma unroll
                    for (int e = 0; e < 8; ++e) { p1[e] = fr >= 1 ? r1[e] : r1p[e]; p2[e] = fr >= 2 ? r2[e] : r2p[e]; }
                    if (m == 0 && fr < 2) { valid = false; const int gi = row >> 6; float* d = UHF + ((size_t)(gi * 2 + fr) * 2) * DFF + c0;
                        *(f32x4*)d = (f32x4){uu[0], uu[1], uu[2], uu[3]}; *(f32x4*)(d + 4) = (f32x4){uu[4], uu[5], uu[6], uu[7]};
                        *(f32x4*)(d + DFF) = (f32x4){vv[0], vv[1], vv[2], vv[3]}; *(f32x4*)(d + DFF + 4) = (f32x4){vv[4], vv[5], vv[6], vv[7]}; }
                    if (m == 3 && fr >= 14) { const int gi = row >> 6; float* d = UHL + (size_t)(gi * 2 + (fr - 14)) * DFF + c0;
                        *(f32x4*)d = (f32x4){uu[0], uu[1], uu[2], uu[3]}; *(f32x4*)(d + 4) = (f32x4){uu[4], uu[5], uu[6], uu[7]};
                        if ((row & 2047) >= 2046) { float* o = out_vp + (size_t)((row >> 11) * 2 + (fr - 14)) * DFF + c0;
                            *(f32x4*)o = (f32x4){uu[0], uu[1], uu[2], uu[3]}; *(f32x4*)(o + 4) = (f32x4){uu[4], uu[5], uu[6], uu[7]}; } }
                } else {
                    const int pos = fr & 7, b = (row - MPROMPT) >> 3; const float* sc = state_conv + (size_t)b * 2 * DFF + c0;
                    float b0[8], b1[8];
#pragma unroll
                    for (int e = 0; e < 8; ++e) { b0[e] = 0.f; b1[e] = 0.f; }
                    if (pos < 2) {
#pragma unroll
                        for (int e = 0; e < 8; ++e) { b0[e] = sc[e]; b1[e] = sc[DFF + e]; } }
#pragma unroll
                    for (int e = 0; e < 8; ++e) { p1[e] = pos >= 1 ? r1[e] : b1[e]; p2[e] = pos >= 2 ? r2[e] : (pos == 1 ? b1[e] : b0[e]); }
                    if (pos >= 6) { float* o = out_vs + (size_t)(b * 2 + (pos - 6)) * DFF + c0;
                        *(f32x4*)o = (f32x4){uu[0], uu[1], uu[2], uu[3]}; *(f32x4*)(o + 4) = (f32x4){uu[4], uu[5], uu[6], uu[7]}; }
                }
                if (valid) { float a[8];
#pragma unroll
                    for (int e = 0; e < 8; ++e) a[e] = gelu_tanh(cb[e] + w0[e] * p2[e] + w1[e] * p1[e] + w2[e] * uu[e]) * vv[e];
                    u32x4 w; w.x = cvt_pk_bf16(a[0], a[1]); w.y = cvt_pk_bf16(a[2], a[3]); w.z = cvt_pk_bf16(a[4], a[5]); w.w = cvt_pk_bf16(a[6], a[7]);
                    *(u32x4*)(ACT + (size_t)row * DFF + c0) = w; }
#pragma unroll
                for (int e = 0; e < 8; ++e) { r1p[e] = r1[e]; r2p[e] = r2[e]; }
            }
        }
    }
};
#ifndef LAS
#define LAS __attribute__((address_space(3)))
#endif
#define LDS_BARRIER() do { asm volatile("s_waitcnt lgkmcnt(0)" ::: "memory"); __builtin_amdgcn_s_barrier(); asm volatile("" ::: "memory"); } while (0)
typedef short bf16x8 __attribute__((ext_vector_type(8)));
constexpr int QT_OFF = 0, KT_OFF = 17408, KHT_OFF = 34816, VT_OFF = 53248, SW_OFF = 73984, ST_OFF = 83200, RAWV_OFF = 122368, SM_OFF = 138752;
constexpr int F_DLAST = 0, F_PTOT = 128, F_SG = 640, F_SM = 704, F_SWI = 768, F_SMT = 832, F_SWEND = 896, F_SDEN = 960, F_SSSQ = 1024, F_SCAL = 1152;
__device__ __forceinline__ bf16x8 ldfrag(const LAS unsigned char* base, int stride_b, int row, int kcol) { return *(const LAS bf16x8*)(base + row * stride_b + kcol * 2); }
__device__ __forceinline__ f32x4 mfma16(bf16x8 a, bf16x8 b, f32x4 c) { return __builtin_amdgcn_mfma_f32_16x16x32_bf16(a, b, c, 0, 0, 0); }
__device__ __forceinline__ u32x2 pack4(f32x4 v) { return (u32x2){cvt_pk_bf16(v[0], v[1]), cvt_pk_bf16(v[2], v[3])}; }

template <bool IS_ML>
__device__ __forceinline__ void mixer_item(const Params& p, LAS unsigned char* L, const int sqi, const int h, const bool prompt) {
    const int tid = threadIdx.x, w = __builtin_amdgcn_readfirstlane(tid >> 6), lane = tid & 63, l15 = lane & 15, q4 = lane >> 4;
    const int Lc = prompt ? 64 : 8, nch = prompt ? 32 : 1;
    const int row0 = prompt ? sqi * 2048 : MPROMPT + sqi * 8;
    const bf16_t* PROJ = (const bf16_t*)(p.ws + WS_R1) + (IS_ML ? 2048 : 0) + h * 128;
    bf16_t* AMIX = (bf16_t*)p.out + (size_t)MROWS * DM + (IS_ML ? 512 : 0) + h * 128;
    const float* GATES = (const float*)(p.ws + WS_GATES);
    LAS unsigned char* Qt = L + QT_OFF; LAS unsigned char* Kt = L + KT_OFF; LAS unsigned char* KhT = L + KHT_OFF; LAS unsigned char* VT = L + VT_OFF;
    LAS unsigned char* Sw = L + SW_OFF; LAS unsigned char* ST = L + ST_OFF; LAS unsigned char* rawV = L + RAWV_OFF; LAS float* sm = (LAS float*)(L + SM_OFF);
    constexpr int NV = IS_ML ? 9 : 8;
    const int tt = w & 3, vb = w >> 2;
    const size_t sbase = (size_t)(sqi * 4 + h) * 128 * 128;
    f32x4 sacc[NV];
    float m_prev = 0.f;
#pragma unroll
    for (int vt = 0; vt < NV; ++vt) sacc[vt] = (f32x4){0.f, 0.f, 0.f, 0.f};
    if (!prompt) {
        const float* S0 = IS_ML ? p.in[3] : p.in[2];
#pragma unroll
        for (int vt = 0; vt < 8; ++vt)
#pragma unroll
            for (int j = 0; j < 4; ++j) sacc[vt][j] = S0[sbase + (size_t)(w * 16 + q4 * 4 + j) * 128 + vt * 16 + l15];
        if (IS_ML) { m_prev = p.in[5][sqi * 4 + h];
            if (l15 == 0) {
#pragma unroll
                for (int j = 0; j < 4; ++j) sacc[NV - 1][j] = p.in[4][(size_t)(sqi * 4 + h) * 128 + w * 16 + q4 * 4 + j]; } }
    }
    float gnr[4][4];
    { const float* gn = (IS_ML ? p.in[13] : p.in[10]) + h * 128;
#pragma unroll
        for (int i = 0; i < 4; ++i)
#pragma unroll
            for (int j = 0; j < 4; ++j) gnr[i][j] = gn[(vb * 4 + i) * 16 + q4 * 4 + j]; }
    u32x4 rq[2], rk[2], rv[2];
    auto load_raw = [&](int c) {
#pragma unroll
        for (int i = 0; i < 2; ++i) { const int pc = tid + 512 * i, r = pc >> 4, c8 = pc & 15;
            if (r < Lc) { const bf16_t* src = PROJ + (size_t)(row0 + c * 64 + r) * NPROJ + c8 * 8;
                rq[i] = *(const u32x4*)src; rk[i] = *(const u32x4*)(src + 512); rv[i] = *(const u32x4*)(src + 1024); }
            else { rq[i] = (u32x4){0u, 0u, 0u, 0u}; rk[i] = rq[i]; rv[i] = rq[i]; } }
    };
    load_raw(0);
    LDS_BARRIER();
#pragma unroll
    for (int vt = 0; vt < NV; ++vt) *(LAS u32x2*)(ST + (vt * 16 + l15) * 272 + (w * 16 + q4 * 4) * 2) = pack4(sacc[vt]);
    if (IS_ML) { for (int i = tid; i < 16 * 72; i += 512) *(LAS unsigned short*)(VT + (128 * 72 + i) * 2) = (i < 72) ? (unsigned short)0x3F80 : (unsigned short)0; }
    for (int c = 0; c < nch; ++c) {
#pragma unroll
        for (int i = 0; i < 2; ++i) { const int pc = tid + 512 * i, r = pc >> 4, c8 = pc & 15;
            *(LAS u32x4*)(Qt + r * 272 + c8 * 16) = rq[i]; *(LAS u32x4*)(Kt + r * 272 + c8 * 16) = rk[i]; *(LAS u32x4*)(rawV + r * 256 + c8 * 16) = rv[i]; }
        if (IS_ML && w == 0) {
            const int t = lane; float lf = 0.f, ig = -INFINITY;
            if (t < Lc) { const float* gp = GATES + (size_t)(row0 + c * 64 + t) * 8; ig = gp[h]; lf = gp[4 + h]; }
            float a = lf;
#pragma unroll
            for (int o = 1; o < 64; o <<= 1) { const float x = __shfl_up(a, o); if (lane >= o) a += x; }
            const float g = ig - a; float cm = g;
#pragma unroll
            for (int o = 1; o < 64; o <<= 1) { const float x = __shfl_up(cm, o); if (lane >= o) cm = fmaxf(cm, x); }
            const float M = fmaxf(m_prev, cm), M63 = __shfl(M, 63), a63 = __shfl(a, 63);
            sm[F_SG + t] = g; sm[F_SM + t] = M; sm[F_SWI + t] = __expf(m_prev - M); sm[F_SMT + t] = a + M; sm[F_SWEND + t] = __expf(g - M63);
            if (lane == 0) { sm[F_SCAL + 0] = __expf(m_prev - M63); sm[F_SCAL + 1] = a63 + M63; }
        }
        LDS_BARRIER();
        if (c + 1 < nch) load_raw(c + 1);
        { const int k = tid & 127, part = tid >> 7; unsigned short kh[16];
            if (!IS_ML) {
                float lfv[16], cs[16]; float run = 0.f;
#pragma unroll
                for (int i = 0; i < 16; ++i) { lfv[i] = bf2f(*(const LAS unsigned short*)(Kt + (part * 16 + i) * 272 + k * 2)); run += lfv[i]; cs[i] = run; }
                sm[F_PTOT + part * 128 + k] = run;
                LDS_BARRIER();
                float pre = 0.f, tot = 0.f;
#pragma unroll
                for (int pp = 0; pp < 4; ++pp) { const float x = sm[F_PTOT + pp * 128 + k]; tot += x; if (pp < part) pre += x; }
                if (part == 0) sm[F_DLAST + k] = __expf(tot);
#pragma unroll
                for (int i = 0; i < 16; ++i) { const int s = part * 16 + i; const float b = pre + cs[i], e = __expf(b), r = __builtin_amdgcn_rcpf(e), kk = 1.f - __expf(lfv[i]);
                    LAS unsigned short* qp = (LAS unsigned short*)(Qt + s * 272 + k * 2); *qp = f2bf(bf2f(*qp) * e);
                    *(LAS unsigned short*)(Kt + s * 272 + k * 2) = f2bf(kk * r); kh[i] = f2bf(kk * __expf(tot - b)); }
            } else {
#pragma unroll
                for (int i = 0; i < 16; ++i) { const int s = part * 16 + i; kh[i] = f2bf(bf2f(*(const LAS unsigned short*)(Kt + s * 272 + k * 2)) * sm[F_SWEND + s]); }
            }
            u32x4 w0, w1;
            w0.x = kh[0] | ((unsigned)kh[1] << 16); w0.y = kh[2] | ((unsigned)kh[3] << 16); w0.z = kh[4] | ((unsigned)kh[5] << 16); w0.w = kh[6] | ((unsigned)kh[7] << 16);
            w1.x = kh[8] | ((unsigned)kh[9] << 16); w1.y = kh[10] | ((unsigned)kh[11] << 16); w1.z = kh[12] | ((unsigned)kh[13] << 16); w1.w = kh[14] | ((unsigned)kh[15] << 16);
            *(LAS u32x4*)(KhT + k * 144 + part * 32) = w0; *(LAS u32x4*)(KhT + k * 144 + part * 32 + 16) = w1;
            unsigned short vv[16];
#pragma unroll
            for (int i = 0; i < 16; ++i) vv[i] = *(const LAS unsigned short*)(rawV + (part * 16 + i) * 256 + k * 2);
            w0.x = vv[0] | ((unsigned)vv[1] << 16); w0.y = vv[2] | ((unsigned)vv[3] << 16); w0.z = vv[4] | ((unsigned)vv[5] << 16); w0.w = vv[6] | ((unsigned)vv[7] << 16);
            w1.x = vv[8] | ((unsigned)vv[9] << 16); w1.y = vv[10] | ((unsigned)vv[11] << 16); w1.z = vv[12] | ((unsigned)vv[13] << 16); w1.w = vv[14] | ((unsigned)vv[15] << 16);
            *(LAS u32x4*)(VT + k * 144 + part * 32) = w0; *(LAS u32x4*)(VT + k * 144 + part * 32 + 16) = w1;
        }
        LDS_BARRIER();
        { const int pt = w >> 1;
#pragma unroll
            for (int e = 0; e < 2; ++e) { const int st = 2 * (w & 1) + e; f32x4 pa = (f32x4){0.f, 0.f, 0.f, 0.f};
                if (st <= pt) {
#pragma unroll
                    for (int ks = 0; ks < 4; ++ks) pa = mfma16(ldfrag(Kt, 272, st * 16 + l15, ks * 32 + q4 * 8), ldfrag(Qt, 272, pt * 16 + l15, ks * 32 + q4 * 8), pa); }
                const int t = pt * 16 + l15, s0 = st * 16 + q4 * 4; const float Mt = IS_ML ? sm[F_SM + t] : 0.f;
#pragma unroll
                for (int j = 0; j < 4; ++j) { const int s = s0 + j; float x = pa[j]; if (IS_ML) x *= __expf(sm[F_SG + s] - Mt); pa[j] = (s <= t) ? x : 0.f; }
                *(LAS u32x2*)(Sw + t * 144 + s0 * 2) = pack4(pa); } }
        f32x4 oacc[5];
        { bf16x8 bq[4];
#pragma unroll
            for (int ks = 0; ks < 4; ++ks) bq[ks] = ldfrag(Qt, 272, tt * 16 + l15, ks * 32 + q4 * 8);
            const float wi = IS_ML ? sm[F_SWI + tt * 16 + l15] : 1.f;
#pragma unroll
            for (int i = 0; i < 5; ++i) { oacc[i] = (f32x4){0.f, 0.f, 0.f, 0.f};
                if (i < 4 || (IS_ML && vb == 1)) { const int vt = i < 4 ? vb * 4 + i : 8;
#pragma unroll
                    for (int ks = 0; ks < 4; ++ks) oacc[i] = mfma16(ldfrag(ST, 272, vt * 16 + l15, ks * 32 + q4 * 8), bq[ks], oacc[i]);
                    if (IS_ML) oacc[i] = oacc[i] * wi; } } }
        LDS_BARRIER();
        { bf16x8 bs[2];
#pragma unroll
            for (int ks = 0; ks < 2; ++ks) bs[ks] = ldfrag(Sw, 144, tt * 16 + l15, ks * 32 + q4 * 8);
#pragma unroll
            for (int i = 0; i < 5; ++i) if (i < 4 || (IS_ML && vb == 1)) { const int vt = i < 4 ? vb * 4 + i : 8;
#pragma unroll
                for (int ks = 0; ks < 2; ++ks) oacc[i] = mfma16(ldfrag(VT, 144, vt * 16 + l15, ks * 32 + q4 * 8), bs[ks], oacc[i]); } }
        { bf16x8 ak[2];
#pragma unroll
            for (int ks = 0; ks < 2; ++ks) ak[ks] = ldfrag(KhT, 144, w * 16 + l15, ks * 32 + q4 * 8);
            f32x4 dl;
            if (IS_ML) { const float fe = sm[F_SCAL + 0]; dl = (f32x4){fe, fe, fe, fe}; m_prev = sm[F_SCAL + 1]; }
            else dl = *(const LAS f32x4*)(sm + F_DLAST + w * 16 + q4 * 4);
#pragma unroll
            for (int vt = 0; vt < NV; ++vt) { sacc[vt] = sacc[vt] * dl;
#pragma unroll
                for (int ks = 0; ks < 2; ++ks) sacc[vt] = mfma16(ak[ks], ldfrag(VT, 144, vt * 16 + l15, ks * 32 + q4 * 8), sacc[vt]);
                *(LAS u32x2*)(ST + (vt * 16 + l15) * 272 + (w * 16 + q4 * 4) * 2) = pack4(sacc[vt]); } }
        const int t = tt * 16 + l15;
        if (IS_ML) {
            if (vb == 1 && q4 == 0) sm[F_SDEN + t] = oacc[4][0];
            LDS_BARRIER();
            const float inv = 1.0f / fmaxf(fabsf(sm[F_SDEN + t]), __expf(-sm[F_SMT + t]));
#pragma unroll
            for (int i = 0; i < 4; ++i) oacc[i] = oacc[i] * inv;
        }
        float ss = 0.f;
#pragma unroll
        for (int i = 0; i < 4; ++i) ss += (oacc[i][0] * oacc[i][0] + oacc[i][1] * oacc[i][1]) + (oacc[i][2] * oacc[i][2] + oacc[i][3] * oacc[i][3]);
        ss += __shfl_xor(ss, 16); ss += __shfl_xor(ss, 32);
        if (q4 == 0) sm[F_SSSQ + t * 2 + vb] = ss;
        LDS_BARRIER();
        if (t < Lc) { const float rs = rsqrtf((sm[F_SSSQ + t * 2] + sm[F_SSSQ + t * 2 + 1]) * (1.f / 128.f) + EPS);
            const size_t row = (size_t)row0 + c * 64 + t;
#pragma unroll
            for (int i = 0; i < 4; ++i) { const int v0 = (vb * 4 + i) * 16 + q4 * 4; const u32x2 gt = *(const u32x2*)(PROJ + row * NPROJ + 1536 + v0);
                f32x4 o; o[0] = oacc[i][0] * rs * gnr[i][0] * __uint_as_float(gt.x << 16); o[1] = oacc[i][1] * rs * gnr[i][1] * __uint_as_float(gt.x & 0xffff0000u);
                o[2] = oacc[i][2] * rs * gnr[i][2] * __uint_as_float(gt.y << 16); o[3] = oacc[i][3] * rs * gnr[i][3] * __uint_as_float(gt.y & 0xffff0000u);
                *(u32x2*)(AMIX + row * DM + v0) = pack4(o); } }
    }
    { float* So = p.out + (IS_ML ? (prompt ? O_CP : O_CS) : (prompt ? O_SP : O_SS));
#pragma unroll
        for (int vt = 0; vt < 8; ++vt)
#pragma unroll
            for (int j = 0; j < 4; ++j) So[sbase + (size_t)(w * 16 + q4 * 4 + j) * 128 + vt * 16 + l15] = sacc[vt][j];
        if (IS_ML) { if (l15 == 0) { float* no = p.out + (prompt ? O_NP : O_NS) + (size_t)(sqi * 4 + h) * 128;
#pragma unroll
                for (int j = 0; j < 4; ++j) no[w * 16 + q4 * 4 + j] = sacc[NV - 1][j]; }
            if (tid == 0) p.out[(prompt ? O_MP : O_MS) + sqi * 4 + h] = m_prev; } }
}
__device__ __forceinline__ void mixer_dispatch(const Params& p, LAS unsigned char* L, int it) {
    int g, sqi, h; const bool prompt = it < 64;
    if (prompt) { g = it >> 5; sqi = (it >> 2) & 7; h = it & 3; } else { const int j = it - 64; g = j >> 9; sqi = (j >> 2) & 127; h = j & 3; }
    if (g == 0) mixer_item<false>(p, L, sqi, h, prompt); else mixer_item<true>(p, L, sqi, h, prompt);
}
__device__ __forceinline__ void phase2_chunked(const Params& p, LAS unsigned char* L) {
    const int G = gridDim.x, b = blockIdx.x;
    if (G > 64) { if (b < 64) mixer_dispatch(p, L, b); else for (int it = b; it < 1088; it += G - 64) mixer_dispatch(p, L, it); }
    else for (int it = b; it < 1088; it += G) mixer_dispatch(p, L, it);
}
constexpr size_t WS_SB = WS_X1;
template <bool IS_ML>
__device__ __forceinline__ void prepass_item(const Params& p, LAS unsigned char* L, const int sqi, const int c, const int h, u32x4 (&rq)[2], u32x4 (&rk)[2], u32x4 (&rv)[2], float& gig, float& glf,
                                             const bf16_t* nsrc, const float* ngates) {
    const int tid = threadIdx.x, w = __builtin_amdgcn_readfirstlane(tid >> 6), lane = tid & 63, l15 = lane & 15, q4 = lane >> 4;
    const int row0 = sqi * 2048 + c * 64;
    bf16_t* PROJ = (bf16_t*)(p.ws + WS_R1) + (IS_ML ? 2048 : 0) + h * 128;
    bf16_t* AMIX = (bf16_t*)p.out + (size_t)MROWS * DM + (IS_ML ? 512 : 0) + h * 128;
    float* SB = (float*)(p.ws + WS_SB) + (size_t)((((IS_ML ? 8 : 0) + sqi) * 32 + c) * 4 + h) * 256;
    LAS unsigned char* Qt = L + QT_OFF; LAS unsigned char* Kt = L + KT_OFF; LAS unsigned char* KhT = L + KHT_OFF; LAS unsigned char* VT = L + VT_OFF;
    LAS unsigned char* Sw = L + SW_OFF; LAS unsigned char* rawV = L + RAWV_OFF; LAS float* sm = (LAS float*)(L + SM_OFF);
    const int tt = w & 3, vb = w >> 2;
    LDS_BARRIER();
    if (IS_ML) { for (int i = tid; i < 16 * 72; i += 512) *(LAS unsigned short*)(VT + (128 * 72 + i) * 2) = (i < 72) ? (unsigned short)0x3F80 : (unsigned short)0; }
#pragma unroll
    for (int i = 0; i < 2; ++i) { const int pc = tid + 512 * i, r = pc >> 4, c8 = pc & 15;
        *(LAS u32x4*)(Qt + r * 272 + c8 * 16) = rq[i]; *(LAS u32x4*)(Kt + r * 272 + c8 * 16) = rk[i]; *(LAS u32x4*)(rawV + r * 256 + c8 * 16) = rv[i]; }
    if (IS_ML && w == 0) {
        const int t = lane; const float ig = gig, lf = glf;
        float a = lf;
#pragma unroll
        for (int o = 1; o < 64; o <<= 1) { const float x = __shfl_up(a, o); if (lane >= o) a += x; }
        const float g = ig - a; float cm = g;
#pragma unroll
        for (int o = 1; o < 64; o <<= 1) { const float x = __shfl_up(cm, o); if (lane >= o) cm = fmaxf(cm, x); }
        const float M63 = __shfl(cm, 63);
        sm[F_SG + t] = g; sm[F_SM + t] = cm; sm[F_SWEND + t] = __expf(g - M63);
        SB[64 + t] = cm; SB[128 + t] = a;
    }
    if (nsrc) {
#pragma unroll
        for (int i = 0; i < 2; ++i) { const int pc = tid + 512 * i, r = pc >> 4, c8 = pc & 15; const bf16_t* src = nsrc + (size_t)r * NPROJ + c8 * 8;
            rq[i] = *(const u32x4*)src; rk[i] = *(const u32x4*)(src + 512); rv[i] = *(const u32x4*)(src + 1024); }
        if (ngates && w == 0) { gig = ngates[lane * 8]; glf = ngates[lane * 8 + 4]; } }
    LDS_BARRIER();
    { const int k = tid & 127, part = tid >> 7; unsigned short kh[16];
        if (!IS_ML) {
            float lfv[16], cs[16]; float run = 0.f;
#pragma unroll
            for (int i = 0; i < 16; ++i) { lfv[i] = bf2f(*(const LAS unsigned short*)(Kt + (part * 16 + i) * 272 + k * 2)); run += lfv[i]; cs[i] = run; }
            sm[F_PTOT + part * 128 + k] = run;
            LDS_BARRIER();
            float pre = 0.f, tot = 0.f;
#pragma unroll
            for (int pp = 0; pp < 4; ++pp) { const float x = sm[F_PTOT + pp * 128 + k]; tot += x; if (pp < part) pre += x; }
            if (part == 0) SB[k] = __expf(tot);
#pragma unroll
            for (int i = 0; i < 16; ++i) { const int s = part * 16 + i; const float b = pre + cs[i], e = __expf(b), r = __builtin_amdgcn_rcpf(e), kk = 1.f - __expf(lfv[i]);
                LAS unsigned short* qp = (LAS unsigned short*)(Qt + s * 272 + k * 2); *qp = f2bf(bf2f(*qp) * e);
                *(LAS unsigned short*)(Kt + s * 272 + k * 2) = f2bf(kk * r); kh[i] = f2bf(kk * __expf(tot - b)); }
        } else {
#pragma unroll
            for (int i = 0; i < 16; ++i) { const int s = part * 16 + i; kh[i] = f2bf(bf2f(*(const LAS unsigned short*)(Kt + s * 272 + k * 2)) * sm[F_SWEND + s]); }
        }
        u32x4 w0, w1;
        w0.x = kh[0] | ((unsigned)kh[1] << 16); w0.y = kh[2] | ((unsigned)kh[3] << 16); w0.z = kh[4] | ((unsigned)kh[5] << 16); w0.w = kh[6] | ((unsigned)kh[7] << 16);
        w1.x = kh[8] | ((unsigned)kh[9] << 16); w1.y = kh[10] | ((unsigned)kh[11] << 16); w1.z = kh[12] | ((unsigned)kh[13] << 16); w1.w = kh[14] | ((unsigned)kh[15] << 16);
        *(LAS u32x4*)(KhT + k * 144 + part * 32) = w0; *(LAS u32x4*)(KhT + k * 144 + part * 32 + 16) = w1;
        unsigned short vv[16];
#pragma unroll
        for (int i = 0; i < 16; ++i) vv[i] = *(const LAS unsigned short*)(rawV + (part * 16 + i) * 256 + k * 2);
        w0.x = vv[0] | ((unsigned)vv[1] << 16); w0.y = vv[2] | ((unsigned)vv[3] << 16); w0.z = vv[4] | ((unsigned)vv[5] << 16); w0.w = vv[6] | ((unsigned)vv[7] << 16);
        w1.x = vv[8] | ((unsigned)vv[9] << 16); w1.y = vv[10] | ((unsigned)vv[11] << 16); w1.z = vv[12] | ((unsigned)vv[13] << 16); w1.w = vv[14] | ((unsigned)vv[15] << 16);
        *(LAS u32x4*)(VT + k * 144 + part * 32) = w0; *(LAS u32x4*)(VT + k * 144 + part * 32 + 16) = w1;
    }
    LDS_BARRIER();
    { const int pt = w >> 1;
#pragma unroll
        for (int e = 0; e < 2; ++e) { const int st = 2 * (w & 1) + e; f32x4 pa = (f32x4){0.f, 0.f, 0.f, 0.f};
            if (st <= pt) {
#pragma unroll
                for (int ks = 0; ks < 4; ++ks) pa = mfma16(ldfrag(Kt, 272, st * 16 + l15, ks * 32 + q4 * 8), ldfrag(Qt, 272, pt * 16 + l15, ks * 32 + q4 * 8), pa); }
            const int t = pt * 16 + l15, s0 = st * 16 + q4 * 4; const float Mt = IS_ML ? sm[F_SM + t] : 0.f;
#pragma unroll
            for (int j = 0; j < 4; ++j) { const int s = s0 + j; float x = pa[j]; if (IS_ML) x *= __expf(sm[F_SG + s] - Mt); pa[j] = (s <= t) ? x : 0.f; }
            *(LAS u32x2*)(Sw + t * 144 + s0 * 2) = pack4(pa); } }
#pragma unroll
    for (int i = 0; i < 2; ++i) { const int pc = tid + 512 * i;
        if (!IS_ML) { const int r = pc >> 4, c8 = pc & 15; *(u32x4*)(PROJ + (size_t)(row0 + r) * NPROJ + c8 * 8) = *(const LAS u32x4*)(Qt + r * 272 + c8 * 16); }
        const int k = pc >> 3, s8 = pc & 7; bf16_t* dst = PROJ + (size_t)(row0 + (k >> 1)) * NPROJ + (k & 1) * 64 + s8 * 8;
        *(u32x4*)(dst + 512) = *(const LAS u32x4*)(KhT + k * 144 + s8 * 16); *(u32x4*)(dst + 1024) = *(const LAS u32x4*)(VT + k * 144 + s8 * 16); }
    LDS_BARRIER();
    { bf16x8 bs[2];
#pragma unroll
        for (int ks = 0; ks < 2; ++ks) bs[ks] = ldfrag(Sw, 144, tt * 16 + l15, ks * 32 + q4 * 8);
#pragma unroll
        for (int i = 0; i < 5; ++i) if (i < 4 || (IS_ML && vb == 1)) { const int vt = i < 4 ? vb * 4 + i : 8; f32x4 o = (f32x4){0.f, 0.f, 0.f, 0.f};
#pragma unroll
            for (int ks = 0; ks < 2; ++ks) o = mfma16(ldfrag(VT, 144, vt * 16 + l15, ks * 32 + q4 * 8), bs[ks], o);
            const int t = tt * 16 + l15;
            if (i < 4) *(u32x2*)(AMIX + (size_t)(row0 + t) * DM + vt * 16 + q4 * 4) = pack4(o);
            else if (q4 == 0) SB[t] = o[0]; } }
}
constexpr int C_QT = 0, C_KHT = 17408, C_VT = 35840, C_ST0 = 56576, C_ST1 = 95744, C_SM = 134912;
constexpr int CF_WI = 0, CF_RHO = 64, CF_DEN = 128, CF_EMT = 192, CF_SCAL = 256, CF_SSSQ = 272;
template <bool IS_ML>
__device__ __forceinline__ void chain_run(const Params& p, LAS unsigned char* L, const int sqi, const int h, const bool write_out = true) {
    const int tid = threadIdx.x, w = __builtin_amdgcn_readfirstlane(tid >> 6), lane = tid & 63, l15 = lane & 15, q4 = lane >> 4;
    const int row0 = sqi * 2048;
    const bf16_t* PROJ = (const bf16_t*)(p.ws + WS_R1) + (IS_ML ? 2048 : 0) + h * 128;
    bf16_t* AMIX = (bf16_t*)p.out + (size_t)MROWS * DM + (IS_ML ? 512 : 0) + h * 128;
    const float* SB0 = (const float*)(p.ws + WS_SB) + (size_t)((((IS_ML ? 8 : 0) + sqi) * 32) * 4 + h) * 256;
    LAS unsigned char* Qt = L + C_QT; LAS unsigned char* KhT = L + C_KHT; LAS unsigned char* VT = L + C_VT; LAS float* sm = (LAS float*)(L + C_SM);
    constexpr int NV = IS_ML ? 9 : 8;
    const int tt = w & 3, vb = w >> 2, t = tt * 16 + l15;
    const size_t sbase = (size_t)(sqi * 4 + h) * 128 * 128;
    f32x4 sacc[NV];
#pragma unroll
    for (int vt = 0; vt < NV; ++vt) sacc[vt] = (f32x4){0.f, 0.f, 0.f, 0.f};
    float m_prev = 0.f;
    const float* gn = (IS_ML ? p.in[13] : p.in[10]) + h * 128;
    u32x4 rq[2], rk[2], rv[2]; u32x2 rin[4], rgt[4]; f32x4 dl = (f32x4){0.f, 0.f, 0.f, 0.f}; float s_den = 0.f, s_ml = 0.f, s_a = 0.f;
    auto prefetch_big = [&](int c) {
#pragma unroll
        for (int i = 0; i < 2; ++i) { const int pc = tid + 512 * i; const int r = pc >> 4, c8 = pc & 15;
            rq[i] = *(const u32x4*)(PROJ + (size_t)(row0 + c * 64 + r) * NPROJ + c8 * 8);
            const int k = pc >> 3, s8 = pc & 7; const bf16_t* src = PROJ + (size_t)(row0 + c * 64 + (k >> 1)) * NPROJ + (k & 1) * 64 + s8 * 8;
            rk[i] = *(const u32x4*)(src + 512); rv[i] = *(const u32x4*)(src + 1024); }
    };
    auto prefetch_io = [&](int c) {
        const size_t row = (size_t)row0 + c * 64 + t;
#pragma unroll
        for (int i = 0; i < 4; ++i) { const int v0 = (vb * 4 + i) * 16 + q4 * 4; rin[i] = *(const u32x2*)(AMIX + row * DM + v0); rgt[i] = *(const u32x2*)(PROJ + row * NPROJ + 1536 + v0); }
    };
    auto prefetch_sb = [&](int c, f32x4& dl_, float& d_, float& ml_, float& a_) {
        const float* sb = SB0 + (size_t)c * 1024;
        if (!IS_ML) dl_ = *(const f32x4*)(sb + w * 16 + q4 * 4);
        else if (w == 0) { d_ = sb[lane]; ml_ = sb[64 + lane]; a_ = sb[128 + lane]; }
    };
    prefetch_big(0); prefetch_io(0); prefetch_sb(0, dl, s_den, s_ml, s_a);
    LDS_BARRIER();
#pragma unroll
    for (int vt = 0; vt < NV; ++vt) *(LAS u32x2*)(L + C_ST0 + (vt * 16 + l15) * 272 + (w * 16 + q4 * 4) * 2) = (u32x2){0u, 0u};
    if (IS_ML) { for (int i = tid; i < 16 * 72; i += 512) *(LAS unsigned short*)(VT + (128 * 72 + i) * 2) = (i < 72) ? (unsigned short)0x3F80 : (unsigned short)0; }
    for (int c = 0; c < 32; ++c) {
        LAS unsigned char* STr = L + ((c & 1) ? C_ST1 : C_ST0); LAS unsigned char* STw = L + ((c & 1) ? C_ST0 : C_ST1);
#pragma unroll
        for (int i = 0; i < 2; ++i) { const int pc = tid + 512 * i; const int r = pc >> 4, c8 = pc & 15, k = pc >> 3, s8 = pc & 7;
            *(LAS u32x4*)(Qt + r * 272 + c8 * 16) = rq[i]; *(LAS u32x4*)(KhT + k * 144 + s8 * 16) = rk[i]; *(LAS u32x4*)(VT + k * 144 + s8 * 16) = rv[i]; }
        if (IS_ML && w == 0) {
            const float M = fmaxf(m_prev, s_ml), M63 = __shfl(M, 63), ml63 = __shfl(s_ml, 63), a63 = __shfl(s_a, 63);
            sm[CF_WI + lane] = __expf(m_prev - M); sm[CF_RHO + lane] = __expf(s_ml - M); sm[CF_DEN + lane] = s_den; sm[CF_EMT + lane] = __expf(-(s_a + M));
            if (lane == 0) { sm[CF_SCAL + 0] = __expf(m_prev - M63); sm[CF_SCAL + 1] = __expf(ml63 - M63); sm[CF_SCAL + 2] = a63 + M63; }
        }
        LDS_BARRIER();
        f32x4 ndl = dl; float n_den = 0.f, n_ml = 0.f, n_a = 0.f;
        if (c + 1 < 32) { prefetch_big(c + 1); prefetch_sb(c + 1, ndl, n_den, n_ml, n_a); }
        float wi_t = 1.f, rho_t = 1.f, denl_t = 0.f, emt_t = 0.f, fend = 1.f, sigma = 1.f;
        if (IS_ML) { wi_t = sm[CF_WI + t]; rho_t = sm[CF_RHO + t]; denl_t = sm[CF_DEN + t]; emt_t = sm[CF_EMT + t]; fend = sm[CF_SCAL + 0]; sigma = sm[CF_SCAL + 1]; m_prev = sm[CF_SCAL + 2]; }
        f32x4 oacc[5];
        { bf16x8 bq[4];
#pragma unroll
            for (int ks = 0; ks < 4; ++ks) bq[ks] = ldfrag(Qt, 272, tt * 16 + l15, ks * 32 + q4 * 8);
#pragma unroll
            for (int i = 0; i < 5; ++i) { oacc[i] = (f32x4){0.f, 0.f, 0.f, 0.f};
                if (i < 4 || IS_ML) { const int vt = i < 4 ? vb * 4 + i : 8;
#pragma unroll
                    for (int ks = 0; ks < 4; ++ks) oacc[i] = mfma16(ldfrag(STr, 272, vt * 16 + l15, ks * 32 + q4 * 8), bq[ks], oacc[i]); } } }
        { bf16x8 ak[2];
#pragma unroll
            for (int ks = 0; ks < 2; ++ks) ak[ks] = ldfrag(KhT, 144, w * 16 + l15, ks * 32 + q4 * 8);
#pragma unroll
            for (int vt = 0; vt < NV; ++vt) {
                if (!IS_ML) { sacc[vt] = sacc[vt] * dl;
#pragma unroll
                    for (int ks = 0; ks < 2; ++ks) sacc[vt] = mfma16(ak[ks], ldfrag(VT, 144, vt * 16 + l15, ks * 32 + q4 * 8), sacc[vt]); }
                else { f32x4 uacc = (f32x4){0.f, 0.f, 0.f, 0.f};
#pragma unroll
                    for (int ks = 0; ks < 2; ++ks) uacc = mfma16(ak[ks], ldfrag(VT, 144, vt * 16 + l15, ks * 32 + q4 * 8), uacc);
                    sacc[vt] = sacc[vt] * fend + uacc * sigma; }
                *(LAS u32x2*)(STw + (vt * 16 + l15) * 272 + (w * 16 + q4 * 4) * 2) = pack4(sacc[vt]); } }
        float inv = 1.f;
        if (IS_ML) { const float di = __shfl(oacc[4][0], l15); inv = 1.0f / fmaxf(fabsf(wi_t * di + rho_t * denl_t), emt_t); }
        float ss = 0.f;
#pragma unroll
        for (int i = 0; i < 4; ++i) { f32x4 in; in[0] = __uint_as_float(rin[i].x << 16); in[1] = __uint_as_float(rin[i].x & 0xffff0000u); in[2] = __uint_as_float(rin[i].y << 16); in[3] = __uint_as_float(rin[i].y & 0xffff0000u);
            if (IS_ML) oacc[i] = (oacc[i] * wi_t + in * rho_t) * inv; else oacc[i] = oacc[i] + in;
            ss += (oacc[i][0] * oacc[i][0] + oacc[i][1] * oacc[i][1]) + (oacc[i][2] * oacc[i][2] + oacc[i][3] * oacc[i][3]); }
        ss += __shfl_xor(ss, 16); ss += __shfl_xor(ss, 32);
        LAS float* sq = sm + CF_SSSQ + (c & 1) * 128;
        if (q4 == 0) sq[t * 2 + vb] = ss;
        LDS_BARRIER();
        { const float rs = rsqrtf((sq[t * 2] + sq[t * 2 + 1]) * (1.f / 128.f) + EPS); const size_t row = (size_t)row0 + c * 64 + t;
#pragma unroll
            for (int i = 0; i < 4; ++i) { const int v0 = (vb * 4 + i) * 16 + q4 * 4; const u32x2 gt = rgt[i];
                const f32x4 gv = *(const f32x4*)(gn + v0);
                f32x4 o; o[0] = oacc[i][0] * rs * gv[0] * __uint_as_float(gt.x << 16); o[1] = oacc[i][1] * rs * gv[1] * __uint_as_float(gt.x & 0xffff0000u);
                o[2] = oacc[i][2] * rs * gv[2] * __uint_as_float(gt.y << 16); o[3] = oacc[i][3] * rs * gv[3] * __uint_as_float(gt.y & 0xffff0000u);
                if (write_out) *(u32x2*)(AMIX + row * DM + v0) = pack4(o); } }
        if (c + 1 < 32) prefetch_io(c + 1);
        dl = ndl; s_den = n_den; s_ml = n_ml; s_a = n_a;
    }
    { float* So = p.out + (IS_ML ? O_CP : O_SP);
#pragma unroll
        for (int vt = 0; vt < 8; ++vt)
#pragma unroll
            for (int j = 0; j < 4; ++j) So[sbase + (size_t)(w * 16 + q4 * 4 + j) * 128 + vt * 16 + l15] = sacc[vt][j];
        if (IS_ML) { if (l15 == 0) { float* no = p.out + O_NP + (size_t)(sqi * 4 + h) * 128;
#pragma unroll
                for (int j = 0; j < 4; ++j) no[w * 16 + q4 * 4 + j] = sacc[NV - 1][j]; }
            if (tid == 0) p.out[O_MP + sqi * 4 + h] = m_prev; } }
}
#ifndef SAMPLE_TWICE
#define SAMPLE_TWICE 0
#endif
#ifndef SAMPLE_TWICE
#define SAMPLE_TWICE 0
#endif
#ifndef CHAIN_TWICE
#define CHAIN_TWICE 0
#endif
#ifndef NS_A
#define NS_A 256
#endif
__device__ __forceinline__ void sample_dispatch(const Params& p, LAS unsigned char* L, int j) {
    const int g = j >> 9, sqi = (j >> 2) & 127, h = j & 3;
    if (g == 0) mixer_item<false>(p, L, sqi, h, false); else mixer_item<true>(p, L, sqi, h, false);
}
__device__ __forceinline__ void phase2a(const Params& p, LAS unsigned char* L) {
    const int tid = threadIdx.x, lane = tid & 63, w = tid >> 6;
    u32x4 rq[2], rk[2], rv[2]; float gig = 0.f, glf = 0.f;
    auto slot = [&](int it) -> const bf16_t* { const int g = it >> 10, sqi = (it >> 7) & 7, c = (it >> 2) & 31, h = it & 3; return (const bf16_t*)(p.ws + WS_R1) + (size_t)(sqi * 2048 + c * 64) * NPROJ + (g ? 2048 : 0) + h * 128; };
    auto gptr = [&](int it) -> const float* { const int g = it >> 10, sqi = (it >> 7) & 7, c = (it >> 2) & 31, h = it & 3; return g ? (const float*)(p.ws + WS_GATES) + (size_t)(sqi * 2048 + c * 64) * 8 + h : nullptr; };
    int it = blockIdx.x;
    if (it < 2048) { const bf16_t* s0 = slot(it);
#pragma unroll
        for (int i = 0; i < 2; ++i) { const int pc = tid + 512 * i, r = pc >> 4, c8 = pc & 15; const bf16_t* src = s0 + (size_t)r * NPROJ + c8 * 8;
            rq[i] = *(const u32x4*)src; rk[i] = *(const u32x4*)(src + 512); rv[i] = *(const u32x4*)(src + 1024); }
        const float* g0 = gptr(it); if (g0 && w == 0) { gig = g0[lane * 8]; glf = g0[lane * 8 + 4]; } }
    for (; it < 2048; it += gridDim.x) { const int g = it >> 10, sqi = (it >> 7) & 7, c = (it >> 2) & 31, h = it & 3; const int nx = it + gridDim.x;
        const bf16_t* ns = nx < 2048 ? slot(nx) : nullptr; const float* ng = nx < 2048 ? gptr(nx) : nullptr;
        if (g == 0) prepass_item<false>(p, L, sqi, c, h, rq, rk, rv, gig, glf, ns, ng); else prepass_item<true>(p, L, sqi, c, h, rq, rk, rv, gig, glf, ns, ng); }
}
__device__ __forceinline__ void phase2a_samples(const Params& p, LAS unsigned char* L) {
    for (int it = 2048 + blockIdx.x; it < 2048 + NS_A; it += gridDim.x) { sample_dispatch(p, L, it - 2048); if (SAMPLE_TWICE) sample_dispatch(p, L, it - 2048); }
}
__device__ __forceinline__ void phase2b(const Params& p, LAS unsigned char* L) {
    const int G = gridDim.x, b = blockIdx.x;
    if (G > 64) {
        if (b < 64) { const int g = b >> 5, sqi = (b >> 2) & 7, h = b & 3; if (g == 0) chain_run<false>(p, L, sqi, h); else chain_run<true>(p, L, sqi, h);
            if (CHAIN_TWICE) { if (g == 0) chain_run<false>(p, L, sqi, h, false); else chain_run<true>(p, L, sqi, h, false); } }
        else for (int j = NS_A + (b - 64); j < 1024; j += G - 64) sample_dispatch(p, L, j);
    } else {
        for (int it = b; it < 64 + 1024 - NS_A; it += G) {
            if (it < 64) { const int g = it >> 5, sqi = (it >> 2) & 7, h = it & 3; if (g == 0) chain_run<false>(p, L, sqi, h); else chain_run<true>(p, L, sqi, h); }
            else sample_dispatch(p, L, NS_A + it - 64); }
    }
}
__device__ __forceinline__ void phase2_naive(const Params& p, unsigned char* shm) {
    float* sq = (float*)shm; float* sd = sq + 128; float* si = sd + 128; float* sv = si + 128; float* part = sv + 128; float* denp = part + 512; float* red = denp + 4;
    const int tid = threadIdx.x, v = tid & 127, kq = tid >> 7;
    const bf16_t* PROJ = (const bf16_t*)(p.ws + WS_R1); bf16_t* AMIX = (bf16_t*)p.out + (size_t)MROWS * DM; const float* GATES = (const float*)(p.ws + WS_GATES);
    for (int it = blockIdx.x; it < 1088; it += gridDim.x) {
        int g, sqi, h, T, row0; const bool prompt = it < 64;
        if (prompt) { g = it >> 5; sqi = (it >> 2) & 7; h = it & 3; T = 2048; row0 = sqi * 2048; }
        else { const int j = it - 64; g = j >> 9; sqi = (j >> 2) & 127; h = j & 3; T = 8; row0 = MPROMPT + sqi * 8; }
        float S[32], nst[32]; float mst = 0.f;
        const size_t sbase = ((size_t)(sqi * 4 + h) * 128) * 128;
#pragma unroll
        for (int i = 0; i < 32; ++i) { S[i] = 0.f; nst[i] = 0.f; }
        if (!prompt) { const float* S0 = g == 0 ? p.in[2] : p.in[3];
#pragma unroll
            for (int i = 0; i < 32; ++i) S[i] = S0[sbase + (size_t)(kq * 32 + i) * 128 + v];
            if (g == 1) { mst = p.in[5][sqi * 4 + h];
#pragma unroll
                for (int i = 0; i < 32; ++i) nst[i] = p.in[4][(size_t)(sqi * 4 + h) * 128 + kq * 32 + i]; } }
        const float* gn = (g == 0 ? p.in[10] : p.in[13]) + h * 128;
        for (int t = 0; t < T; ++t) {
            const size_t row = (size_t)row0 + t; const bf16_t* pr = PROJ + row * NPROJ + g * 2048 + h * 128;
            float m_new = 0.f;
            if (g == 0) {
                if (tid < 128) sq[tid] = bf2f(pr[tid]);
                else if (tid < 256) { const float f = __expf(bf2f(pr[512 + tid - 128])); sd[tid - 128] = f; si[tid - 128] = 1.f - f; }
                else if (tid < 384) sv[tid - 256] = bf2f(pr[1024 + tid - 256]);
            } else {
                const float ig = GATES[row * 8 + h], lf = GATES[row * 8 + 4 + h];
                m_new = fmaxf(lf + mst, ig); const float fd = __expf(lf + mst - m_new), ii = __expf(ig - m_new);
                if (tid < 128) sq[tid] = bf2f(pr[tid]);
                else if (tid < 256) { sd[tid - 128] = fd; si[tid - 128] = ii * bf2f(pr[512 + tid - 128]); }
                else if (tid < 384) sv[tid - 256] = bf2f(pr[1024 + tid - 256]);
            }
            __syncthreads();
            const float vv = sv[v]; float acc = 0.f, dacc = 0.f;
#pragma unroll
            for (int i = 0; i < 32; ++i) { const int k = kq * 32 + i; const float d = sd[k], ik = si[k], q = sq[k]; S[i] = d * S[i] + ik * vv; acc += q * S[i]; nst[i] = d * nst[i] + ik; dacc += q * nst[i]; }
            part[kq * 128 + v] = acc; if (v == 0) denp[kq] = dacc;
            __syncthreads();
            float o = 0.f;
            if (tid < 128) { o = (part[tid] + part[128 + tid]) + (part[256 + tid] + part[384 + tid]);
                if (g == 1) { const float den = (denp[0] + denp[1]) + (denp[2] + denp[3]); o = o / fmaxf(fabsf(den), __expf(-m_new)); }
                const float ss = wave_sum(o * o); if ((tid & 63) == 0) red[tid >> 6] = ss; }
            __syncthreads();
            if (tid < 128) { const float tot = red[0] + red[1]; const float gate = bf2f(pr[1536 + tid]);
                AMIX[row * DM + g * 512 + h * 128 + tid] = f2bf(o * rsqrtf(tot * (1.f / 128.f) + EPS) * gn[tid] * gate); }
            mst = m_new;
            __syncthreads();
        }
        float* So = p.out + (g == 0 ? (prompt ? O_SP : O_SS) : (prompt ? O_CP : O_CS));
#pragma unroll
        for (int i = 0; i < 32; ++i) So[sbase + (size_t)(kq * 32 + i) * 128 + v] = S[i];
        if (g == 1 && v == 0) { float* no = p.out + (prompt ? O_NP : O_NS) + (size_t)(sqi * 4 + h) * 128;
#pragma unroll
            for (int i = 0; i < 32; ++i) no[kq * 32 + i] = nst[i];
            if (kq == 0) p.out[(prompt ? O_MP : O_MS) + sqi * 4 + h] = mst; }
    }
}
__device__ __forceinline__ void phase5(const Params& p) {
    const float* UHL = (const float*)(p.ws + WS_UHL); const float* UHF = (const float*)(p.ws + WS_UHF); bf16_t* ACT = (bf16_t*)(p.ws + WS_R1 + R1_ACT);
    const float* cw = p.in[18]; const float* cbp = p.in[19];
    constexpr int NQ = DFF / 4;
    for (int i = blockIdx.x * 512 + threadIdx.x; i < 256 * 2 * NQ; i += gridDim.x * 512) {
        const int cq = i % NQ, j = (i / NQ) & 1, gi = i / (2 * NQ), c = 4 * cq; const int row = gi * 64 + j;
        const bool first = (gi & 31) == 0;
        const f32x4 z = (f32x4){0.f, 0.f, 0.f, 0.f};
        const f32x4 l0 = first ? z : *(const f32x4*)(UHL + (size_t)((gi - 1) * 2 + 0) * DFF + c), l1 = first ? z : *(const f32x4*)(UHL + (size_t)((gi - 1) * 2 + 1) * DFF + c);
        const f32x4 u0 = *(const f32x4*)(UHF + (size_t)((gi * 2 + 0) * 2) * DFF + c);
        const f32x4 uu = *(const f32x4*)(UHF + (size_t)((gi * 2 + j) * 2) * DFF + c), vv = *(const f32x4*)(UHF + (size_t)((gi * 2 + j) * 2 + 1) * DFF + c);
        const f32x4 p2 = j == 0 ? l0 : l1, p1 = j == 0 ? l1 : u0;
        const f32x4 w0 = *(const f32x4*)(cw + c), w1 = *(const f32x4*)(cw + DFF + c), w2 = *(const f32x4*)(cw + 2 * DFF + c), cb = *(const f32x4*)(cbp + c);
        float a[4];
#pragma unroll
        for (int e = 0; e < 4; ++e) a[e] = gelu_tanh(cb[e] + w0[e] * p2[e] + w1[e] * p1[e] + w2[e] * uu[e]) * vv[e];
        *(u32x2*)(ACT + (size_t)row * DFF + c) = (u32x2){cvt_pk_bf16(a[0], a[1]), cvt_pk_bf16(a[2], a[3])};
    }
}
__device__ __forceinline__ void phase7(const Params& p) {
    const float* gf = p.in[21]; float* Y = p.out; const float* X1 = (const float*)(p.ws + WS_X1); const float* PART = (const float*)(p.ws + WS_R1 + R1_X1B);
    const int wave = threadIdx.x >> 6, lane = threadIdx.x & 63;
    f32x4 g[4];
#pragma unroll
    for (int j = 0; j < 4; ++j) g[j] = *(const f32x4*)(gf + 4 * lane + 256 * j);
    for (int row = blockIdx.x * 8 + wave; row < MROWS; row += gridDim.x * 8) {
        f32x4 v[4]; float s = 0.f;
        if (row < MPROMPT) {
#pragma unroll
            for (int j = 0; j < 4; ++j) v[j] = *(const f32x4*)(Y + (size_t)row * DM + 4 * lane + 256 * j);
        } else {
#pragma unroll
            for (int j = 0; j < 4; ++j) v[j] = *(const f32x4*)(X1 + (size_t)row * DM + 4 * lane + 256 * j);
#pragma unroll
            for (int sl = 0; sl < 7; ++sl)
#pragma unroll
                for (int j = 0; j < 4; ++j) v[j] = v[j] + *(const f32x4*)(PART + (size_t)sl * (1024 * DM) + (size_t)(row - MPROMPT) * DM + 4 * lane + 256 * j);
        }
#pragma unroll
        for (int j = 0; j < 4; ++j) s += (v[j].x * v[j].x + v[j].y * v[j].y) + (v[j].z * v[j].z + v[j].w * v[j].w);
        const float rs = rsqrtf(wave_sum(s) * (1.f / DM) + EPS);
#pragma unroll
        for (int j = 0; j < 4; ++j) *(f32x4*)(Y + (size_t)row * DM + 4 * lane + 256 * j) = v[j] * rs * g[j];
    }
}
#define RUN(ph) (((PHMASK >> (ph)) & 1) && ph_lo <= (ph) && (ph) <= ph_hi)
#define SYNC(ph) do { if (ph_lo <= (ph) && (ph) < ph_hi) { xcd_barrier(xb); } } while (0)
#define TWICE(ph, body) do { body; if ((REPMASK >> (ph)) & 1) { grid.sync(); body; } } while (0)
__device__ __forceinline__ void run_p1(const Params& p, PG8_LAS unsigned char* lds) { bf16_t* H = (bf16_t*)p.out; bf16_t* PROJ = (bf16_t*)(p.ws + WS_R1);
    pg8::StaticOrder S; S.init(MROWS, NIN, gridDim.x, blockIdx.x); pg8::Gemm g{H, (const bf16_t*)(p.ws + WS_WIN), MROWS, NIN, DM};
    EpiInProj E{PROJ, p.in[9], (float*)(p.ws + WS_GATES), p.in[11], p.in[12]}; pg8::gemm_phase(lds, g, S, E); }
__device__ __forceinline__ void run_p3(const Params& p, PG8_LAS unsigned char* lds) { bf16_t* AMIX = (bf16_t*)p.out + (size_t)MROWS * DM; bf16_t* X1B = (bf16_t*)(p.ws + WS_R1 + R1_X1B); float* X1 = (float*)(p.ws + WS_X1);
    pg8::StaticOrder S; S.init(MROWS, DM, gridDim.x, blockIdx.x); pg8::Gemm g{AMIX, (const bf16_t*)(p.ws + WS_WOUT), MROWS, DM, DM};
    EpiResid E{p.in[0], p.in[1], X1, X1B, (float*)(p.ws + WS_SSQ2), nullptr}; pg8::gemm_phase(lds, g, S, E); }
__device__ __forceinline__ void run_p4(const Params& p, PG8_LAS unsigned char* lds) { bf16_t* X1B = (bf16_t*)(p.ws + WS_R1 + R1_X1B); bf16_t* ACT = (bf16_t*)(p.ws + WS_R1 + R1_ACT);
    pg8::StaticOrder S; S.init(MROWS, NGV, gridDim.x, blockIdx.x); pg8::Gemm g{X1B, (const bf16_t*)(p.ws + WS_WGV), MROWS, NGV, DM};
    EpiGateVal E{ACT, (const float*)(p.ws + WS_SSQ2), p.in[18], p.in[19], p.in[6], (float*)(p.ws + WS_UHL), (float*)(p.ws + WS_UHF), p.out + O_VP, p.out + O_VS}; pg8::gemm_phase(lds, g, S, E); }
struct DownOrder {
    pg8::StaticOrder S; int G, c;
    __device__ void init(int G_, int c_) { G = G_; c = c_; S.init(MPROMPT, DM, G_, c_, DFF); }
    __device__ bool next(int i, Unit& u) const {
        const int L = i * G + c;
        if (L < 256) { pg8::StaticOrder T = S; T.G = 256; T.c = L; return T.next(0, u); }
        const int r = L - 256; if (r >= 112) return false;
        const int s = r % 7, t = r / 7; u.pm = 64 + (t >> 2); u.pn = t & 3; u.k0 = 384 * s; u.nt = s == 6 ? 8 : 6; return true;
    }
    __device__ __forceinline__ void a_ready(const Unit&) const {}
    __device__ __forceinline__ void done(const Unit&) const {}
};
__device__ __forceinline__ void run_p6(const Params& p, PG8_LAS unsigned char* lds) { bf16_t* ACT = (bf16_t*)(p.ws + WS_R1 + R1_ACT); float* X1 = (float*)(p.ws + WS_X1);
    DownOrder S; S.init(gridDim.x, blockIdx.x); pg8::Gemm g{ACT, (const bf16_t*)(p.ws + WS_WD), MROWS, DM, DFF};
    EpiResid E{X1, X1 + (size_t)MPROMPT * DM, p.out, nullptr, nullptr, (float*)(p.ws + WS_R1 + R1_X1B)}; pg8::gemm_phase(lds, g, S, E); }
__global__ __launch_bounds__(512, 2) void fwd_kernel(Params p, int ph_lo, int ph_hi) {
    extern __shared__ __attribute__((aligned(16))) unsigned char shm[];
    PG8_LAS unsigned char* lds = (PG8_LAS unsigned char*)shm;
    cg::grid_group grid = cg::this_grid();
    volatile LAS unsigned* xst = (volatile LAS unsigned*)(lds + LDS_BYTES - 16);
    if (threadIdx.x == 0) { xst[0] = 0u; xst[1] = 0u; }
    __syncthreads();
    XcdBarrier xb = xcd_barrier_post((unsigned*)(p.ws + WS_BAR), xst);
    if (ph_lo < -1000) grid.sync();
    if (RUN(0)) TWICE(0, phase0(p, shm));
    SYNC(0);
    if (RUN(1)) TWICE(1, run_p1(p, lds));
    SYNC(1);
#if NAIVE_MIXER
    if (RUN(2)) phase2_naive(p, shm);
#else
    if (RUN(2)) { phase2a(p, lds); phase2a_samples(p, lds); xcd_barrier(xb); phase2b(p, lds); }
#endif
    SYNC(2);
    if (RUN(3)) run_p3(p, lds);
    SYNC(3);
    if (RUN(4)) TWICE(4, run_p4(p, lds));
    SYNC(4);
    if (RUN(5)) TWICE(5, phase5(p));
    SYNC(5);
    if (RUN(6)) run_p6(p, lds);
    SYNC(6);
    if (RUN(7)) phase7(p);
#if EXTRA_SYNCS
    for (int i = 0; i < EXTRA_SYNCS; ++i) xcd_barrier(xb);
#endif
}
extern "C" void kernel_launch(void* const* d_in, const int* in_sizes, int n_in, void* d_out, int out_size, void* d_ws, size_t ws_size, hipStream_t stream) {
    static int grid = 0;
    if (grid == 0) {
        if (n_in != 22 || ws_size < WS_END) { fprintf(stderr, "kernel_launch: unexpected n_in %d / ws_size %zu (need %zu)\n", n_in, ws_size, (size_t)WS_END); grid = -1; return; }
        int dev = 0, cus = 0, per_cu = 0;
        hipGetDevice(&dev); hipDeviceGetAttribute(&cus, hipDeviceAttributeMultiprocessorCount, dev);
        if (hipFuncSetAttribute((const void*)fwd_kernel, hipFuncAttributeMaxDynamicSharedMemorySize, LDS_BYTES) != hipSuccess) { fprintf(stderr, "kernel_launch: hipFuncSetAttribute failed\n"); grid = -1; return; }
        if (hipOccupancyMaxActiveBlocksPerMultiprocessor(&per_cu, (const void*)fwd_kernel, 512, LDS_BYTES) != hipSuccess || per_cu < 1) { fprintf(stderr, "kernel_launch: occupancy query says %d blocks per CU\n", per_cu); per_cu = 1; }
        (void)hipGetLastError();
        grid = cus;
        fprintf(stderr, "kernel_launch: cus %d per_cu %d grid %d ws %zu\n", cus, per_cu, grid, ws_size);
    }
    if (grid < 0) return;
    Params p{};
    for (int i = 0; i < 22; ++i) p.in[i] = (const float*)d_in[i];
    p.out = (float*)d_out; p.ws = (unsigned char*)d_ws;
    if (hipMemsetAsync((char*)d_ws + WS_BAR, 0, 16384, stream) != hipSuccess) { fprintf(stderr, "kernel_launch: memset of the barrier words failed\n"); return; }
#if ONE_LAUNCH
    int lo = 0, hi = 7; void* args[] = {&p, &lo, &hi};
    hipError_t e = hipLaunchCooperativeKernel((const void*)fwd_kernel, dim3(grid), dim3(512), args, LDS_BYTES, stream);
    if (e != hipSuccess) fprintf(stderr, "cooperative launch failed: %s (grid %d)\n", hipGetErrorString(e), grid);
#else
    for (int ph = 0; ph < 8; ++ph) hipLaunchKernelGGL(fwd_kernel, dim3(grid), dim3(512), LDS_BYTES, stream, p, ph, ph);
#endif
}
```

```cpp
#include <hip/hip_runtime.h>
#include <hip/hip_cooperative_groups.h>
#include <cstdio>
#include <cstdint>
namespace cg = cooperative_groups;
#ifndef ONE_LAUNCH
#define ONE_LAUNCH 1
#endif
#ifndef PHMASK
#define PHMASK 255
#endif
#ifndef NAIVE_MIXER
#define NAIVE_MIXER 0
#endif
#ifndef REPMASK
#define REPMASK 0
#endif
#ifndef EXTRA_SYNCS
#define EXTRA_SYNCS 0
#endif
#ifndef P3_OVERLAP
#define P3_OVERLAP 0
#endif
namespace pg8 {
#define PG8_LAS __attribute__((address_space(3)))
typedef unsigned short bf16_t;
typedef short bf16x8 __attribute__((ext_vector_type(8)));
typedef float f32x4 __attribute__((ext_vector_type(4)));
typedef unsigned u32x4 __attribute__((ext_vector_type(4)));
constexpr int BM = 256, BK = 64, HALF = 128, HTB = HALF * BK * 2  , STAGE_BYTES = 8 * HTB, NXCD = 8, WGM = 8;

__host__ __device__ __forceinline__ int lds_byte(int r, int c) { const int st = (r >> 4) * 2 + (c >> 5), rr = r & 15, cc = c & 31, ob = rr * 64 + cc * 2; return st * 1024 + (ob ^ (((ob >> 9) & 1) << 5)); }
__host__ __device__ __forceinline__ void stage_rc(int b, int& R, int& C) { const int st = b / 1024, sb = b % 1024, swz = sb ^ (((sb >> 9) & 1) << 5); R = (st >> 1) * 16 + swz / 64; C = (st & 1) * 32 + (swz % 64) / 2; }
__host__ __device__ __forceinline__ int perm32(int rho) { const int n = rho >> 4, i = rho & 15; return 8 * (i >> 2) + 4 * n + (i & 3); }

struct Unit { int pm, pn, k0, nt; };
struct Gemm { const bf16_t* A; const bf16_t* Bt; int M, N, K; };

struct StaticOrder {
    int nM, nN, nwg, G, c, ntK;
    __host__ __device__ void init(int M, int N, int G_, int c_, int K_ = 1024) { nM = M / BM; nN = N / BM; nwg = nM * nN; G = G_; c = c_; ntK = K_ / BK; }
    __host__ __device__ bool next(int i, Unit& u) const {
        const long L = (long)i * G + c; if (L >= nwg) return false;
        int wgid = (int)L; { const int q = nwg / NXCD, r = nwg % NXCD, xcd = wgid % NXCD, off = wgid / NXCD; wgid = (xcd < r ? xcd * (q + 1) : r * (q + 1) + (xcd - r) * q) + off; }
        const int nig = WGM * nN, gid = wgid / nig, fm = gid * WGM, gsz = (nM - fm) < WGM ? (nM - fm) : WGM;
        u.pm = fm + ((wgid % nig) % gsz); u.pn = (wgid % nig) / gsz; u.k0 = 0; u.nt = ntK; return true;
    }
    __device__ __forceinline__ void a_ready(const Unit&) const {}
    __device__ __forceinline__ void done(const Unit&) const {}
};

typedef float f32x2_t __attribute__((ext_vector_type(2)));
typedef __bf16 bf16x2_t __attribute__((ext_vector_type(2)));
__device__ __forceinline__ unsigned cvt_pk_bf16(float lo, float hi) { const f32x2_t v = {lo, hi}; return __builtin_bit_cast(unsigned, __builtin_convertvector(v, bf16x2_t)); }
template <class Epi, class Sched>
__device__ __forceinline__ void gemm_phase(PG8_LAS unsigned char* lds, const Gemm g, const Sched& S, const Epi& E) {
    const int tid = threadIdx.x, wid = __builtin_amdgcn_readfirstlane(tid >> 6), lane = tid & 63, wr = wid >> 2, wc = wid & 3, fr = lane & 15, fq = lane >> 4;
    const int K = g.K;
    unsigned voffA[2], voffB[2];
#pragma unroll
    for (int i = 0; i < 2; ++i) { int R, C; stage_rc(tid * 16 + i * 8192, R, C); const int Rb = Epi::PERM ? ((R & ~31) + perm32(R & 31)) : R;
        voffA[i] = (unsigned)(R * K + C) * 2u; voffB[i] = (unsigned)(Rb * K + C) * 2u; }
    const size_t kstep = (size_t)(BK * 2);
    const size_t hstep = (size_t)HALF * K * 2;
    const size_t tstep = 2 * hstep;
    const unsigned ldsw = (unsigned)wid * 1024u;
    const int aoff = lds_byte(wr * 64 + fr, fq * 8), boff = lds_byte(wc * 32 + fr, fq * 8);
#define PG8_SA(b, h) (((b) * 2 + (h)) * HTB)
#define PG8_SB(b, h) ((4 + (b) * 2 + (h)) * HTB)
#define PG8_STAGE(bufoff, gbase, voff) do { _Pragma("unroll") for (int _i = 0; _i < 2; ++_i) \
        __builtin_amdgcn_global_load_lds((const unsigned*)((const char*)(gbase) + (voff)[_i]), (PG8_LAS unsigned*)(lds + (bufoff) + ldsw + _i * 8192), 16, 0, 0); } while (0)
#define PG8_LDA(dst, b, h) do { _Pragma("unroll") for (int m = 0; m < 4; ++m) _Pragma("unroll") for (int k = 0; k < 2; ++k) dst[m][k] = *(const PG8_LAS bf16x8*)(lds + PG8_SA(b, h) + aoff + m * 2048 + k * 1024); } while (0)
#define PG8_LDB(dst, b, h) do { _Pragma("unroll") for (int n = 0; n < 2; ++n) _Pragma("unroll") for (int k = 0; k < 2; ++k) dst[n][k] = *(const PG8_LAS bf16x8*)(lds + PG8_SB(b, h) + boff + n * 2048 + k * 1024); } while (0)
#define PG8_MMA(ai, bj, At, Bt) do { __builtin_amdgcn_s_setprio(1); _Pragma("unroll") for (int m = 0; m < 4; ++m) _Pragma("unroll") for (int n = 0; n < 2; ++n) _Pragma("unroll") for (int k = 0; k < 2; ++k) \
        acc[ai][bj][m][n] = __builtin_amdgcn_mfma_f32_16x16x32_bf16(Bt[n][k], At[m][k], acc[ai][bj][m][n], 0, 0, 0); __builtin_amdgcn_s_setprio(0); } while (0)
#define PG8_WAIT_V(n) asm volatile("s_waitcnt vmcnt(" #n ")" ::: "memory")
#define PG8_WAIT_L(n) asm volatile("s_waitcnt lgkmcnt(" #n ")" ::: "memory")
#define PG8_BAR __builtin_amdgcn_s_barrier()
#define PG8_SCHED __builtin_amdgcn_sched_barrier(0)
    Unit cur, nxt; int ui = 0;
    if (!S.next(0, cur)) return;
    f32x4 acc[2][2][4][2];
#pragma unroll
    for (int a = 0; a < 2; ++a)
#pragma unroll
        for (int b = 0; b < 2; ++b)
#pragma unroll
            for (int m = 0; m < 4; ++m)
#pragma unroll
                for (int n = 0; n < 2; ++n) acc[a][b][m][n] = (f32x4){0.f, 0.f, 0.f, 0.f};
    bf16x8 At[4][2], B0[2][2], B1[2][2];
    const char* cA = (const char*)g.A + (size_t)cur.pm * tstep + (size_t)cur.k0 * 2; const char* cB = (const char*)g.Bt + (size_t)cur.pn * tstep + (size_t)cur.k0 * 2;
    S.a_ready(cur);
    PG8_STAGE(PG8_SB(0, 0), cB, voffB); PG8_STAGE(PG8_SA(0, 0), cA, voffA); PG8_STAGE(PG8_SB(0, 1), cB + hstep, voffB); PG8_STAGE(PG8_SA(0, 1), cA + hstep, voffA);
    if (wr == 1) PG8_BAR;
    PG8_WAIT_V(4); PG8_BAR;
    PG8_STAGE(PG8_SB(1, 0), cB + kstep, voffB); PG8_STAGE(PG8_SA(1, 0), cA + kstep, voffA); PG8_STAGE(PG8_SB(1, 1), cB + hstep + kstep, voffB);
    PG8_WAIT_V(6); PG8_BAR;
    for (;;) {
        const bool has_next = S.next(ui + 1, nxt);
        const char* nA = has_next ? (const char*)g.A + (size_t)nxt.pm * tstep + (size_t)nxt.k0 * 2 : cA; const char* nB = has_next ? (const char*)g.Bt + (size_t)nxt.pn * tstep + (size_t)nxt.k0 * 2 : cB;
        const int nt = cur.nt;
        for (int t = 0; t < nt; t += 2) {
            const bool last = (t == nt - 2);
            const char* a1 = cA + (size_t)(t + 1) * kstep;
            const char* a2 = last ? nA : cA + (size_t)(t + 2) * kstep; const char* b2 = last ? nB : cB + (size_t)(t + 2) * kstep;
            const char* a3 = a2 + kstep; const char* b3 = b2 + kstep;
            if (last && has_next) S.a_ready(nxt);
            PG8_LDB(B0, 0, 0); PG8_SCHED; PG8_LDA(At, 0, 0); PG8_STAGE(PG8_SA(1, 1), a1 + hstep, voffA);
            PG8_WAIT_L(8); PG8_BAR; PG8_WAIT_L(0); PG8_MMA(0, 0, At, B0); PG8_BAR; PG8_SCHED;
            PG8_LDB(B1, 0, 1); PG8_STAGE(PG8_SB(0, 0), b2, voffB);
            PG8_BAR; PG8_WAIT_L(0); PG8_MMA(0, 1, At, B1); PG8_BAR;
            PG8_LDA(At, 0, 1); PG8_STAGE(PG8_SA(0, 0), a2, voffA);
            PG8_BAR; PG8_WAIT_L(0); PG8_MMA(1, 0, At, B0); PG8_BAR; PG8_SCHED;
            PG8_STAGE(PG8_SB(0, 1), b2 + hstep, voffB);
            PG8_WAIT_V(6); PG8_BAR; PG8_MMA(1, 1, At, B1); PG8_BAR;
            PG8_LDB(B0, 1, 0); PG8_SCHED; PG8_LDA(At, 1, 0); PG8_STAGE(PG8_SA(0, 1), a2 + hstep, voffA);
            PG8_WAIT_L(8); PG8_BAR; PG8_WAIT_L(0); PG8_MMA(0, 0, At, B0); PG8_BAR; PG8_SCHED;
            PG8_LDB(B1, 1, 1); PG8_STAGE(PG8_SB(1, 0), b3, voffB);
            PG8_BAR; PG8_WAIT_L(0); PG8_MMA(0, 1, At, B1); PG8_BAR;
            PG8_LDA(At, 1, 1); PG8_STAGE(PG8_SA(1, 0), a3, voffA);
            PG8_BAR; PG8_WAIT_L(0); PG8_MMA(1, 0, At, B0); PG8_BAR; PG8_SCHED;
            PG8_STAGE(PG8_SB(1, 1), b3 + hstep, voffB);
            PG8_WAIT_V(6); PG8_BAR; PG8_MMA(1, 1, At, B1); PG8_BAR;
        }
        if constexpr (!Epi::AFTER_DRAIN) { E(acc, cur, wr, wc, fr, fq); S.done(cur); }
        if (!has_next) break;
#pragma unroll
        for (int a = 0; a < 2; ++a)
#pragma unroll
            for (int b = 0; b < 2; ++b)
#pragma unroll
                for (int m = 0; m < 4; ++m)
#pragma unroll
                    for (int n = 0; n < 2; ++n) acc[a][b][m][n] = (f32x4){0.f, 0.f, 0.f, 0.f};
        cur = nxt; cA = nA; cB = nB; ++ui;
    }
    PG8_WAIT_V(0);
    if (wr == 0) PG8_BAR;
    PG8_BAR;
    if constexpr (Epi::AFTER_DRAIN) { E.fused(acc, cur, wr, wc, fr, fq, lds, wid, lane); S.done(cur); }
#undef PG8_SA
#undef PG8_SB
#undef PG8_STAGE
#undef PG8_LDA
#undef PG8_LDB
#undef PG8_MMA
#undef PG8_WAIT_V
#undef PG8_WAIT_L
#undef PG8_BAR
#undef PG8_SCHED
}

}
#define XB_TMO      128
#define XB_XCNT(j)  (256  + 64 * (j))
#define XB_XSUB(j)  (1280 + 64 * (j))
#define XB_XGEN(j)  (2304 + 64 * (j))
#define XB_TOP      3328
#define XB_TOPGEN   3392
#define XCD_BAR_WORDS 3456
#define XB_SPIN_CAP (1u << 18)
#ifndef LAS
#define LAS __attribute__((address_space(3)))
#endif

__device__ __forceinline__ unsigned xb_ld(unsigned* p)              { return __hip_atomic_load(p, __ATOMIC_RELAXED, __HIP_MEMORY_SCOPE_AGENT); }
__device__ __forceinline__ unsigned xb_add(unsigned* p, unsigned v) { return __hip_atomic_fetch_add(p, v, __ATOMIC_RELAXED, __HIP_MEMORY_SCOPE_AGENT); }
__device__ __forceinline__ unsigned xb_xcc_id() { return (unsigned)__builtin_amdgcn_s_getreg((3 << 11) | 20) & 0xFu; }
#define XB_SPIN(cond, bar) do { unsigned _sp = 0; while (cond) { __builtin_amdgcn_s_sleep(1); \
    if ((++_sp & 255u) == 0u) { if (xb_ld(&(bar)[XB_TMO])) break; if (_sp > XB_SPIN_CAP) { atomicAdd(&(bar)[XB_TMO], 1u); break; } } } } while (0)

struct XcdBarrier {
    unsigned* bar; unsigned x;
    volatile LAS unsigned* st;
};

__device__ __forceinline__ XcdBarrier xcd_barrier_post(unsigned* bar, volatile LAS unsigned* st) {
    XcdBarrier b; b.bar = bar; b.x = xb_xcc_id(); b.st = st;
    if (threadIdx.x == 0) (void)xb_add(&bar[XB_XCNT(b.x)], 1u);
    return b;
}
__device__ __forceinline__ void xcd_barrier_complete(unsigned* bar, unsigned x, unsigned& nloc, unsigned& nx) {
    const unsigned G = gridDim.x * gridDim.y * gridDim.z;
    unsigned sum, cnt, mine, sp = 0u;
    for (;;) {
        sum = 0u; cnt = 0u; mine = 0u;
#pragma unroll
        for (unsigned j = 0; j < 16; ++j) { const unsigned c = xb_ld(&bar[XB_XCNT(j)]); sum += c; cnt += (c > 0u) ? 1u : 0u; mine = (j == x) ? c : mine; }
        if (sum == G) break;
        __builtin_amdgcn_s_sleep(1);
        if ((++sp & 255u) == 0u) { if (xb_ld(&bar[XB_TMO])) break; if (sp > XB_SPIN_CAP) { atomicAdd(&bar[XB_TMO], 1u); break; } }
    }
    nloc = mine > 0u ? mine : 1u; nx = cnt > 0u ? cnt : 1u;
}

__device__ __forceinline__ void xcd_barrier(const XcdBarrier& b) {
    asm volatile("s_waitcnt vmcnt(0)" ::: "memory");
    __syncthreads();
    if (threadIdx.x == 0) {
        unsigned* bar = b.bar;
        __builtin_amdgcn_s_waitcnt(0);
        unsigned nloc = b.st[0], nx = b.st[1];
        if (nloc == 0u) { xcd_barrier_complete(bar, b.x, nloc, nx); b.st[0] = nloc; b.st[1] = nx; }
        const unsigned old = xb_add(&bar[XB_XSUB(b.x)], 1u);
        const unsigned gen = old / nloc;
        if (old + 1u == (gen + 1u) * nloc) {
            __builtin_amdgcn_fence(__ATOMIC_RELEASE, "agent");
            asm volatile("s_waitcnt vmcnt(0)" ::: "memory");
            const unsigned og = xb_add(&bar[XB_TOP], 1u);
            const unsigned tg = og / nx;
            if (og + 1u == (tg + 1u) * nx) xb_add(&bar[XB_TOPGEN], 1u);
            else XB_SPIN(xb_ld(&bar[XB_TOPGEN]) == tg, bar);
            __builtin_amdgcn_fence(__ATOMIC_ACQUIRE, "agent");
            xb_add(&bar[XB_XGEN(b.x)], 1u);
            asm volatile("s_waitcnt vmcnt(0)" ::: "memory");
        } else {
            XB_SPIN(xb_ld(&bar[XB_XGEN(b.x)]) == gen, bar);
            __builtin_amdgcn_fence(__ATOMIC_ACQUIRE, "agent");
            asm volatile("s_waitcnt vmcnt(0)" ::: "memory");
        }
    }
    __syncthreads();
}

using pg8::bf16_t; using pg8::f32x4; using pg8::u32x4; using pg8::Unit; using pg8::cvt_pk_bf16;
typedef unsigned u32x2 __attribute__((ext_vector_type(2)));
constexpr int DM = 1024, MROWS = 17408, MPROMPT = 16384, NPROJ = 4096, INCOLS = 4104, DFF = 2816, NGV = 5632;
constexpr float EPS = 1e-6f;
constexpr size_t O_Y = 0, O_SP = 17825792, O_SS = 18350080, O_CP = 26738688, O_CS = 27262976, O_NP = 35651584, O_NS = 35655680,
                 O_MP = 35721216, O_MS = 35721248, O_VP = 35721760, O_VS = 35766816;
constexpr int NIN = 4352;
constexpr size_t WS_CTL = 0, WS_WIN = 4096, WS_WOUT = WS_WIN + (size_t)NIN * 1024 * 2, WS_WGV = WS_WOUT + 1024 * 1024 * 2, WS_WD = WS_WGV + 5632 * 1024 * 2,
                 WS_GATES = WS_WD + 1024 * 2816 * 2, WS_SSQ2 = WS_GATES + 17408 * 32, WS_SSQ3 = WS_SSQ2 + 17408 * 4, WS_UHL = WS_SSQ3 + 17408 * 4, WS_UHF = WS_UHL + 256 * 2 * 2816 * 4,
                 WS_X1 = WS_UHF + 256 * 4 * 2816 * 4, WS_R1 = WS_X1 + (size_t)17408 * 1024 * 4, WS_BAR = WS_R1 + (size_t)17408 * 4096 * 2, WS_END = WS_BAR + 16384;
static_assert(WS_END <= 268435456, "workspace budget");
constexpr size_t R1_X1B = 1048576, R1_ACT = 36700160 + 1048576;
constexpr int LDS_BYTES = 160 * 1024 - 2048;

struct Params { const float* in[22]; float* out; unsigned char* ws; };

__device__ __forceinline__ float bf2f(unsigned short b) { return __uint_as_float(((unsigned)b) << 16); }
__device__ __forceinline__ unsigned short f2bf(float f) { unsigned u = __float_as_uint(f); u += 0x7fffu + ((u >> 16) & 1u); return (unsigned short)(u >> 16); }
__device__ __forceinline__ float wave_sum(float v) {
#pragma unroll
    for (int o = 1; o < 64; o <<= 1) v += __shfl_xor(v, o);
    return v;
}
__device__ __forceinline__ float sigmoidf_(float x) { return __builtin_amdgcn_rcpf(1.0f + __expf(-x)); }

__device__ __forceinline__ void p0_transpose_item(const float* W, int ldw, int K, bf16_t* WT, int drow0, int k0, int n0, int nmax, const float* kscale, float* scr, int lane) {
    const int ncol = min(n0 + (lane & 31), nmax);
    float v[32];
#pragma unroll
    for (int i = 0; i < 32; ++i) v[i] = W[(size_t)(k0 + 2 * i + (lane >> 5)) * ldw + ncol];
    if (kscale) {
#pragma unroll
        for (int i = 0; i < 32; ++i) v[i] *= kscale[k0 + 2 * i + (lane >> 5)]; }
#pragma unroll
    for (int i = 0; i < 32; ++i) scr[(2 * i + (lane >> 5)) * 33 + (lane & 31)] = v[i];
    asm volatile("s_waitcnt lgkmcnt(0)" ::: "memory");
    const int c = lane & 7;
#pragma unroll
    for (int j = 0; j < 4; ++j) { const int n = (lane >> 3) + 8 * j; const float* s = scr + (8 * c) * 33 + n;
        u32x4 o; o.x = cvt_pk_bf16(s[0 * 33], s[1 * 33]); o.y = cvt_pk_bf16(s[2 * 33], s[3 * 33]); o.z = cvt_pk_bf16(s[4 * 33], s[5 * 33]); o.w = cvt_pk_bf16(s[6 * 33], s[7 * 33]);
        *(u32x4*)(WT + (size_t)(drow0 + n) * K + k0 + 8 * c) = o; }
    asm volatile("s_waitcnt lgkmcnt(0)" ::: "memory");
}

__device__ __forceinline__ void phase0(const Params& p, unsigned char* shm) {
    const int tid = threadIdx.x, wave = tid >> 6, lane = tid & 63;
    float* scr = (float*)(shm + wave * 8704);
    const int gw = blockIdx.x * 8 + wave, NGW = gridDim.x * 8;
    bf16_t* WinT = (bf16_t*)(p.ws + WS_WIN); bf16_t* WoutT = (bf16_t*)(p.ws + WS_WOUT);
    { float* z = (float*)(p.ws + WS_SSQ2); for (int i = blockIdx.x * 512 + tid; i < 2 * MROWS; i += gridDim.x * 512) z[i] = 0.f; }
    if (blockIdx.x == 0 && tid < 64) ((unsigned*)(p.ws + WS_CTL))[tid] = 0u;
    bf16_t* H = (bf16_t*)p.out;
    {   f32x4 g1[4];
#pragma unroll
        for (int j = 0; j < 4; ++j) g1[j] = *(const f32x4*)(p.in[7] + 4 * lane + 256 * j);
        int row = gw; f32x4 v[4];
        if (row < MROWS) { const float* xr = row < MPROMPT ? p.in[0] + (size_t)row * DM : p.in[1] + (size_t)(row - MPROMPT) * DM;
#pragma unroll
            for (int j = 0; j < 4; ++j) v[j] = *(const f32x4*)(xr + 4 * lane + 256 * j); }
        while (row < MROWS) {
            const int nrow = row + NGW; f32x4 nv[4];
#pragma unroll
            for (int j = 0; j < 4; ++j) nv[j] = (f32x4){0.f, 0.f, 0.f, 0.f};
            if (nrow < MROWS) { const float* xr = nrow < MPROMPT ? p.in[0] + (size_t)nrow * DM : p.in[1] + (size_t)(nrow - MPROMPT) * DM;
#pragma unroll
                for (int j = 0; j < 4; ++j) nv[j] = *(const f32x4*)(xr + 4 * lane + 256 * j); }
            float s = 0.f;
#pragma unroll
            for (int j = 0; j < 4; ++j) s += (v[j].x * v[j].x + v[j].y * v[j].y) + (v[j].z * v[j].z + v[j].w * v[j].w);
            const float rs = rsqrtf(wave_sum(s) * (1.f / DM) + EPS);
#pragma unroll
            for (int j = 0; j < 4; ++j) { const f32x4 o = v[j] * rs * g1[j];
                *(u32x2*)(H + (size_t)row * DM + 4 * lane + 256 * j) = (u32x2){cvt_pk_bf16(o.x, o.y), cvt_pk_bf16(o.z, o.w)}; }
#pragma unroll
            for (int j = 0; j < 4; ++j) v[j] = nv[j];
            row = nrow;
        }
    }
    constexpr int I_IN = 16 * 129, I_OUT = 16 * 32, NIT = I_IN + I_OUT;
    for (int it = gw; it < NIT; it += NGW) {
        int r = it;
        if (r < I_IN) { const int kb = r / 129, nb = r % 129; p0_transpose_item(p.in[8], INCOLS, DM, WinT, 32 * nb, 64 * kb, 32 * nb, INCOLS - 1, nullptr, scr, lane); continue; } r -= I_IN;
        { const int kb = r / 32, nb = r % 32; p0_transpose_item(p.in[14], DM, DM, WoutT, 32 * nb, 64 * kb, 32 * nb, DM - 1, nullptr, scr, lane); }
    }
}
__device__ __forceinline__ void deferred_transposes(const Params& p, unsigned char* shm, const int widx, const int nw) {
    const int wave = threadIdx.x >> 6, lane = threadIdx.x & 63;
    float* scr = (float*)(shm + wave * 8704);
    bf16_t* WgvT = (bf16_t*)(p.ws + WS_WGV); bf16_t* WdT = (bf16_t*)(p.ws + WS_WD);
    constexpr int I_G = 16 * 88, I_D = 44 * 32, NIT = 2 * I_G + I_D;
    for (int it = widx; it < NIT; it += nw) {
        int r = it;
        if (r < I_G) { const int kb = r / 88, nb = r % 88, n0 = 32 * nb; p0_transpose_item(p.in[16], DFF, DM, WgvT, 256 * (n0 >> 7) + (n0 & 127), 64 * kb, n0, DFF - 1, p.in[15], scr, lane); continue; } r -= I_G;
        if (r < I_G) { const int kb = r / 88, nb = r % 88, n0 = 32 * nb; p0_transpose_item(p.in[17], DFF, DM, WgvT, 256 * (n0 >> 7) + 128 + (n0 & 127), 64 * kb, n0, DFF - 1, p.in[15], scr, lane); continue; } r -= I_G;
        { const int kb = r / 32, nb = r % 32; p0_transpose_item(p.in[20], DM, DFF, WdT, 32 * nb, 64 * kb, 32 * nb, DM - 1, nullptr, scr, lane); }
    }
}
struct EpiInProj {
    static constexpr bool PERM = true, AFTER_DRAIN = false;
    bf16_t* O; const float* lbl; float* gates; const float* b_ig; const float* b_fg;
    __device__ __forceinline__ void operator()(const f32x4 (&acc)[2][2][4][2], const Unit& u, int wr, int wc, int fr, int fq) const {
        const int seg = u.pn >> 1, row0 = u.pm * 256 + wr * 64 + fr, col0 = u.pn * 256 + wc * 32 + 8 * fq;
        if (seg == 8) {
            if (wc == 0 && fq == 0) {
                float bi[4], bf_[4];
#pragma unroll
                for (int e = 0; e < 4; ++e) { bi[e] = b_ig[e]; bf_[e] = b_fg[e]; }
#pragma unroll
                for (int ai = 0; ai < 2; ++ai)
#pragma unroll
                    for (int m = 0; m < 4; ++m) { float* gp = gates + (size_t)(row0 + ai * 128 + m * 16) * 8; f32x4 a = acc[ai][0][m][0], b = acc[ai][0][m][1];
#pragma unroll
                        for (int e = 0; e < 4; ++e) { a[e] += bi[e]; const float z = b[e] + bf_[e]; b[e] = z > 0.f ? -log1pf(__expf(-z)) : z - log1pf(__expf(z)); }
                        *(f32x4*)gp = a; *(f32x4*)(gp + 4) = b; }
            }
            return;
        }
        float lb[2][8];
        if (seg == 1) {
#pragma unroll
            for (int bj = 0; bj < 2; ++bj)
#pragma unroll
                for (int e = 0; e < 8; ++e) { const int c = col0 + bj * 128 + e - 512; lb[bj][e] = __builtin_amdgcn_rcpf(1.0f + __expf(lbl[512 + c] - lbl[c])); }
        }
#pragma unroll
        for (int ai = 0; ai < 2; ++ai)
#pragma unroll
            for (int m = 0; m < 4; ++m) { bf16_t* rowp = O + (size_t)(row0 + ai * 128 + m * 16) * NPROJ + col0;
#pragma unroll
                for (int bj = 0; bj < 2; ++bj) { float v[8];
#pragma unroll
                    for (int e = 0; e < 8; ++e) v[e] = acc[ai][bj][m][e >> 2][e & 3];
                    if (seg == 1) {
#pragma unroll
                        for (int e = 0; e < 8; ++e) v[e] = __logf(lb[bj][e] + (1.0f - lb[bj][e]) * sigmoidf_(v[e]));
                    } else if (seg == 3) {
#pragma unroll
                        for (int e = 0; e < 8; ++e) v[e] = v[e] * sigmoidf_(v[e]);
                    } else if (seg == 5) {
#pragma unroll
                        for (int e = 0; e < 8; ++e) v[e] = v[e] * 0.08838834764831845f;
                    } else if (seg == 7) {
#pragma unroll
                        for (int e = 0; e < 8; ++e) v[e] = sigmoidf_(v[e]);
                    }
                    u32x4 w; w.x = cvt_pk_bf16(v[0], v[1]); w.y = cvt_pk_bf16(v[2], v[3]); w.z = cvt_pk_bf16(v[4], v[5]); w.w = cvt_pk_bf16(v[6], v[7]);
                    *(u32x4*)(rowp + bj * 128) = w; } }
    }
};
struct EpiResid {
    static constexpr bool PERM = true, AFTER_DRAIN = false;
    const float* base_p; const float* base_s;
    float* out; bf16_t* outb; float* ssq; float* part;
    __device__ __forceinline__ void operator()(const f32x4 (&acc)[2][2][4][2], const Unit& u, int wr, int wc, int fr, int fq) const {
        const int row0 = u.pm * 256 + wr * 64 + fr, col0 = u.pn * 256 + wc * 32 + 8 * fq;
        if (part && u.pm >= 64) { float* pp = part + (size_t)(u.k0 / 384) * (1024 * DM) - (size_t)MPROMPT * DM;
#pragma unroll
            for (int ai = 0; ai < 2; ++ai)
#pragma unroll
                for (int m = 0; m < 4; ++m) { const size_t off = (size_t)(row0 + ai * 128 + m * 16) * DM + col0;
#pragma unroll
                    for (int bj = 0; bj < 2; ++bj) { *(f32x4*)(pp + off + bj * 128) = acc[ai][bj][m][0]; *(f32x4*)(pp + off + bj * 128 + 4) = acc[ai][bj][m][1]; } }
            return; }
        const float* base = u.pm < 64 ? base_p : base_s - (size_t)MPROMPT * DM;
#pragma unroll
        for (int ai = 0; ai < 2; ++ai)
#pragma unroll
            for (int m = 0; m < 4; ++m) { const int row = row0 + ai * 128 + m * 16; const size_t off = (size_t)row * DM + col0; float ss = 0.f;
#pragma unroll
                for (int bj = 0; bj < 2; ++bj) { const f32x4 xa = *(const f32x4*)(base + off + bj * 128), xb = *(const f32x4*)(base + off + bj * 128 + 4);
                    const f32x4 v0 = acc[ai][bj][m][0] + xa, v1 = acc[ai][bj][m][1] + xb;
                    *(f32x4*)(out + off + bj * 128) = v0; *(f32x4*)(out + off + bj * 128 + 4) = v1;
                    if (outb) { u32x4 w; w.x = cvt_pk_bf16(v0[0], v0[1]); w.y = cvt_pk_bf16(v0[2], v0[3]); w.z = cvt_pk_bf16(v1[0], v1[1]); w.w = cvt_pk_bf16(v1[2], v1[3]); *(u32x4*)(outb + off + bj * 128) = w; }
                    ss += (v0[0] * v0[0] + v0[1] * v0[1]) + (v0[2] * v0[2] + v0[3] * v0[3]) + (v1[0] * v1[0] + v1[1] * v1[1]) + (v1[2] * v1[2] + v1[3] * v1[3]); }
                if (ssq) { ss += __shfl_xor(ss, 16); ss += __shfl_xor(ss, 32); if (fq == 0) atomicAdd(ssq + row, ss); } }
    }
};
__device__ __forceinline__ float gelu_tanh(float x) { const float z = 0.7978845608028654f * (x + 0.044715f * x * x * x); return x * __builtin_amdgcn_rcpf(1.0f + __expf(-2.0f * z)); }
__device__ __forceinline__ float rot16(float x, int lane, int n) { return __shfl(x, (lane & ~15) | ((lane - n) & 15)); }
struct EpiGateVal {
    static constexpr bool PERM = true, AFTER_DRAIN = false;
    bf16_t* ACT; const float* ssq2; const float* conv_w; const float* conv_b; const float* state_conv; float* UHL; float* UHF; float* out_vp; float* out_vs;
    __device__ __forceinline__ void operator()(const f32x4 (&acc)[2][2][4][2], const Unit& u, int wr, int wc, int fr, int fq) const {
        const int lane = threadIdx.x & 63;
        const int c0 = u.pn * 128 + wc * 32 + 8 * fq;
        float w0[8], w1[8], w2[8], cb[8];
#pragma unroll
        for (int e = 0; e < 8; ++e) { w0[e] = conv_w[c0 + e]; w1[e] = conv_w[DFF + c0 + e]; w2[e] = conv_w[2 * DFF + c0 + e]; cb[e] = conv_b[c0 + e]; }
        const bool sample = u.pm >= 64;
#pragma unroll
        for (int ai = 0; ai < 2; ++ai) {
            float r1p[8], r2p[8];
#pragma unroll
            for (int e = 0; e < 8; ++e) { r1p[e] = 0.f; r2p[e] = 0.f; }
#pragma unroll
            for (int m = 0; m < 4; ++m) { const int row = u.pm * 256 + ai * 128 + wr * 64 + m * 16 + fr;
                const float rs = rsqrtf(ssq2[row] * (1.f / DM) + EPS);
                float uu[8], vv[8], r1[8], r2[8];
#pragma unroll
                for (int e = 0; e < 8; ++e) { uu[e] = acc[ai][0][m][e >> 2][e & 3] * rs; vv[e] = acc[ai][1][m][e >> 2][e & 3] * rs; }
#pragma unroll
                for (int e = 0; e < 8; ++e) { r1[e] = rot16(uu[e], lane, 1); r2[e] = rot16(uu[e], lane, 2); }
                float p1[8], p2[8]; bool valid = true;
                if (!sample) {
#pragma unroll
                    for (int e = 0; e < 8; ++e) { p1[e] = fr >= 1 ? r1[e] : r1p[e]; p2[e] = fr >= 2 ? r2[e] : r2p[e]; }
                    if (m == 0 && fr < 2) { valid = false; const int gi = row >> 6; float* d = UHF + ((size_t)(gi * 2 + fr) * 2) * DFF + c0;
                        *(f32x4*)d = (f32x4){uu[0], uu[1], uu[2], uu[3]}; *(f32x4*)(d + 4) = (f32x4){uu[4], uu[5], uu[6], uu[7]};
                        *(f32x4*)(d + DFF) = (f32x4){vv[0], vv[1], vv[2], vv[3]}; *(f32x4*)(d + DFF + 4) = (f32x4){vv[4], vv[5], vv[6], vv[7]}; }
                    if (m == 3 && fr >= 14) { const int gi = row >> 6; float* d = UHL + (size_t)(gi * 2 + (fr - 14)) * DFF + c0;
                        *(f32x4*)d = (f32x4){uu[0], uu[1], uu[2], uu[3]}; *(f32x4*)(d + 4) = (f32x4){uu[4], uu[5], uu[6], uu[7]};
                        if ((row & 2047) >= 2046) { float* o = out_vp + (size_t)((row >> 11) * 2 + (fr - 14)) * DFF + c0;
                            *(f32x4*)o = (f32x4){uu[0], uu[1], uu[2], uu[3]}; *(f32x4*)(o + 4) = (f32x4){uu[4], uu[5], uu[6], uu[7]}; } }
                } else {
                    const int pos = fr & 7, b = (row - MPROMPT) >> 3; const float* sc = state_conv + (size_t)b * 2 * DFF + c0;
                    float b0[8], b1[8];
#pragma unroll
                    for (int e = 0; e < 8; ++e) { b0[e] = 0.f; b1[e] = 0.f; }
                    if (pos < 2) {
#pragma unroll
                        for (int e = 0; e < 8; ++e) { b0[e] = sc[e]; b1[e] = sc[DFF + e]; } }
#pragma unroll
                    for (int e = 0; e < 8; ++e) { p1[e] = pos >= 1 ? r1[e] : b1[e]; p2[e] = pos >= 2 ? r2[e] : (pos == 1 ? b1[e] : b0[e]); }
                    if (pos >= 6) { float* o = out_vs + (size_t)(b * 2 + (pos - 6)) * DFF + c0;
                        *(f32x4*)o = (f32x4){uu[0], uu[1], uu[2], uu[3]}; *(f32x4*)(o + 4) = (f32x4){uu[4], uu[5], uu[6], uu[7]}; }
                }
                if (valid) { float a[8];
#pragma unroll
                    for (int e = 0; e < 8; ++e) a[e] = gelu_tanh(cb[e] + w0[e] * p2[e] + w1[e] * p1[e] + w2[e] * uu[e]) * vv[e];
                    u32x4 w; w.x = cvt_pk_bf16(a[0], a[1]); w.y = cvt_pk_bf16(a[2], a[3]); w.z = cvt_pk_bf16(a[4], a[5]); w.w = cvt_pk_bf16(a[6], a[7]);
                    *(u32x4*)(ACT + (size_t)row * DFF + c0) = w; }
#pragma unroll
                for (int e = 0; e < 8; ++e) { r1p[e] = r1[e]; r2p[e] = r2[e]; }
            }
        }
    }
};
#ifndef LAS
#define LAS __attribute__((address_space(3)))
#endif
#define LDS_BARRIER() do { asm volatile("s_waitcnt lgkmcnt(0)" ::: "memory"); __builtin_amdgcn_s_barrier(); asm volatile("" ::: "memory"); } while (0)
typedef short bf16x8 __attribute__((ext_vector_type(8)));
constexpr int QT_OFF = 0, KT_OFF = 17408, KHT_OFF = 34816, VT_OFF = 53248, SW_OFF = 73984, ST_OFF = 83200, RAWV_OFF = 122368, SM_OFF = 138752;
constexpr int F_DLAST = 0, F_PTOT = 128, F_SG = 640, F_SM = 704, F_SWI = 768, F_SMT = 832, F_SWEND = 896, F_SDEN = 960, F_SSSQ = 1024, F_SCAL = 1152;
__device__ __forceinline__ bf16x8 ldfrag(const LAS unsigned char* base, int stride_b, int row, int kcol) { return *(const LAS bf16x8*)(base + row * stride_b + kcol * 2); }
__device__ __forceinline__ f32x4 mfma16(bf16x8 a, bf16x8 b, f32x4 c) { return __builtin_amdgcn_mfma_f32_16x16x32_bf16(a, b, c, 0, 0, 0); }
__device__ __forceinline__ u32x2 pack4(f32x4 v) { return (u32x2){cvt_pk_bf16(v[0], v[1]), cvt_pk_bf16(v[2], v[3])}; }

template <bool IS_ML>
__device__ __forceinline__ void mixer_item(const Params& p, LAS unsigned char* L, const int sqi, const int h, const bool prompt) {
    const int tid = threadIdx.x, w = __builtin_amdgcn_readfirstlane(tid >> 6), lane = tid & 63, l15 = lane & 15, q4 = lane >> 4;
    const int Lc = prompt ? 64 : 8, nch = prompt ? 32 : 1;
    const int row0 = prompt ? sqi * 2048 : MPROMPT + sqi * 8;
    const bf16_t* PROJ = (const bf16_t*)(p.ws + WS_R1) + (IS_ML ? 2048 : 0) + h * 128;
    bf16_t* AMIX = (bf16_t*)p.out + (size_t)MROWS * DM + (IS_ML ? 512 : 0) + h * 128;
    const float* GATES = (const float*)(p.ws + WS_GATES);
    LAS unsigned char* Qt = L + QT_OFF; LAS unsigned char* Kt = L + KT_OFF; LAS unsigned char* KhT = L + KHT_OFF; LAS unsigned char* VT = L + VT_OFF;
    LAS unsigned char* Sw = L + SW_OFF; LAS unsigned char* ST = L + ST_OFF; LAS unsigned char* rawV = L + RAWV_OFF; LAS float* sm = (LAS float*)(L + SM_OFF);
    constexpr int NV = IS_ML ? 9 : 8;
    const int tt = w & 3, vb = w >> 2;
    const size_t sbase = (size_t)(sqi * 4 + h) * 128 * 128;
    f32x4 sacc[NV];
    float m_prev = 0.f;
#pragma unroll
    for (int vt = 0; vt < NV; ++vt) sacc[vt] = (f32x4){0.f, 0.f, 0.f, 0.f};
    if (!prompt) {
        const float* S0 = IS_ML ? p.in[3] : p.in[2];
#pragma unroll
        for (int vt = 0; vt < 8; ++vt)
#pragma unroll
            for (int j = 0; j < 4; ++j) sacc[vt][j] = S0[sbase + (size_t)(w * 16 + q4 * 4 + j) * 128 + vt * 16 + l15];
        if (IS_ML) { m_prev = p.in[5][sqi * 4 + h];
            if (l15 == 0) {
#pragma unroll
                for (int j = 0; j < 4; ++j) sacc[NV - 1][j] = p.in[4][(size_t)(sqi * 4 + h) * 128 + w * 16 + q4 * 4 + j]; } }
    }
    float gnr[4][4];
    { const float* gn = (IS_ML ? p.in[13] : p.in[10]) + h * 128;
#pragma unroll
        for (int i = 0; i < 4; ++i)
#pragma unroll
            for (int j = 0; j < 4; ++j) gnr[i][j] = gn[(vb * 4 + i) * 16 + q4 * 4 + j]; }
    u32x4 rq[2], rk[2], rv[2];
    auto load_raw = [&](int c) {
#pragma unroll
        for (int i = 0; i < 2; ++i) { const int pc = tid + 512 * i, r = pc >> 4, c8 = pc & 15;
            if (r < Lc) { const bf16_t* src = PROJ + (size_t)(row0 + c * 64 + r) * NPROJ + c8 * 8;
                rq[i] = *(const u32x4*)src; rk[i] = *(const u32x4*)(src + 512); rv[i] = *(const u32x4*)(src + 1024); }
            else { rq[i] = (u32x4){0u, 0u, 0u, 0u}; rk[i] = rq[i]; rv[i] = rq[i]; } }
    };
    load_raw(0);
    LDS_BARRIER();
#pragma unroll
    for (int vt = 0; vt < NV; ++vt) *(LAS u32x2*)(ST + (vt * 16 + l15) * 272 + (w * 16 + q4 * 4) * 2) = pack4(sacc[vt]);
    if (IS_ML) { for (int i = tid; i < 16 * 72; i += 512) *(LAS unsigned short*)(VT + (128 * 72 + i) * 2) = (i < 72) ? (unsigned short)0x3F80 : (unsigned short)0; }
    for (int c = 0; c < nch; ++c) {
#pragma unroll
        for (int i = 0; i < 2; ++i) { const int pc = tid + 512 * i, r = pc >> 4, c8 = pc & 15;
            *(LAS u32x4*)(Qt + r * 272 + c8 * 16) = rq[i]; *(LAS u32x4*)(Kt + r * 272 + c8 * 16) = rk[i]; *(LAS u32x4*)(rawV + r * 256 + c8 * 16) = rv[i]; }
        if (IS_ML && w == 0) {
            const int t = lane; float lf = 0.f, ig = -INFINITY;
            if (t < Lc) { const float* gp = GATES + (size_t)(row0 + c * 64 + t) * 8; ig = gp[h]; lf = gp[4 + h]; }
            float a = lf;
#pragma unroll
            for (int o = 1; o < 64; o <<= 1) { const float x = __shfl_up(a, o); if (lane >= o) a += x; }
            const float g = ig - a; float cm = g;
#pragma unroll
            for (int o = 1; o < 64; o <<= 1) { const float x = __shfl_up(cm, o); if (lane >= o) cm = fmaxf(cm, x); }
            const float M = fmaxf(m_prev, cm), M63 = __shfl(M, 63), a63 = __shfl(a, 63);
            sm[F_SG + t] = g; sm[F_SM + t] = M; sm[F_SWI + t] = __expf(m_prev - M); sm[F_SMT + t] = a + M; sm[F_SWEND + t] = __expf(g - M63);
            if (lane == 0) { sm[F_SCAL + 0] = __expf(m_prev - M63); sm[F_SCAL + 1] = a63 + M63; }
        }
        LDS_BARRIER();
        if (c + 1 < nch) load_raw(c + 1);
        { const int k = tid & 127, part = tid >> 7; unsigned short kh[16];
            if (!IS_ML) {
                float lfv[16], cs[16]; float run = 0.f;
#pragma unroll
                for (int i = 0; i < 16; ++i) { lfv[i] = bf2f(*(const LAS unsigned short*)(Kt + (part * 16 + i) * 272 + k * 2)); run += lfv[i]; cs[i] = run; }
                sm[F_PTOT + part * 128 + k] = run;
                LDS_BARRIER();
                float pre = 0.f, tot = 0.f;
#pragma unroll
                for (int pp = 0; pp < 4; ++pp) { const float x = sm[F_PTOT + pp * 128 + k]; tot += x; if (pp < part) pre += x; }
                if (part == 0) sm[F_DLAST + k] = __expf(tot);
#pragma unroll
                for (int i = 0; i < 16; ++i) { const int s = part * 16 + i; const float b = pre + cs[i], e = __expf(b), r = __builtin_amdgcn_rcpf(e), kk = 1.f - __expf(lfv[i]);
                    LAS unsigned short* qp = (LAS unsigned short*)(Qt + s * 272 + k * 2); *qp = f2bf(bf2f(*qp) * e);
                    *(LAS unsigned short*)(Kt + s * 272 + k * 2) = f2bf(kk * r); kh[i] = f2bf(kk * __expf(tot - b)); }
            } else {
#pragma unroll
                for (int i = 0; i < 16; ++i) { const int s = part * 16 + i; kh[i] = f2bf(bf2f(*(const LAS unsigned short*)(Kt + s * 272 + k * 2)) * sm[F_SWEND + s]); }
            }
            u32x4 w0, w1;
            w0.x = kh[0] | ((unsigned)kh[1] << 16); w0.y = kh[2] | ((unsigned)kh[3] << 16); w0.z = kh[4] | ((unsigned)kh[5] << 16); w0.w = kh[6] | ((unsigned)kh[7] << 16);
            w1.x = kh[8] | ((unsigned)kh[9] << 16); w1.y = kh[10] | ((unsigned)kh[11] << 16); w1.z = kh[12] | ((unsigned)kh[13] << 16); w1.w = kh[14] | ((unsigned)kh[15] << 16);
            *(LAS u32x4*)(KhT + k * 144 + part * 32) = w0; *(LAS u32x4*)(KhT + k * 144 + part * 32 + 16) = w1;
            unsigned short vv[16];
#pragma unroll
            for (int i = 0; i < 16; ++i) vv[i] = *(const LAS unsigned short*)(rawV + (part * 16 + i) * 256 + k * 2);
            w0.x = vv[0] | ((unsigned)vv[1] << 16); w0.y = vv[2] | ((unsigned)vv[3] << 16); w0.z = vv[4] | ((unsigned)vv[5] << 16); w0.w = vv[6] | ((unsigned)vv[7] << 16);
            w1.x = vv[8] | ((unsigned)vv[9] << 16); w1.y = vv[10] | ((unsigned)vv[11] << 16); w1.z = vv[12] | ((unsigned)vv[13] << 16); w1.w = vv[14] | ((unsigned)vv[15] << 16);
            *(LAS u32x4*)(VT + k * 144 + part * 32) = w0; *(LAS u32x4*)(VT + k * 144 + part * 32 + 16) = w1;
        }
        LDS_BARRIER();
        { const int pt = w >> 1;
#pragma unroll
            for (int e = 0; e < 2; ++e) { const int st = 2 * (w & 1) + e; f32x4 pa = (f32x4){0.f, 0.f, 0.f, 0.f};
                if (st <= pt) {
#pragma unroll
                    for (int ks = 0; ks < 4; ++ks) pa = mfma16(ldfrag(Kt, 272, st * 16 + l15, ks * 32 + q4 * 8), ldfrag(Qt, 272, pt * 16 + l15, ks * 32 + q4 * 8), pa); }
                const int t = pt * 16 + l15, s0 = st * 16 + q4 * 4; const float Mt = IS_ML ? sm[F_SM + t] : 0.f;
#pragma unroll
                for (int j = 0; j < 4; ++j) { const int s = s0 + j; float x = pa[j]; if (IS_ML) x *= __expf(sm[F_SG + s] - Mt); pa[j] = (s <= t) ? x : 0.f; }
                *(LAS u32x2*)(Sw + t * 144 + s0 * 2) = pack4(pa); } }
        f32x4 oacc[5];
        { bf16x8 bq[4];
#pragma unroll
            for (int ks = 0; ks < 4; ++ks) bq[ks] = ldfrag(Qt, 272, tt * 16 + l15, ks * 32 + q4 * 8);
            const float wi = IS_ML ? sm[F_SWI + tt * 16 + l15] : 1.f;
#pragma unroll
            for (int i = 0; i < 5; ++i) { oacc[i] = (f32x4){0.f, 0.f, 0.f, 0.f};
                if (i < 4 || (IS_ML && vb == 1)) { const int vt = i < 4 ? vb * 4 + i : 8;
#pragma unroll
                    for (int ks = 0; ks < 4; ++ks) oacc[i] = mfma16(ldfrag(ST, 272, vt * 16 + l15, ks * 32 + q4 * 8), bq[ks], oacc[i]);
                    if (IS_ML) oacc[i] = oacc[i] * wi; } } }
        LDS_BARRIER();
        { bf16x8 bs[2];
#pragma unroll
            for (int ks = 0; ks < 2; ++ks) bs[ks] = ldfrag(Sw, 144, tt * 16 + l15, ks * 32 + q4 * 8);
#pragma unroll
            for (int i = 0; i < 5; ++i) if (i < 4 || (IS_ML && vb == 1)) { const int vt = i < 4 ? vb * 4 + i : 8;
#pragma unroll
                for (int ks = 0; ks < 2; ++ks) oacc[i] = mfma16(ldfrag(VT, 144, vt * 16 + l15, ks * 32 + q4 * 8), bs[ks], oacc[i]); } }
        { bf16x8 ak[2];
#pragma unroll
            for (int ks = 0; ks < 2; ++ks) ak[ks] = ldfrag(KhT, 144, w * 16 + l15, ks * 32 + q4 * 8);
            f32x4 dl;
            if (IS_ML) { const float fe = sm[F_SCAL + 0]; dl = (f32x4){fe, fe, fe, fe}; m_prev = sm[F_SCAL + 1]; }
            else dl = *(const LAS f32x4*)(sm + F_DLAST + w * 16 + q4 * 4);
#pragma unroll
            for (int vt = 0; vt < NV; ++vt) { sacc[vt] = sacc[vt] * dl;
#pragma unroll
                for (int ks = 0; ks < 2; ++ks) sacc[vt] = mfma16(ak[ks], ldfrag(VT, 144, vt * 16 + l15, ks * 32 + q4 * 8), sacc[vt]);
                *(LAS u32x2*)(ST + (vt * 16 + l15) * 272 + (w * 16 + q4 * 4) * 2) = pack4(sacc[vt]); } }
        const int t = tt * 16 + l15;
        if (IS_ML) {
            if (vb == 1 && q4 == 0) sm[F_SDEN + t] = oacc[4][0];
            LDS_BARRIER();
            const float inv = 1.0f / fmaxf(fabsf(sm[F_SDEN + t]), __expf(-sm[F_SMT + t]));
#pragma unroll
            for (int i = 0; i < 4; ++i) oacc[i] = oacc[i] * inv;
        }
        float ss = 0.f;
#pragma unroll
        for (int i = 0; i < 4; ++i) ss += (oacc[i][0] * oacc[i][0] + oacc[i][1] * oacc[i][1]) + (oacc[i][2] * oacc[i][2] + oacc[i][3] * oacc[i][3]);
        ss += __shfl_xor(ss, 16); ss += __shfl_xor(ss, 32);
        if (q4 == 0) sm[F_SSSQ + t * 2 + vb] = ss;
        LDS_BARRIER();
        if (t < Lc) { const float rs = rsqrtf((sm[F_SSSQ + t * 2] + sm[F_SSSQ + t * 2 + 1]) * (1.f / 128.f) + EPS);
            const size_t row = (size_t)row0 + c * 64 + t;
#pragma unroll
            for (int i = 0; i < 4; ++i) { const int v0 = (vb * 4 + i) * 16 + q4 * 4; const u32x2 gt = *(const u32x2*)(PROJ + row * NPROJ + 1536 + v0);
                f32x4 o; o[0] = oacc[i][0] * rs * gnr[i][0] * __uint_as_float(gt.x << 16); o[1] = oacc[i][1] * rs * gnr[i][1] * __uint_as_float(gt.x & 0xffff0000u);
                o[2] = oacc[i][2] * rs * gnr[i][2] * __uint_as_float(gt.y << 16); o[3] = oacc[i][3] * rs * gnr[i][3] * __uint_as_float(gt.y & 0xffff0000u);
                *(u32x2*)(AMIX + row * DM + v0) = pack4(o); } }
    }
    { float* So = p.out + (IS_ML ? (prompt ? O_CP : O_CS) : (prompt ? O_SP : O_SS));
#pragma unroll
        for (int vt = 0; vt < 8; ++vt)
#pragma unroll
            for (int j = 0; j < 4; ++j) So[sbase + (size_t)(w * 16 + q4 * 4 + j) * 128 + vt * 16 + l15] = sacc[vt][j];
        if (IS_ML) { if (l15 == 0) { float* no = p.out + (prompt ? O_NP : O_NS) + (size_t)(sqi * 4 + h) * 128;
#pragma unroll
                for (int j = 0; j < 4; ++j) no[w * 16 + q4 * 4 + j] = sacc[NV - 1][j]; }
            if (tid == 0) p.out[(prompt ? O_MP : O_MS) + sqi * 4 + h] = m_prev; } }
}
__device__ __forceinline__ void mixer_dispatch(const Params& p, LAS unsigned char* L, int it) {
    int g, sqi, h; const bool prompt = it < 64;
    if (prompt) { g = it >> 5; sqi = (it >> 2) & 7; h = it & 3; } else { const int j = it - 64; g = j >> 9; sqi = (j >> 2) & 127; h = j & 3; }
    if (g == 0) mixer_item<false>(p, L, sqi, h, prompt); else mixer_item<true>(p, L, sqi, h, prompt);
}
__device__ __forceinline__ void phase2_chunked(const Params& p, LAS unsigned char* L) {
    const int G = gridDim.x, b = blockIdx.x;
    if (G > 64) { if (b < 64) mixer_dispatch(p, L, b); else for (int it = b; it < 1088; it += G - 64) mixer_dispatch(p, L, it); }
    else for (int it = b; it < 1088; it += G) mixer_dispatch(p, L, it);
}
constexpr size_t WS_SB = WS_X1;
template <bool IS_ML>
__device__ __forceinline__ void prepass_item(const Params& p, LAS unsigned char* L, const int sqi, const int c, const int h, u32x4 (&rq)[2], u32x4 (&rk)[2], u32x4 (&rv)[2], float& gig, float& glf,
                                             const bf16_t* nsrc, const float* ngates) {
    const int tid = threadIdx.x, w = __builtin_amdgcn_readfirstlane(tid >> 6), lane = tid & 63, l15 = lane & 15, q4 = lane >> 4;
    const int row0 = sqi * 2048 + c * 64;
    bf16_t* PROJ = (bf16_t*)(p.ws + WS_R1) + (IS_ML ? 2048 : 0) + h * 128;
    bf16_t* AMIX = (bf16_t*)p.out + (size_t)MROWS * DM + (IS_ML ? 512 : 0) + h * 128;
    float* SB = (float*)(p.ws + WS_SB) + (size_t)((((IS_ML ? 8 : 0) + sqi) * 32 + c) * 4 + h) * 256;
    LAS unsigned char* Qt = L + QT_OFF; LAS unsigned char* Kt = L + KT_OFF; LAS unsigned char* KhT = L + KHT_OFF; LAS unsigned char* VT = L + VT_OFF;
    LAS unsigned char* Sw = L + SW_OFF; LAS unsigned char* rawV = L + RAWV_OFF; LAS float* sm = (LAS float*)(L + SM_OFF);
    const int tt = w & 3, vb = w >> 2;
    LDS_BARRIER();
    if (IS_ML) { for (int i = tid; i < 16 * 72; i += 512) *(LAS unsigned short*)(VT + (128 * 72 + i) * 2) = (i < 72) ? (unsigned short)0x3F80 : (unsigned short)0; }
#pragma unroll
    for (int i = 0; i < 2; ++i) { const int pc = tid + 512 * i, r = pc >> 4, c8 = pc & 15;
        *(LAS u32x4*)(Qt + r * 272 + c8 * 16) = rq[i]; *(LAS u32x4*)(Kt + r * 272 + c8 * 16) = rk[i]; *(LAS u32x4*)(rawV + r * 256 + c8 * 16) = rv[i]; }
    if (IS_ML && w == 0) {
        const int t = lane; const float ig = gig, lf = glf;
        float a = lf;
#pragma unroll
        for (int o = 1; o < 64; o <<= 1) { const float x = __shfl_up(a, o); if (lane >= o) a += x; }
        const float g = ig - a; float cm = g;
#pragma unroll
        for (int o = 1; o < 64; o <<= 1) { const float x = __shfl_up(cm, o); if (lane >= o) cm = fmaxf(cm, x); }
        const float M63 = __shfl(cm, 63);
        sm[F_SG + t] = g; sm[F_SM + t] = cm; sm[F_SWEND + t] = __expf(g - M63);
        SB[64 + t] = cm; SB[128 + t] = a;
    }
    if (nsrc) {
#pragma unroll
        for (int i = 0; i < 2; ++i) { const int pc = tid + 512 * i, r = pc >> 4, c8 = pc & 15; const bf16_t* src = nsrc + (size_t)r * NPROJ + c8 * 8;
            rq[i] = *(const u32x4*)src; rk[i] = *(const u32x4*)(src + 512); rv[i] = *(const u32x4*)(src + 1024); }
        if (ngates && w == 0) { gig = ngates[lane * 8]; glf = ngates[lane * 8 + 4]; } }
    LDS_BARRIER();
    { const int k = tid & 127, part = tid >> 7; unsigned short kh[16];
        if (!IS_ML) {
            float lfv[16], cs[16]; float run = 0.f;
#pragma unroll
            for (int i = 0; i < 16; ++i) { lfv[i] = bf2f(*(const LAS unsigned short*)(Kt + (part * 16 + i) * 272 + k * 2)); run += lfv[i]; cs[i] = run; }
            sm[F_PTOT + part * 128 + k] = run;
            LDS_BARRIER();
            float pre = 0.f, tot = 0.f;
#pragma unroll
            for (int pp = 0; pp < 4; ++pp) { const float x = sm[F_PTOT + pp * 128 + k]; tot += x; if (pp < part) pre += x; }
            if (part == 0) SB[k] = __expf(tot);
#pragma unroll
            for (int i = 0; i < 16; ++i) { const int s = part * 16 + i; const float b = pre + cs[i], e = __expf(b), r = __builtin_amdgcn_rcpf(e), kk = 1.f - __expf(lfv[i]);
                LAS unsigned short* qp = (LAS unsigned short*)(Qt + s * 272 + k * 2); *qp = f2bf(bf2f(*qp) * e);
                *(LAS unsigned short*)(Kt + s * 272 + k * 2) = f2bf(kk * r); kh[i] = f2bf(kk * __expf(tot - b)); }
        } else {
#pragma unroll
            for (int i = 0; i < 16; ++i) { const int s = part * 16 + i; kh[i] = f2bf(bf2f(*(const LAS unsigned short*)(Kt + s * 272 + k * 2)) * sm[F_SWEND + s]); }
        }
        u32x4 w0, w1;
        w0.x = kh[0] | ((unsigned)kh[1] << 16); w0.y = kh[2] | ((unsigned)kh[3] << 16); w0.z = kh[4] | ((unsigned)kh[5] << 16); w0.w = kh[6] | ((unsigned)kh[7] << 16);
        w1.x = kh[8] | ((unsigned)kh[9] << 16); w1.y = kh[10] | ((unsigned)kh[11] << 16); w1.z = kh[12] | ((unsigned)kh[13] << 16); w1.w = kh[14] | ((unsigned)kh[15] << 16);
        *(LAS u32x4*)(KhT + k * 144 + part * 32) = w0; *(LAS u32x4*)(KhT + k * 144 + part * 32 + 16) = w1;
        unsigned short vv[16];
#pragma unroll
        for (int i = 0; i < 16; ++i) vv[i] = *(const LAS unsigned short*)(rawV + (part * 16 + i) * 256 + k * 2);
        w0.x = vv[0] | ((unsigned)vv[1] << 16); w0.y = vv[2] | ((unsigned)vv[3] << 16); w0.z = vv[4] | ((unsigned)vv[5] << 16); w0.w = vv[6] | ((unsigned)vv[7] << 16);
        w1.x = vv[8] | ((unsigned)vv[9] << 16); w1.y = vv[10] | ((unsigned)vv[11] << 16); w1.z = vv[12] | ((unsigned)vv[13] << 16); w1.w = vv[14] | ((unsigned)vv[15] << 16);
        *(LAS u32x4*)(VT + k * 144 + part * 32) = w0; *(LAS u32x4*)(VT + k * 144 + part * 32 + 16) = w1;
    }
    LDS_BARRIER();
    { const int pt = w >> 1;
#pragma unroll
        for (int e = 0; e < 2; ++e) { const int st = 2 * (w & 1) + e; f32x4 pa = (f32x4){0.f, 0.f, 0.f, 0.f};
            if (st <= pt) {
#pragma unroll
                for (int ks = 0; ks < 4; ++ks) pa = mfma16(ldfrag(Kt, 272, st * 16 + l15, ks * 32 + q4 * 8), ldfrag(Qt, 272, pt * 16 + l15, ks * 32 + q4 * 8), pa); }
            const int t = pt * 16 + l15, s0 = st * 16 + q4 * 4; const float Mt = IS_ML ? sm[F_SM + t] : 0.f;
#pragma unroll
            for (int j = 0; j < 4; ++j) { const int s = s0 + j; float x = pa[j]; if (IS_ML) x *= __expf(sm[F_SG + s] - Mt); pa[j] = (s <= t) ? x : 0.f; }
            *(LAS u32x2*)(Sw + t * 144 + s0 * 2) = pack4(pa); } }
#pragma unroll
    for (int i = 0; i < 2; ++i) { const int pc = tid + 512 * i;
        if (!IS_ML) { const int r = pc >> 4, c8 = pc & 15; *(u32x4*)(PROJ + (size_t)(row0 + r) * NPROJ + c8 * 8) = *(const LAS u32x4*)(Qt + r * 272 + c8 * 16); }
        const int k = pc >> 3, s8 = pc & 7; bf16_t* dst = PROJ + (size_t)(row0 + (k >> 1)) * NPROJ + (k & 1) * 64 + s8 * 8;
        *(u32x4*)(dst + 512) = *(const LAS u32x4*)(KhT + k * 144 + s8 * 16); *(u32x4*)(dst + 1024) = *(const LAS u32x4*)(VT + k * 144 + s8 * 16); }
    LDS_BARRIER();
    { bf16x8 bs[2];
#pragma unroll
        for (int ks = 0; ks < 2; ++ks) bs[ks] = ldfrag(Sw, 144, tt * 16 + l15, ks * 32 + q4 * 8);
#pragma unroll
        for (int i = 0; i < 5; ++i) if (i < 4 || (IS_ML && vb == 1)) { const int vt = i < 4 ? vb * 4 + i : 8; f32x4 o = (f32x4){0.f, 0.f, 0.f, 0.f};
#pragma unroll
            for (int ks = 0; ks < 2; ++ks) o = mfma16(ldfrag(VT, 144, vt * 16 + l15, ks * 32 + q4 * 8), bs[ks], o);
            const int t = tt * 16 + l15;
            if (i < 4) *(u32x2*)(AMIX + (size_t)(row0 + t) * DM + vt * 16 + q4 * 4) = pack4(o);
            else if (q4 == 0) SB[t] = o[0]; } }
}
constexpr int C_QT = 0, C_KHT = 17408, C_VT = 35840, C_ST0 = 56576, C_ST1 = 95744, C_SM = 134912;
constexpr int CF_WI = 0, CF_RHO = 64, CF_DEN = 128, CF_EMT = 192, CF_SCAL = 256, CF_SSSQ = 272;
template <bool IS_ML>
__device__ __forceinline__ void chain_run(const Params& p, LAS unsigned char* L, const int sqi, const int h, const bool write_out = true) {
    const int tid = threadIdx.x, w = __builtin_amdgcn_readfirstlane(tid >> 6), lane = tid & 63, l15 = lane & 15, q4 = lane >> 4;
    const int row0 = sqi * 2048;
    const bf16_t* PROJ = (const bf16_t*)(p.ws + WS_R1) + (IS_ML ? 2048 : 0) + h * 128;
    bf16_t* AMIX = (bf16_t*)p.out + (size_t)MROWS * DM + (IS_ML ? 512 : 0) + h * 128;
    const float* SB0 = (const float*)(p.ws + WS_SB) + (size_t)((((IS_ML ? 8 : 0) + sqi) * 32) * 4 + h) * 256;
    LAS unsigned char* Qt = L + C_QT; LAS unsigned char* KhT = L + C_KHT; LAS unsigned char* VT = L + C_VT; LAS float* sm = (LAS float*)(L + C_SM);
    constexpr int NV = IS_ML ? 9 : 8;
    const int tt = w & 3, vb = w >> 2, t = tt * 16 + l15;
    const size_t sbase = (size_t)(sqi * 4 + h) * 128 * 128;
    f32x4 sacc[NV];
#pragma unroll
    for (int vt = 0; vt < NV; ++vt) sacc[vt] = (f32x4){0.f, 0.f, 0.f, 0.f};
    float m_prev = 0.f;
    const float* gn = (IS_ML ? p.in[13] : p.in[10]) + h * 128;
    u32x4 rq[2], rk[2], rv[2]; u32x2 rin[4], rgt[4]; f32x4 dl = (f32x4){0.f, 0.f, 0.f, 0.f}; float s_den = 0.f, s_ml = 0.f, s_a = 0.f;
    auto prefetch_big = [&](int c) {
#pragma unroll
        for (int i = 0; i < 2; ++i) { const int pc = tid + 512 * i; const int r = pc >> 4, c8 = pc & 15;
            rq[i] = *(const u32x4*)(PROJ + (size_t)(row0 + c * 64 + r) * NPROJ + c8 * 8);
            const int k = pc >> 3, s8 = pc & 7; const bf16_t* src = PROJ + (size_t)(row0 + c * 64 + (k >> 1)) * NPROJ + (k & 1) * 64 + s8 * 8;
            rk[i] = *(const u32x4*)(src + 512); rv[i] = *(const u32x4*)(src + 1024); }
    };
    auto prefetch_io = [&](int c) {
        const size_t row = (size_t)row0 + c * 64 + t;
#pragma unroll
        for (int i = 0; i < 4; ++i) { const int v0 = (vb * 4 + i) * 16 + q4 * 4; rin[i] = *(const u32x2*)(AMIX + row * DM + v0); rgt[i] = *(const u32x2*)(PROJ + row * NPROJ + 1536 + v0); }
    };
    auto prefetch_sb = [&](int c, f32x4& dl_, float& d_, float& ml_, float& a_) {
        const float* sb = SB0 + (size_t)c * 1024;
        if (!IS_ML) dl_ = *(const f32x4*)(sb + w * 16 + q4 * 4);
        else if (w == 0) { d_ = sb[lane]; ml_ = sb[64 + lane]; a_ = sb[128 + lane]; }
    };
    prefetch_big(0); prefetch_io(0); prefetch_sb(0, dl, s_den, s_ml, s_a);
    LDS_BARRIER();
#pragma unroll
    for (int vt = 0; vt < NV; ++vt) *(LAS u32x2*)(L + C_ST0 + (vt * 16 + l15) * 272 + (w * 16 + q4 * 4) * 2) = (u32x2){0u, 0u};
    if (IS_ML) { for (int i = tid; i < 16 * 72; i += 512) *(LAS unsigned short*)(VT + (128 * 72 + i) * 2) = (i < 72) ? (unsigned short)0x3F80 : (unsigned short)0; }
    for (int c = 0; c < 32; ++c) {
        LAS unsigned char* STr = L + ((c & 1) ? C_ST1 : C_ST0); LAS unsigned char* STw = L + ((c & 1) ? C_ST0 : C_ST1);
#pragma unroll
        for (int i = 0; i < 2; ++i) { const int pc = tid + 512 * i; const int r = pc >> 4, c8 = pc & 15, k = pc >> 3, s8 = pc & 7;
            *(LAS u32x4*)(Qt + r * 272 + c8 * 16) = rq[i]; *(LAS u32x4*)(KhT + k * 144 + s8 * 16) = rk[i]; *(LAS u32x4*)(VT + k * 144 + s8 * 16) = rv[i]; }
        if (IS_ML && w == 0) {
            const float M = fmaxf(m_prev, s_ml), M63 = __shfl(M, 63), ml63 = __shfl(s_ml, 63), a63 = __shfl(s_a, 63);
            sm[CF_WI + lane] = __expf(m_prev - M); sm[CF_RHO + lane] = __expf(s_ml - M); sm[CF_DEN + lane] = s_den; sm[CF_EMT + lane] = __expf(-(s_a + M));
            if (lane == 0) { sm[CF_SCAL + 0] = __expf(m_prev - M63); sm[CF_SCAL + 1] = __expf(ml63 - M63); sm[CF_SCAL + 2] = a63 + M63; }
        }
        LDS_BARRIER();
        f32x4 ndl = dl; float n_den = 0.f, n_ml = 0.f, n_a = 0.f;
        if (c + 1 < 32) { prefetch_big(c + 1); prefetch_sb(c + 1, ndl, n_den, n_ml, n_a); }
        float wi_t = 1.f, rho_t = 1.f, denl_t = 0.f, emt_t = 0.f, fend = 1.f, sigma = 1.f;
        if (IS_ML) { wi_t = sm[CF_WI + t]; rho_t = sm[CF_RHO + t]; denl_t = sm[CF_DEN + t]; emt_t = sm[CF_EMT + t]; fend = sm[CF_SCAL + 0]; sigma = sm[CF_SCAL + 1]; m_prev = sm[CF_SCAL + 2]; }
        f32x4 oacc[5];
        { bf16x8 bq[4];
#pragma unroll
            for (int ks = 0; ks < 4; ++ks) bq[ks] = ldfrag(Qt, 272, tt * 16 + l15, ks * 32 + q4 * 8);
#pragma unroll
            for (int i = 0; i < 5; ++i) { oacc[i] = (f32x4){0.f, 0.f, 0.f, 0.f};
                if (i < 4 || IS_ML) { const int vt = i < 4 ? vb * 4 + i : 8;
#pragma unroll
                    for (int ks = 0; ks < 4; ++ks) oacc[i] = mfma16(ldfrag(STr, 272, vt * 16 + l15, ks * 32 + q4 * 8), bq[ks], oacc[i]); } } }
        { bf16x8 ak[2];
#pragma unroll
            for (int ks = 0; ks < 2; ++ks) ak[ks] = ldfrag(KhT, 144, w * 16 + l15, ks * 32 + q4 * 8);
#pragma unroll
            for (int vt = 0; vt < NV; ++vt) {
                if (!IS_ML) { sacc[vt] = sacc[vt] * dl;
#pragma unroll
                    for (int ks = 0; ks < 2; ++ks) sacc[vt] = mfma16(ak[ks], ldfrag(VT, 144, vt * 16 + l15, ks * 32 + q4 * 8), sacc[vt]); }
                else { f32x4 uacc = (f32x4){0.f, 0.f, 0.f, 0.f};
#pragma unroll
                    for (int ks = 0; ks < 2; ++ks) uacc = mfma16(ak[ks], ldfrag(VT, 144, vt * 16 + l15, ks * 32 + q4 * 8), uacc);
                    sacc[vt] = sacc[vt] * fend + uacc * sigma; }
                *(LAS u32x2*)(STw + (vt * 16 + l15) * 272 + (w * 16 + q4 * 4) * 2) = pack4(sacc[vt]); } }
        float inv = 1.f;
        if (IS_ML) { const float di = __shfl(oacc[4][0], l15); inv = 1.0f / fmaxf(fabsf(wi_t * di + rho_t * denl_t), emt_t); }
        float ss = 0.f;
#pragma unroll
        for (int i = 0; i < 4; ++i) { f32x4 in; in[0] = __uint_as_float(rin[i].x << 16); in[1] = __uint_as_float(rin[i].x & 0xffff0000u); in[2] = __uint_as_float(rin[i].y << 16); in[3] = __uint_as_float(rin[i].y & 0xffff0000u);
            if (IS_ML) oacc[i] = (oacc[i] * wi_t + in * rho_t) * inv; else oacc[i] = oacc[i] + in;
            ss += (oacc[i][0] * oacc[i][0] + oacc[i][1] * oacc[i][1]) + (oacc[i][2] * oacc[i][2] + oacc[i][3] * oacc[i][3]); }
        ss += __shfl_xor(ss, 16); ss += __shfl_xor(ss, 32);
        LAS float* sq = sm + CF_SSSQ + (c & 1) * 128;
        if (q4 == 0) sq[t * 2 + vb] = ss;
        LDS_BARRIER();
        { const float rs = rsqrtf((sq[t * 2] + sq[t * 2 + 1]) * (1.f / 128.f) + EPS); const size_t row = (size_t)row0 + c * 64 + t;
#pragma unroll
            for (int i = 0; i < 4; ++i) { const int v0 = (vb * 4 + i) * 16 + q4 * 4; const u32x2 gt = rgt[i];
                const f32x4 gv = *(const f32x4*)(gn + v0);
                f32x4 o; o[0] = oacc[i][0] * rs * gv[0] * __uint_as_float(gt.x << 16); o[1] = oacc[i][1] * rs * gv[1] * __uint_as_float(gt.x & 0xffff0000u);
                o[2] = oacc[i][2] * rs * gv[2] * __uint_as_float(gt.y << 16); o[3] = oacc[i][3] * rs * gv[3] * __uint_as_float(gt.y & 0xffff0000u);
                if (write_out) *(u32x2*)(AMIX + row * DM + v0) = pack4(o); } }
        if (c + 1 < 32) prefetch_io(c + 1);
        dl = ndl; s_den = n_den; s_ml = n_ml; s_a = n_a;
    }
    { float* So = p.out + (IS_ML ? O_CP : O_SP);
#pragma unroll
        for (int vt = 0; vt < 8; ++vt)
#pragma unroll
            for (int j = 0; j < 4; ++j) So[sbase + (size_t)(w * 16 + q4 * 4 + j) * 128 + vt * 16 + l15] = sacc[vt][j];
        if (IS_ML) { if (l15 == 0) { float* no = p.out + O_NP + (size_t)(sqi * 4 + h) * 128;
#pragma unroll
                for (int j = 0; j < 4; ++j) no[w * 16 + q4 * 4 + j] = sacc[NV - 1][j]; }
            if (tid == 0) p.out[O_MP + sqi * 4 + h] = m_prev; } }
}
#ifndef SAMPLE_TWICE
#define SAMPLE_TWICE 0
#endif
#ifndef SAMPLE_TWICE
#define SAMPLE_TWICE 0
#endif
#ifndef CHAIN_TWICE
#define CHAIN_TWICE 0
#endif
#ifndef NS_A
#define NS_A 256
#endif
__device__ __forceinline__ void sample_dispatch(const Params& p, LAS unsigned char* L, int j) {
    const int g = j >> 9, sqi = (j >> 2) & 127, h = j & 3;
    if (g == 0) mixer_item<false>(p, L, sqi, h, false); else mixer_item<true>(p, L, sqi, h, false);
}
__device__ __forceinline__ void phase2a(const Params& p, LAS unsigned char* L) {
    const int tid = threadIdx.x, lane = tid & 63, w = tid >> 6;
    u32x4 rq[2], rk[2], rv[2]; float gig = 0.f, glf = 0.f;
    auto slot = [&](int it) -> const bf16_t* { const int g = it >> 10, sqi = (it >> 7) & 7, c = (it >> 2) & 31, h = it & 3; return (const bf16_t*)(p.ws + WS_R1) + (size_t)(sqi * 2048 + c * 64) * NPROJ + (g ? 2048 : 0) + h * 128; };
    auto gptr = [&](int it) -> const float* { const int g = it >> 10, sqi = (it >> 7) & 7, c = (it >> 2) & 31, h = it & 3; return g ? (const float*)(p.ws + WS_GATES) + (size_t)(sqi * 2048 + c * 64) * 8 + h : nullptr; };
    int it = blockIdx.x;
    if (it < 2048) { const bf16_t* s0 = slot(it);
#pragma unroll
        for (int i = 0; i < 2; ++i) { const int pc = tid + 512 * i, r = pc >> 4, c8 = pc & 15; const bf16_t* src = s0 + (size_t)r * NPROJ + c8 * 8;
            rq[i] = *(const u32x4*)src; rk[i] = *(const u32x4*)(src + 512); rv[i] = *(const u32x4*)(src + 1024); }
        const float* g0 = gptr(it); if (g0 && w == 0) { gig = g0[lane * 8]; glf = g0[lane * 8 + 4]; } }
    for (; it < 2048; it += gridDim.x) { const int g = it >> 10, sqi = (it >> 7) & 7, c = (it >> 2) & 31, h = it & 3; const int nx = it + gridDim.x;
        const bf16_t* ns = nx < 2048 ? slot(nx) : nullptr; const float* ng = nx < 2048 ? gptr(nx) : nullptr;
        if (g == 0) prepass_item<false>(p, L, sqi, c, h, rq, rk, rv, gig, glf, ns, ng); else prepass_item<true>(p, L, sqi, c, h, rq, rk, rv, gig, glf, ns, ng); }
}
__device__ __forceinline__ void phase2a_samples(const Params& p, LAS unsigned char* L) {
    for (int it = 2048 + blockIdx.x; it < 2048 + NS_A; it += gridDim.x) { sample_dispatch(p, L, it - 2048); if (SAMPLE_TWICE) sample_dispatch(p, L, it - 2048); }
}
__device__ __forceinline__ void phase2_naive(const Params& p, unsigned char* shm) {
    float* sq = (float*)shm; float* sd = sq + 128; float* si = sd + 128; float* sv = si + 128; float* part = sv + 128; float* denp = part + 512; float* red = denp + 4;
    const int tid = threadIdx.x, v = tid & 127, kq = tid >> 7;
    const bf16_t* PROJ = (const bf16_t*)(p.ws + WS_R1); bf16_t* AMIX = (bf16_t*)p.out + (size_t)MROWS * DM; const float* GATES = (const float*)(p.ws + WS_GATES);
    for (int it = blockIdx.x; it < 1088; it += gridDim.x) {
        int g, sqi, h, T, row0; const bool prompt = it < 64;
        if (prompt) { g = it >> 5; sqi = (it >> 2) & 7; h = it & 3; T = 2048; row0 = sqi * 2048; }
        else { const int j = it - 64; g = j >> 9; sqi = (j >> 2) & 127; h = j & 3; T = 8; row0 = MPROMPT + sqi * 8; }
        float S[32], nst[32]; float mst = 0.f;
        const size_t sbase = ((size_t)(sqi * 4 + h) * 128) * 128;
#pragma unroll
        for (int i = 0; i < 32; ++i) { S[i] = 0.f; nst[i] = 0.f; }
        if (!prompt) { const float* S0 = g == 0 ? p.in[2] : p.in[3];
#pragma unroll
            for (int i = 0; i < 32; ++i) S[i] = S0[sbase + (size_t)(kq * 32 + i) * 128 + v];
            if (g == 1) { mst = p.in[5][sqi * 4 + h];
#pragma unroll
                for (int i = 0; i < 32; ++i) nst[i] = p.in[4][(size_t)(sqi * 4 + h) * 128 + kq * 32 + i]; } }
        const float* gn = (g == 0 ? p.in[10] : p.in[13]) + h * 128;
        for (int t = 0; t < T; ++t) {
            const size_t row = (size_t)row0 + t; const bf16_t* pr = PROJ + row * NPROJ + g * 2048 + h * 128;
            float m_new = 0.f;
            if (g == 0) {
                if (tid < 128) sq[tid] = bf2f(pr[tid]);
                else if (tid < 256) { const float f = __expf(bf2f(pr[512 + tid - 128])); sd[tid - 128] = f; si[tid - 128] = 1.f - f; }
                else if (tid < 384) sv[tid - 256] = bf2f(pr[1024 + tid - 256]);
            } else {
                const float ig = GATES[row * 8 + h], lf = GATES[row * 8 + 4 + h];
                m_new = fmaxf(lf + mst, ig); const float fd = __expf(lf + mst - m_new), ii = __expf(ig - m_new);
                if (tid < 128) sq[tid] = bf2f(pr[tid]);
                else if (tid < 256) { sd[tid - 128] = fd; si[tid - 128] = ii * bf2f(pr[512 + tid - 128]); }
                else if (tid < 384) sv[tid - 256] = bf2f(pr[1024 + tid - 256]);
            }
            __syncthreads();
            const float vv = sv[v]; float acc = 0.f, dacc = 0.f;
#pragma unroll
            for (int i = 0; i < 32; ++i) { const int k = kq * 32 + i; const float d = sd[k], ik = si[k], q = sq[k]; S[i] = d * S[i] + ik * vv; acc += q * S[i]; nst[i] = d * nst[i] + ik; dacc += q * nst[i]; }
            part[kq * 128 + v] = acc; if (v == 0) denp[kq] = dacc;
            __syncthreads();
            float o = 0.f;
            if (tid < 128) { o = (part[tid] + part[128 + tid]) + (part[256 + tid] + part[384 + tid]);
                if (g == 1) { const float den = (denp[0] + denp[1]) + (denp[2] + denp[3]); o = o / fmaxf(fabsf(den), __expf(-m_new)); }
                const float ss = wave_sum(o * o); if ((tid & 63) == 0) red[tid >> 6] = ss; }
            __syncthreads();
            if (tid < 128) { const float tot = red[0] + red[1]; const float gate = bf2f(pr[1536 + tid]);
                AMIX[row * DM + g * 512 + h * 128 + tid] = f2bf(o * rsqrtf(tot * (1.f / 128.f) + EPS) * gn[tid] * gate); }
            mst = m_new;
            __syncthreads();
        }
        float* So = p.out + (g == 0 ? (prompt ? O_SP : O_SS) : (prompt ? O_CP : O_CS));
#pragma unroll
        for (int i = 0; i < 32; ++i) So[sbase + (size_t)(kq * 32 + i) * 128 + v] = S[i];
        if (g == 1 && v == 0) { float* no = p.out + (prompt ? O_NP : O_NS) + (size_t)(sqi * 4 + h) * 128;
#pragma unroll
            for (int i = 0; i < 32; ++i) no[kq * 32 + i] = nst[i];
            if (kq == 0) p.out[(prompt ? O_MP : O_MS) + sqi * 4 + h] = mst; }
    }
}
__device__ __forceinline__ void phase5(const Params& p) {
    const float* UHL = (const float*)(p.ws + WS_UHL); const float* UHF = (const float*)(p.ws + WS_UHF); bf16_t* ACT = (bf16_t*)(p.ws + WS_R1 + R1_ACT);
    const float* cw = p.in[18]; const float* cbp = p.in[19];
    constexpr int NQ = DFF / 4;
    for (int i = blockIdx.x * 512 + threadIdx.x; i < 256 * 2 * NQ; i += gridDim.x * 512) {
        const int cq = i % NQ, j = (i / NQ) & 1, gi = i / (2 * NQ), c = 4 * cq; const int row = gi * 64 + j;
        const bool first = (gi & 31) == 0;
        const f32x4 z = (f32x4){0.f, 0.f, 0.f, 0.f};
        const f32x4 l0 = first ? z : *(const f32x4*)(UHL + (size_t)((gi - 1) * 2 + 0) * DFF + c), l1 = first ? z : *(const f32x4*)(UHL + (size_t)((gi - 1) * 2 + 1) * DFF + c);
        const f32x4 u0 = *(const f32x4*)(UHF + (size_t)((gi * 2 + 0) * 2) * DFF + c);
        const f32x4 uu = *(const f32x4*)(UHF + (size_t)((gi * 2 + j) * 2) * DFF + c), vv = *(const f32x4*)(UHF + (size_t)((gi * 2 + j) * 2 + 1) * DFF + c);
        const f32x4 p2 = j == 0 ? l0 : l1, p1 = j == 0 ? l1 : u0;
        const f32x4 w0 = *(const f32x4*)(cw + c), w1 = *(const f32x4*)(cw + DFF + c), w2 = *(const f32x4*)(cw + 2 * DFF + c), cb = *(const f32x4*)(cbp + c);
        float a[4];
#pragma unroll
        for (int e = 0; e < 4; ++e) a[e] = gelu_tanh(cb[e] + w0[e] * p2[e] + w1[e] * p1[e] + w2[e] * uu[e]) * vv[e];
        *(u32x2*)(ACT + (size_t)row * DFF + c) = (u32x2){cvt_pk_bf16(a[0], a[1]), cvt_pk_bf16(a[2], a[3])};
    }
}
__device__ __forceinline__ void phase7(const Params& p) {
    const float* gf = p.in[21]; float* Y = p.out; const float* X1 = (const float*)(p.ws + WS_X1); const float* PART = (const float*)(p.ws + WS_R1 + R1_X1B);
    const int wave = threadIdx.x >> 6, lane = threadIdx.x & 63;
    f32x4 g[4];
#pragma unroll
    for (int j = 0; j < 4; ++j) g[j] = *(const f32x4*)(gf + 4 * lane + 256 * j);
    for (int row = blockIdx.x * 8 + wave; row < MROWS; row += gridDim.x * 8) {
        f32x4 v[4]; float s = 0.f;
        if (row < MPROMPT) {
#pragma unroll
            for (int j = 0; j < 4; ++j) v[j] = *(const f32x4*)(Y + (size_t)row * DM + 4 * lane + 256 * j);
        } else {
#pragma unroll
            for (int j = 0; j < 4; ++j) v[j] = *(const f32x4*)(X1 + (size_t)row * DM + 4 * lane + 256 * j);
#pragma unroll
            for (int sl = 0; sl < 7; ++sl)
#pragma unroll
                for (int j = 0; j < 4; ++j) v[j] = v[j] + *(const f32x4*)(PART + (size_t)sl * (1024 * DM) + (size_t)(row - MPROMPT) * DM + 4 * lane + 256 * j);
        }
#pragma unroll
        for (int j = 0; j < 4; ++j) s += (v[j].x * v[j].x + v[j].y * v[j].y) + (v[j].z * v[j].z + v[j].w * v[j].w);
        const float rs = rsqrtf(wave_sum(s) * (1.f / DM) + EPS);
#pragma unroll
        for (int j = 0; j < 4; ++j) *(f32x4*)(Y + (size_t)row * DM + 4 * lane + 256 * j) = v[j] * rs * g[j];
    }
}
#define RUN(ph) (((PHMASK >> (ph)) & 1) && ph_lo <= (ph) && (ph) <= ph_hi)
#define SYNC(ph) do { if (ph_lo <= (ph) && (ph) < ph_hi) { xcd_barrier(xb); } } while (0)
#define TWICE(ph, body) do { body; if ((REPMASK >> (ph)) & 1) { grid.sync(); body; } } while (0)
__device__ __forceinline__ void run_p1(const Params& p, PG8_LAS unsigned char* lds) { bf16_t* H = (bf16_t*)p.out; bf16_t* PROJ = (bf16_t*)(p.ws + WS_R1);
    pg8::StaticOrder S; S.init(MROWS, NIN, gridDim.x, blockIdx.x); pg8::Gemm g{H, (const bf16_t*)(p.ws + WS_WIN), MROWS, NIN, DM};
    EpiInProj E{PROJ, p.in[9], (float*)(p.ws + WS_GATES), p.in[11], p.in[12]}; pg8::gemm_phase(lds, g, S, E); }
__device__ __forceinline__ void run_p3(const Params& p, PG8_LAS unsigned char* lds) { bf16_t* AMIX = (bf16_t*)p.out + (size_t)MROWS * DM; bf16_t* X1B = (bf16_t*)(p.ws + WS_R1 + R1_X1B); float* X1 = (float*)(p.ws + WS_X1);
    pg8::StaticOrder S; S.init(P3_OVERLAP ? MPROMPT : MROWS, DM, gridDim.x, blockIdx.x);   pg8::Gemm g{AMIX, (const bf16_t*)(p.ws + WS_WOUT), MROWS, DM, DM};
    EpiResid E{p.in[0], p.in[1], X1, X1B, (float*)(p.ws + WS_SSQ2), nullptr}; pg8::gemm_phase(lds, g, S, E); }
struct OneUnit { int pm, pn, ntK;
    __device__ bool next(int i, Unit& u) const { if (i) return false; u.pm = pm; u.pn = pn; u.k0 = 0; u.nt = ntK; return true; }
    __device__ __forceinline__ void a_ready(const Unit&) const {}
    __device__ __forceinline__ void done(const Unit&) const {} };
__device__ __forceinline__ void run_p3_sample(const Params& p, PG8_LAS unsigned char* lds, const int j) {
    bf16_t* AMIX = (bf16_t*)p.out + (size_t)MROWS * DM; bf16_t* X1B = (bf16_t*)p.out; float* X1 = (float*)(p.ws + WS_X1);
    OneUnit S{64 + (j >> 2), j & 3, DM / 64}; pg8::Gemm g{AMIX, (const bf16_t*)(p.ws + WS_WOUT), MROWS, DM, DM};
    EpiResid E{p.in[0], p.in[1], X1, X1B, (float*)(p.ws + WS_SSQ2), nullptr}; pg8::gemm_phase(lds, g, S, E); }
__device__ __forceinline__ void phase2b(const Params& p, PG8_LAS unsigned char* lds, unsigned char* shm) {
    const int b = blockIdx.x, G = gridDim.x;
    if (G >= 96) {
        if (b < 64) { const int g = b >> 5, sqi = (b >> 2) & 7, h = b & 3; if (g == 0) chain_run<false>(p, lds, sqi, h); else chain_run<true>(p, lds, sqi, h); }
        else { for (int j = NS_A + (b - 64); j < 1024; j += G - 64) sample_dispatch(p, lds, j);
            LDS_BARRIER();
            deferred_transposes(p, shm, (b - 64) * 8 + (threadIdx.x >> 6), (G - 64) * 8); }
    } else {
        for (int it = b; it < 64; it += G) { const int g = it >> 5, sqi = (it >> 2) & 7, h = it & 3; if (g == 0) chain_run<false>(p, lds, sqi, h); else chain_run<true>(p, lds, sqi, h); }
        for (int j = NS_A + b; j < 1024; j += G) sample_dispatch(p, lds, j);
        LDS_BARRIER();
        deferred_transposes(p, shm, b * 8 + (threadIdx.x >> 6), G * 8);
    }
}
__device__ __forceinline__ void run_p4(const Params& p, PG8_LAS unsigned char* lds) { bf16_t* X1B = (bf16_t*)(p.ws + WS_R1 + R1_X1B); bf16_t* ACT = (bf16_t*)(p.ws + WS_R1 + R1_ACT);
    pg8::StaticOrder S; S.init(MROWS, NGV, gridDim.x, blockIdx.x); pg8::Gemm g{X1B, (const bf16_t*)(p.ws + WS_WGV), MROWS, NGV, DM};
    EpiGateVal E{ACT, (const float*)(p.ws + WS_SSQ2), p.in[18], p.in[19], p.in[6], (float*)(p.ws + WS_UHL), (float*)(p.ws + WS_UHF), p.out + O_VP, p.out + O_VS}; pg8::gemm_phase(lds, g, S, E); }
struct DownOrder {
    pg8::StaticOrder S; int G, c;
    __device__ void init(int G_, int c_) { G = G_; c = c_; S.init(MPROMPT, DM, G_, c_, DFF); }
    __device__ bool next(int i, Unit& u) const {
        const int L = i * G + c;
        if (L < 256) { pg8::StaticOrder T = S; T.G = 256; T.c = L; return T.next(0, u); }
        const int r = L - 256; if (r >= 112) return false;
        const int s = r % 7, t = r / 7; u.pm = 64 + (t >> 2); u.pn = t & 3; u.k0 = 384 * s; u.nt = s == 6 ? 8 : 6; return true;
    }
    __device__ __forceinline__ void a_ready(const Unit&) const {}
    __device__ __forceinline__ void done(const Unit&) const {}
};
__device__ __forceinline__ void run_p6(const Params& p, PG8_LAS unsigned char* lds) { bf16_t* ACT = (bf16_t*)(p.ws + WS_R1 + R1_ACT); float* X1 = (float*)(p.ws + WS_X1);
    DownOrder S; S.init(gridDim.x, blockIdx.x); pg8::Gemm g{ACT, (const bf16_t*)(p.ws + WS_WD), MROWS, DM, DFF};
    EpiResid E{X1, X1 + (size_t)MPROMPT * DM, p.out, nullptr, nullptr, (float*)(p.ws + WS_R1 + R1_X1B)}; pg8::gemm_phase(lds, g, S, E); }
__global__ __launch_bounds__(512, 2) void fwd_kernel(Params p, int ph_lo, int ph_hi) {
    extern __shared__ __attribute__((aligned(16))) unsigned char shm[];
    PG8_LAS unsigned char* lds = (PG8_LAS unsigned char*)shm;
    cg::grid_group grid = cg::this_grid();
    volatile LAS unsigned* xst = (volatile LAS unsigned*)(lds + LDS_BYTES - 16);
    if (threadIdx.x == 0) { xst[0] = 0u; xst[1] = 0u; }
    __syncthreads();
    XcdBarrier xb = xcd_barrier_post((unsigned*)(p.ws + WS_BAR), xst);
    if (ph_lo < -1000) grid.sync();
    if (RUN(0)) TWICE(0, phase0(p, shm));
    SYNC(0);
    if (RUN(1)) TWICE(1, run_p1(p, lds));
    SYNC(1);
#if NAIVE_MIXER
    if (RUN(2)) phase2_naive(p, shm);
#else
    if (RUN(2)) { phase2a(p, lds); phase2a_samples(p, lds); xcd_barrier(xb); phase2b(p, lds, shm); }
#endif
    SYNC(2);
    if (RUN(3)) run_p3(p, lds);
    SYNC(3);
    if (RUN(4)) TWICE(4, run_p4(p, lds));
    SYNC(4);
    if (RUN(5)) TWICE(5, phase5(p));
    SYNC(5);
    if (RUN(6)) run_p6(p, lds);
    SYNC(6);
    if (RUN(7)) phase7(p);
#if EXTRA_SYNCS
    for (int i = 0; i < EXTRA_SYNCS; ++i) xcd_barrier(xb);
#endif
}
extern "C" void kernel_launch(void* const* d_in, const int* in_sizes, int n_in, void* d_out, int out_size, void* d_ws, size_t ws_size, hipStream_t stream) {
    static int grid = 0;
    if (grid == 0) {
        if (n_in != 22 || ws_size < WS_END) { fprintf(stderr, "kernel_launch: unexpected n_in %d / ws_size %zu (need %zu)\n", n_in, ws_size, (size_t)WS_END); grid = -1; return; }
        int dev = 0, cus = 0, per_cu = 0;
        hipGetDevice(&dev); hipDeviceGetAttribute(&cus, hipDeviceAttributeMultiprocessorCount, dev);
        if (hipFuncSetAttribute((const void*)fwd_kernel, hipFuncAttributeMaxDynamicSharedMemorySize, LDS_BYTES) != hipSuccess) { fprintf(stderr, "kernel_launch: hipFuncSetAttribute failed\n"); grid = -1; return; }
        if (hipOccupancyMaxActiveBlocksPerMultiprocessor(&per_cu, (const void*)fwd_kernel, 512, LDS_BYTES) != hipSuccess || per_cu < 1) { fprintf(stderr, "kernel_launch: occupancy query says %d blocks per CU\n", per_cu); per_cu = 1; }
        (void)hipGetLastError();
        grid = cus;
        fprintf(stderr, "kernel_launch: cus %d per_cu %d grid %d ws %zu\n", cus, per_cu, grid, ws_size);
    }
    if (grid < 0) return;
    Params p{};
    for (int i = 0; i < 22; ++i) p.in[i] = (const float*)d_in[i];
    p.out = (float*)d_out; p.ws = (unsigned char*)d_ws;
    if (hipMemsetAsync((char*)d_ws + WS_BAR, 0, 16384, stream) != hipSuccess) { fprintf(stderr, "kernel_launch: memset of the barrier words failed\n"); return; }
#if ONE_LAUNCH
    int lo = 0, hi = 7; void* args[] = {&p, &lo, &hi};
    hipError_t e = hipLaunchCooperativeKernel((const void*)fwd_kernel, dim3(grid), dim3(512), args, LDS_BYTES, stream);
    if (e != hipSuccess) fprintf(stderr, "cooperative launch failed: %s (grid %d)\n", hipGetErrorString(e), grid);
#else
    for (int ph = 0; ph < 8; ++ph) hipLaunchKernelGGL(fwd_kernel, dim3(grid), dim3(512), LDS_BYTES, stream, p, ph, ph);
#endif
}
```

```cpp
#include <hip/hip_runtime.h>
#include <hip/hip_cooperative_groups.h>
#include <cstdio>
#include <cstdint>
namespace cg = cooperative_groups;
#ifndef ONE_LAUNCH
#define ONE_LAUNCH 1
#endif
#ifndef PHMASK
#define PHMASK 255
#endif
#ifndef NAIVE_MIXER
#define NAIVE_MIXER 0
#endif
#ifndef REPMASK
#define REPMASK 0
#endif
#ifndef EXTRA_SYNCS
#define EXTRA_SYNCS 0
#endif
#ifndef P3_OVERLAP
#define P3_OVERLAP 0
#endif
namespace pg8 {
#define PG8_LAS __attribute__((address_space(3)))
typedef unsigned short bf16_t;
typedef short bf16x8 __attribute__((ext_vector_type(8)));
typedef float f32x4 __attribute__((ext_vector_type(4)));
typedef unsigned u32x4 __attribute__((ext_vector_type(4)));
constexpr int BM = 256, BK = 64, HALF = 128, HTB = HALF * BK * 2  , STAGE_BYTES = 8 * HTB, NXCD = 8, WGM = 8;

__host__ __device__ __forceinline__ int lds_byte(int r, int c) { const int st = (r >> 4) * 2 + (c >> 5), rr = r & 15, cc = c & 31, ob = rr * 64 + cc * 2; return st * 1024 + (ob ^ (((ob >> 9) & 1) << 5)); }
__host__ __device__ __forceinline__ void stage_rc(int b, int& R, int& C) { const int st = b / 1024, sb = b % 1024, swz = sb ^ (((sb >> 9) & 1) << 5); R = (st >> 1) * 16 + swz / 64; C = (st & 1) * 32 + (swz % 64) / 2; }
__host__ __device__ __forceinline__ int perm32(int rho) { const int n = rho >> 4, i = rho & 15; return 8 * (i >> 2) + 4 * n + (i & 3); }

struct Unit { int pm, pn, k0, nt; };
struct Gemm { const bf16_t* A; const bf16_t* Bt; int M, N, K; };

struct StaticOrder {
    int nM, nN, nwg, G, c, ntK;
    __host__ __device__ void init(int M, int N, int G_, int c_, int K_ = 1024) { nM = M / BM; nN = N / BM; nwg = nM * nN; G = G_; c = c_; ntK = K_ / BK; }
    __host__ __device__ bool next(int i, Unit& u) const {
        const long L = (long)i * G + c; if (L >= nwg) return false;
        int wgid = (int)L; { const int q = nwg / NXCD, r = nwg % NXCD, xcd = wgid % NXCD, off = wgid / NXCD; wgid = (xcd < r ? xcd * (q + 1) : r * (q + 1) + (xcd - r) * q) + off; }
        const int nig = WGM * nN, gid = wgid / nig, fm = gid * WGM, gsz = (nM - fm) < WGM ? (nM - fm) : WGM;
        u.pm = fm + ((wgid % nig) % gsz); u.pn = (wgid % nig) / gsz; u.k0 = 0; u.nt = ntK; return true;
    }
    __device__ __forceinline__ void a_ready(const Unit&) const {}
    __device__ __forceinline__ void done(const Unit&) const {}
};

typedef float f32x2_t __attribute__((ext_vector_type(2)));
typedef __bf16 bf16x2_t __attribute__((ext_vector_type(2)));
__device__ __forceinline__ unsigned cvt_pk_bf16(float lo, float hi) { const f32x2_t v = {lo, hi}; return __builtin_bit_cast(unsigned, __builtin_convertvector(v, bf16x2_t)); }
template <class Epi, class Sched>
__device__ __forceinline__ void gemm_phase(PG8_LAS unsigned char* lds, const Gemm g, const Sched& S, const Epi& E) {
    const int tid = threadIdx.x, wid = __builtin_amdgcn_readfirstlane(tid >> 6), lane = tid & 63, wr = wid >> 2, wc = wid & 3, fr = lane & 15, fq = lane >> 4;
    const int K = g.K;
    unsigned voffA[2], voffB[2];
#pragma unroll
    for (int i = 0; i < 2; ++i) { int R, C; stage_rc(tid * 16 + i * 8192, R, C); const int Rb = Epi::PERM ? ((R & ~31) + perm32(R & 31)) : R;
        voffA[i] = (unsigned)(R * K + C) * 2u; voffB[i] = (unsigned)(Rb * K + C) * 2u; }
    const size_t kstep = (size_t)(BK * 2);
    const size_t hstep = (size_t)HALF * K * 2;
    const size_t tstep = 2 * hstep;
    const unsigned ldsw = (unsigned)wid * 1024u;
    const int aoff = lds_byte(wr * 64 + fr, fq * 8), boff = lds_byte(wc * 32 + fr, fq * 8);
#define PG8_SA(b, h) (((b) * 2 + (h)) * HTB)
#define PG8_SB(b, h) ((4 + (b) * 2 + (h)) * HTB)
#define PG8_STAGE(bufoff, gbase, voff) do { _Pragma("unroll") for (int _i = 0; _i < 2; ++_i) \
        __builtin_amdgcn_global_load_lds((const unsigned*)((const char*)(gbase) + (voff)[_i]), (PG8_LAS unsigned*)(lds + (bufoff) + ldsw + _i * 8192), 16, 0, 0); } while (0)
#define PG8_LDA(dst, b, h) do { _Pragma("unroll") for (int m = 0; m < 4; ++m) _Pragma("unroll") for (int k = 0; k < 2; ++k) dst[m][k] = *(const PG8_LAS bf16x8*)(lds + PG8_SA(b, h) + aoff + m * 2048 + k * 1024); } while (0)
#define PG8_LDB(dst, b, h) do { _Pragma("unroll") for (int n = 0; n < 2; ++n) _Pragma("unroll") for (int k = 0; k < 2; ++k) dst[n][k] = *(const PG8_LAS bf16x8*)(lds + PG8_SB(b, h) + boff + n * 2048 + k * 1024); } while (0)
#define PG8_MMA(ai, bj, At, Bt) do { __builtin_amdgcn_s_setprio(1); _Pragma("unroll") for (int m = 0; m < 4; ++m) _Pragma("unroll") for (int n = 0; n < 2; ++n) _Pragma("unroll") for (int k = 0; k < 2; ++k) \
        acc[ai][bj][m][n] = __builtin_amdgcn_mfma_f32_16x16x32_bf16(Bt[n][k], At[m][k], acc[ai][bj][m][n], 0, 0, 0); __builtin_amdgcn_s_setprio(0); } while (0)
#define PG8_WAIT_V(n) asm volatile("s_waitcnt vmcnt(" #n ")" ::: "memory")
#define PG8_WAIT_L(n) asm volatile("s_waitcnt lgkmcnt(" #n ")" ::: "memory")
#define PG8_BAR __builtin_amdgcn_s_barrier()
#define PG8_SCHED __builtin_amdgcn_sched_barrier(0)
    Unit cur, nxt; int ui = 0;
    if (!S.next(0, cur)) return;
    f32x4 acc[2][2][4][2];
#pragma unroll
    for (int a = 0; a < 2; ++a)
#pragma unroll
        for (int b = 0; b < 2; ++b)
#pragma unroll
            for (int m = 0; m < 4; ++m)
#pragma unroll
                for (int n = 0; n < 2; ++n) acc[a][b][m][n] = (f32x4){0.f, 0.f, 0.f, 0.f};
    bf16x8 At[4][2], B0[2][2], B1[2][2];
    const char* cA = (const char*)g.A + (size_t)cur.pm * tstep + (size_t)cur.k0 * 2; const char* cB = (const char*)g.Bt + (size_t)cur.pn * tstep + (size_t)cur.k0 * 2;
    S.a_ready(cur);
    PG8_STAGE(PG8_SB(0, 0), cB, voffB); PG8_STAGE(PG8_SA(0, 0), cA, voffA); PG8_STAGE(PG8_SB(0, 1), cB + hstep, voffB); PG8_STAGE(PG8_SA(0, 1), cA + hstep, voffA);
    if (wr == 1) PG8_BAR;
    PG8_WAIT_V(4); PG8_BAR;
    PG8_STAGE(PG8_SB(1, 0), cB + kstep, voffB); PG8_STAGE(PG8_SA(1, 0), cA + kstep, voffA); PG8_STAGE(PG8_SB(1, 1), cB + hstep + kstep, voffB);
    PG8_WAIT_V(6); PG8_BAR;
    for (;;) {
        const bool has_next = S.next(ui + 1, nxt);
        const char* nA = has_next ? (const char*)g.A + (size_t)nxt.pm * tstep + (size_t)nxt.k0 * 2 : cA; const char* nB = has_next ? (const char*)g.Bt + (size_t)nxt.pn * tstep + (size_t)nxt.k0 * 2 : cB;
        const int nt = cur.nt;
        for (int t = 0; t < nt; t += 2) {
            const bool last = (t == nt - 2);
            const char* a1 = cA + (size_t)(t + 1) * kstep;
            const char* a2 = last ? nA : cA + (size_t)(t + 2) * kstep; const char* b2 = last ? nB : cB + (size_t)(t + 2) * kstep;
            const char* a3 = a2 + kstep; const char* b3 = b2 + kstep;
            if (last && has_next) S.a_ready(nxt);
            PG8_LDB(B0, 0, 0); PG8_SCHED; PG8_LDA(At, 0, 0); PG8_STAGE(PG8_SA(1, 1), a1 + hstep, voffA);
            PG8_WAIT_L(8); PG8_BAR; PG8_WAIT_L(0); PG8_MMA(0, 0, At, B0); PG8_BAR; PG8_SCHED;
            PG8_LDB(B1, 0, 1); PG8_STAGE(PG8_SB(0, 0), b2, voffB);
            PG8_BAR; PG8_WAIT_L(0); PG8_MMA(0, 1, At, B1); PG8_BAR;
            PG8_LDA(At, 0, 1); PG8_STAGE(PG8_SA(0, 0), a2, voffA);
            PG8_BAR; PG8_WAIT_L(0); PG8_MMA(1, 0, At, B0); PG8_BAR; PG8_SCHED;
            PG8_STAGE(PG8_SB(0, 1), b2 + hstep, voffB);
            PG8_WAIT_V(6); PG8_BAR; PG8_MMA(1, 1, At, B1); PG8_BAR;
            PG8_LDB(B0, 1, 0); PG8_SCHED; PG8_LDA(At, 1, 0); PG8_STAGE(PG8_SA(0, 1), a2 + hstep, voffA);
            PG8_WAIT_L(8); PG8_BAR; PG8_WAIT_L(0); PG8_MMA(0, 0, At, B0); PG8_BAR; PG8_SCHED;
            PG8_LDB(B1, 1, 1); PG8_STAGE(PG8_SB(1, 0), b3, voffB);
            PG8_BAR; PG8_WAIT_L(0); PG8_MMA(0, 1, At, B1); PG8_BAR;
            PG8_LDA(At, 1, 1); PG8_STAGE(PG8_SA(1, 0), a3, voffA);
            PG8_BAR; PG8_WAIT_L(0); PG8_MMA(1, 0, At, B0); PG8_BAR; PG8_SCHED;
            PG8_STAGE(PG8_SB(1, 1), b3 + hstep, voffB);
            PG8_WAIT_V(6); PG8_BAR; PG8_MMA(1, 1, At, B1); PG8_BAR;
        }
        if constexpr (!Epi::AFTER_DRAIN) { E(acc, cur, wr, wc, fr, fq); S.done(cur); }
        if (!has_next) break;
#pragma unroll
        for (int a = 0; a < 2; ++a)
#pragma unroll
            for (int b = 0; b < 2; ++b)
#pragma unroll
                for (int m = 0; m < 4; ++m)
#pragma unroll
                    for (int n = 0; n < 2; ++n) acc[a][b][m][n] = (f32x4){0.f, 0.f, 0.f, 0.f};
        cur = nxt; cA = nA; cB = nB; ++ui;
    }
    PG8_WAIT_V(0);
    if (wr == 0) PG8_BAR;
    PG8_BAR;
    if constexpr (Epi::AFTER_DRAIN) { E.fused(acc, cur, wr, wc, fr, fq, lds, wid, lane); S.done(cur); }
#undef PG8_SA
#undef PG8_SB
#undef PG8_STAGE
#undef PG8_LDA
#undef PG8_LDB
#undef PG8_MMA
#undef PG8_WAIT_V
#undef PG8_WAIT_L
#undef PG8_BAR
#undef PG8_SCHED
}

}
#define XB_TMO      128
#define XB_XCNT(j)  (256  + 64 * (j))
#define XB_XSUB(j)  (1280 + 64 * (j))
#define XB_XGEN(j)  (2304 + 64 * (j))
#define XB_TOP      3328
#define XB_TOPGEN   3392
#define XCD_BAR_WORDS 3456
#define XB_SPIN_CAP (1u << 18)
#ifndef LAS
#define LAS __attribute__((address_space(3)))
#endif

__device__ __forceinline__ unsigned xb_ld(unsigned* p)              { return __hip_atomic_load(p, __ATOMIC_RELAXED, __HIP_MEMORY_SCOPE_AGENT); }
__device__ __forceinline__ unsigned xb_add(unsigned* p, unsigned v) { return __hip_atomic_fetch_add(p, v, __ATOMIC_RELAXED, __HIP_MEMORY_SCOPE_AGENT); }
__device__ __forceinline__ unsigned xb_xcc_id() { return (unsigned)__builtin_amdgcn_s_getreg((3 << 11) | 20) & 0xFu; }
#define XB_SPIN(cond, bar) do { unsigned _sp = 0; while (cond) { __builtin_amdgcn_s_sleep(1); \
    if ((++_sp & 255u) == 0u) { if (xb_ld(&(bar)[XB_TMO])) break; if (_sp > XB_SPIN_CAP) { atomicAdd(&(bar)[XB_TMO], 1u); break; } } } } while (0)

struct XcdBarrier {
    unsigned* bar; unsigned x;
    volatile LAS unsigned* st;
};

__device__ __forceinline__ XcdBarrier xcd_barrier_post(unsigned* bar, volatile LAS unsigned* st) {
    XcdBarrier b; b.bar = bar; b.x = xb_xcc_id(); b.st = st;
    if (threadIdx.x == 0) (void)xb_add(&bar[XB_XCNT(b.x)], 1u);
    return b;
}
__device__ __forceinline__ void xcd_barrier_complete(unsigned* bar, unsigned x, unsigned& nloc, unsigned& nx) {
    const unsigned G = gridDim.x * gridDim.y * gridDim.z;
    unsigned sum, cnt, mine, sp = 0u;
    for (;;) {
        sum = 0u; cnt = 0u; mine = 0u;
#pragma unroll
        for (unsigned j = 0; j < 16; ++j) { const unsigned c = xb_ld(&bar[XB_XCNT(j)]); sum += c; cnt += (c > 0u) ? 1u : 0u; mine = (j == x) ? c : mine; }
        if (sum == G) break;
        __builtin_amdgcn_s_sleep(1);
        if ((++sp & 255u) == 0u) { if (xb_ld(&bar[XB_TMO])) break; if (sp > XB_SPIN_CAP) { atomicAdd(&bar[XB_TMO], 1u); break; } }
    }
    nloc = mine > 0u ? mine : 1u; nx = cnt > 0u ? cnt : 1u;
}

__device__ __forceinline__ void xcd_barrier(const XcdBarrier& b) {
    asm volatile("s_waitcnt vmcnt(0)" ::: "memory");
    __syncthreads();
    if (threadIdx.x == 0) {
        unsigned* bar = b.bar;
        __builtin_amdgcn_s_waitcnt(0);
        unsigned nloc = b.st[0], nx = b.st[1];
        if (nloc == 0u) { xcd_barrier_complete(bar, b.x, nloc, nx); b.st[0] = nloc; b.st[1] = nx; }
        const unsigned old = xb_add(&bar[XB_XSUB(b.x)], 1u);
        const unsigned gen = old / nloc;
        if (old + 1u == (gen + 1u) * nloc) {
            __builtin_amdgcn_fence(__ATOMIC_RELEASE, "agent");
            asm volatile("s_waitcnt vmcnt(0)" ::: "memory");
            const unsigned og = xb_add(&bar[XB_TOP], 1u);
            const unsigned tg = og / nx;
            if (og + 1u == (tg + 1u) * nx) xb_add(&bar[XB_TOPGEN], 1u);
            else XB_SPIN(xb_ld(&bar[XB_TOPGEN]) == tg, bar);
            __builtin_amdgcn_fence(__ATOMIC_ACQUIRE, "agent");
            xb_add(&bar[XB_XGEN(b.x)], 1u);
            asm volatile("s_waitcnt vmcnt(0)" ::: "memory");
        } else {
            XB_SPIN(xb_ld(&bar[XB_XGEN(b.x)]) == gen, bar);
            __builtin_amdgcn_fence(__ATOMIC_ACQUIRE, "agent");
            asm volatile("s_waitcnt vmcnt(0)" ::: "memory");
        }
    }
    __syncthreads();
}

using pg8::bf16_t; using pg8::f32x4; using pg8::u32x4; using pg8::Unit; using pg8::cvt_pk_bf16;
typedef unsigned u32x2 __attribute__((ext_vector_type(2)));
constexpr int DM = 1024, MROWS = 17408, MPROMPT = 16384, NPROJ = 4096, INCOLS = 4104, DFF = 2816, NGV = 5632;
constexpr float EPS = 1e-6f;
constexpr size_t O_Y = 0, O_SP = 17825792, O_SS = 18350080, O_CP = 26738688, O_CS = 27262976, O_NP = 35651584, O_NS = 35655680,
                 O_MP = 35721216, O_MS = 35721248, O_VP = 35721760, O_VS = 35766816;
constexpr int NIN = 4352;
constexpr size_t WS_CTL = 0, WS_WIN = 4096, WS_WOUT = WS_WIN + (size_t)NIN * 1024 * 2, WS_WGV = WS_WOUT + 1024 * 1024 * 2, WS_WD = WS_WGV + 5632 * 1024 * 2,
                 WS_GATES = WS_WD + 1024 * 2816 * 2, WS_SSQ2 = WS_GATES + 17408 * 32, WS_SSQ3 = WS_SSQ2 + 17408 * 4, WS_UHL = WS_SSQ3 + 17408 * 4, WS_UHF = WS_UHL + 256 * 2 * 2816 * 4,
                 WS_X1 = WS_UHF + 256 * 4 * 2816 * 4, WS_R1 = WS_X1 + (size_t)17408 * 1024 * 4, WS_BAR = WS_R1 + (size_t)17408 * 4096 * 2, WS_END = WS_BAR + 16384;
static_assert(WS_END <= 268435456, "workspace budget");
constexpr size_t R1_X1B = 1048576, R1_ACT = 36700160 + 1048576;
constexpr int LDS_BYTES = 160 * 1024 - 2048;

struct Params { const float* in[22]; float* out; unsigned char* ws; };

__device__ __forceinline__ float bf2f(unsigned short b) { return __uint_as_float(((unsigned)b) << 16); }
__device__ __forceinline__ unsigned short f2bf(float f) { unsigned u = __float_as_uint(f); u += 0x7fffu + ((u >> 16) & 1u); return (unsigned short)(u >> 16); }
__device__ __forceinline__ float wave_sum(float v) {
#pragma unroll
    for (int o = 1; o < 64; o <<= 1) v += __shfl_xor(v, o);
    return v;
}
__device__ __forceinline__ float sigmoidf_(float x) { return __builtin_amdgcn_rcpf(1.0f + __expf(-x)); }

__device__ __forceinline__ void p0_transpose_item(const float* W, int ldw, int K, bf16_t* WT, int drow0, int k0, int n0, int nmax, const float* kscale, float* scr, int lane) {
    const int ncol = min(n0 + (lane & 31), nmax);
    float v[32];
#pragma unroll
    for (int i = 0; i < 32; ++i) v[i] = W[(size_t)(k0 + 2 * i + (lane >> 5)) * ldw + ncol];
    if (kscale) {
#pragma unroll
        for (int i = 0; i < 32; ++i) v[i] *= kscale[k0 + 2 * i + (lane >> 5)]; }
#pragma unroll
    for (int i = 0; i < 32; ++i) scr[(2 * i + (lane >> 5)) * 33 + (lane & 31)] = v[i];
    asm volatile("s_waitcnt lgkmcnt(0)" ::: "memory");
    const int c = lane & 7;
#pragma unroll
    for (int j = 0; j < 4; ++j) { const int n = (lane >> 3) + 8 * j; const float* s = scr + (8 * c) * 33 + n;
        u32x4 o; o.x = cvt_pk_bf16(s[0 * 33], s[1 * 33]); o.y = cvt_pk_bf16(s[2 * 33], s[3 * 33]); o.z = cvt_pk_bf16(s[4 * 33], s[5 * 33]); o.w = cvt_pk_bf16(s[6 * 33], s[7 * 33]);
        *(u32x4*)(WT + (size_t)(drow0 + n) * K + k0 + 8 * c) = o; }
    asm volatile("s_waitcnt lgkmcnt(0)" ::: "memory");
}

__device__ __forceinline__ void phase0(const Params& p, unsigned char* shm) {
    const int tid = threadIdx.x, wave = tid >> 6, lane = tid & 63;
    float* scr = (float*)(shm + wave * 8704);
    const int gw = blockIdx.x * 8 + wave, NGW = gridDim.x * 8;
    bf16_t* WinT = (bf16_t*)(p.ws + WS_WIN); bf16_t* WoutT = (bf16_t*)(p.ws + WS_WOUT);
    { float* z = (float*)(p.ws + WS_SSQ2); for (int i = blockIdx.x * 512 + tid; i < 2 * MROWS; i += gridDim.x * 512) z[i] = 0.f; }
    if (blockIdx.x == 0 && tid < 64) ((unsigned*)(p.ws + WS_CTL))[tid] = 0u;
    bf16_t* H = (bf16_t*)p.out;
    {   f32x4 g1[4];
#pragma unroll
        for (int j = 0; j < 4; ++j) g1[j] = *(const f32x4*)(p.in[7] + 4 * lane + 256 * j);
        int row = gw; f32x4 v[4];
        if (row < MROWS) { const float* xr = row < MPROMPT ? p.in[0] + (size_t)row * DM : p.in[1] + (size_t)(row - MPROMPT) * DM;
#pragma unroll
            for (int j = 0; j < 4; ++j) v[j] = *(const f32x4*)(xr + 4 * lane + 256 * j); }
        while (row < MROWS) {
            const int nrow = row + NGW; f32x4 nv[4];
#pragma unroll
            for (int j = 0; j < 4; ++j) nv[j] = (f32x4){0.f, 0.f, 0.f, 0.f};
            if (nrow < MROWS) { const float* xr = nrow < MPROMPT ? p.in[0] + (size_t)nrow * DM : p.in[1] + (size_t)(nrow - MPROMPT) * DM;
#pragma unroll
                for (int j = 0; j < 4; ++j) nv[j] = *(const f32x4*)(xr + 4 * lane + 256 * j); }
            float s = 0.f;
#pragma unroll
            for (int j = 0; j < 4; ++j) s += (v[j].x * v[j].x + v[j].y * v[j].y) + (v[j].z * v[j].z + v[j].w * v[j].w);
            const float rs = rsqrtf(wave_sum(s) * (1.f / DM) + EPS);
#pragma unroll
            for (int j = 0; j < 4; ++j) { const f32x4 o = v[j] * rs * g1[j];
                *(u32x2*)(H + (size_t)row * DM + 4 * lane + 256 * j) = (u32x2){cvt_pk_bf16(o.x, o.y), cvt_pk_bf16(o.z, o.w)}; }
#pragma unroll
            for (int j = 0; j < 4; ++j) v[j] = nv[j];
            row = nrow;
        }
    }
    constexpr int I_IN = 16 * 129, I_OUT = 16 * 32, NIT = I_IN + I_OUT;
    for (int it = gw; it < NIT; it += NGW) {
        int r = it;
        if (r < I_IN) { const int kb = r / 129, nb = r % 129; p0_transpose_item(p.in[8], INCOLS, DM, WinT, 32 * nb, 64 * kb, 32 * nb, INCOLS - 1, nullptr, scr, lane); continue; } r -= I_IN;
        { const int kb = r / 32, nb = r % 32; p0_transpose_item(p.in[14], DM, DM, WoutT, 32 * nb, 64 * kb, 32 * nb, DM - 1, nullptr, scr, lane); }
    }
}
__device__ __forceinline__ void deferred_transposes(const Params& p, unsigned char* shm, const int widx, const int nw) {
    const int wave = threadIdx.x >> 6, lane = threadIdx.x & 63;
    float* scr = (float*)(shm + wave * 8704);
    bf16_t* WgvT = (bf16_t*)(p.ws + WS_WGV); bf16_t* WdT = (bf16_t*)(p.ws + WS_WD);
    constexpr int I_G = 16 * 88, I_D = 44 * 32, NIT = 2 * I_G + I_D;
    for (int it = widx; it < NIT; it += nw) {
        int r = it;
        if (r < I_G) { const int kb = r / 88, nb = r % 88, n0 = 32 * nb; p0_transpose_item(p.in[16], DFF, DM, WgvT, 256 * (n0 >> 7) + (n0 & 127), 64 * kb, n0, DFF - 1, p.in[15], scr, lane); continue; } r -= I_G;
        if (r < I_G) { const int kb = r / 88, nb = r % 88, n0 = 32 * nb; p0_transpose_item(p.in[17], DFF, DM, WgvT, 256 * (n0 >> 7) + 128 + (n0 & 127), 64 * kb, n0, DFF - 1, p.in[15], scr, lane); continue; } r -= I_G;
        { const int kb = r / 32, nb = r % 32; p0_transpose_item(p.in[20], DM, DFF, WdT, 32 * nb, 64 * kb, 32 * nb, DM - 1, nullptr, scr, lane); }
    }
}
struct EpiInProj {
    static constexpr bool PERM = true, AFTER_DRAIN = false;
    bf16_t* O; const float* lbl; float* gates; const float* b_ig; const float* b_fg;
    __device__ __forceinline__ void operator()(const f32x4 (&acc)[2][2][4][2], const Unit& u, int wr, int wc, int fr, int fq) const {
        const int seg = u.pn >> 1, row0 = u.pm * 256 + wr * 64 + fr, col0 = u.pn * 256 + wc * 32 + 8 * fq;
        if (seg == 8) {
            if (wc == 0 && fq == 0) {
                float bi[4], bf_[4];
#pragma unroll
                for (int e = 0; e < 4; ++e) { bi[e] = b_ig[e]; bf_[e] = b_fg[e]; }
#pragma unroll
                for (int ai = 0; ai < 2; ++ai)
#pragma unroll
                    for (int m = 0; m < 4; ++m) { float* gp = gates + (size_t)(row0 + ai * 128 + m * 16) * 8; f32x4 a = acc[ai][0][m][0], b = acc[ai][0][m][1];
#pragma unroll
                        for (int e = 0; e < 4; ++e) { a[e] += bi[e]; const float z = b[e] + bf_[e]; b[e] = z > 0.f ? -log1pf(__expf(-z)) : z - log1pf(__expf(z)); }
                        *(f32x4*)gp = a; *(f32x4*)(gp + 4) = b; }
            }
            return;
        }
        float lb[2][8];
        if (seg == 1) {
#pragma unroll
            for (int bj = 0; bj < 2; ++bj)
#pragma unroll
                for (int e = 0; e < 8; ++e) { const int c = col0 + bj * 128 + e - 512; lb[bj][e] = __builtin_amdgcn_rcpf(1.0f + __expf(lbl[512 + c] - lbl[c])); }
        }
#pragma unroll
        for (int ai = 0; ai < 2; ++ai)
#pragma unroll
            for (int m = 0; m < 4; ++m) { bf16_t* rowp = O + (size_t)(row0 + ai * 128 + m * 16) * NPROJ + col0;
#pragma unroll
                for (int bj = 0; bj < 2; ++bj) { float v[8];
#pragma unroll
                    for (int e = 0; e < 8; ++e) v[e] = acc[ai][bj][m][e >> 2][e & 3];
                    if (seg == 1) {
#pragma unroll
                        for (int e = 0; e < 8; ++e) v[e] = __logf(lb[bj][e] + (1.0f - lb[bj][e]) * sigmoidf_(v[e]));
                    } else if (seg == 3) {
#pragma unroll
                        for (int e = 0; e < 8; ++e) v[e] = v[e] * sigmoidf_(v[e]);
                    } else if (seg == 5) {
#pragma unroll
                        for (int e = 0; e < 8; ++e) v[e] = v[e] * 0.08838834764831845f;
                    } else if (seg == 7) {
#pragma unroll
                        for (int e = 0; e < 8; ++e) v[e] = sigmoidf_(v[e]);
                    }
                    u32x4 w; w.x = cvt_pk_bf16(v[0], v[1]); w.y = cvt_pk_bf16(v[2], v[3]); w.z = cvt_pk_bf16(v[4], v[5]); w.w = cvt_pk_bf16(v[6], v[7]);
                    *(u32x4*)(rowp + bj * 128) = w; } }
    }
};
struct EpiResid {
    static constexpr bool PERM = true, AFTER_DRAIN = false;
    const float* base_p; const float* base_s;
    float* out; bf16_t* outb; float* ssq; float* part;
    __device__ __forceinline__ void operator()(const f32x4 (&acc)[2][2][4][2], const Unit& u, int wr, int wc, int fr, int fq) const {
        const int row0 = u.pm * 256 + wr * 64 + fr, col0 = u.pn * 256 + wc * 32 + 8 * fq;
        if (part && u.pm >= 64) { float* pp = part + (size_t)(u.k0 / 384) * (1024 * DM) - (size_t)MPROMPT * DM;
#pragma unroll
            for (int ai = 0; ai < 2; ++ai)
#pragma unroll
                for (int m = 0; m < 4; ++m) { const size_t off = (size_t)(row0 + ai * 128 + m * 16) * DM + col0;
#pragma unroll
                    for (int bj = 0; bj < 2; ++bj) { *(f32x4*)(pp + off + bj * 128) = acc[ai][bj][m][0]; *(f32x4*)(pp + off + bj * 128 + 4) = acc[ai][bj][m][1]; } }
            return; }
        const float* base = u.pm < 64 ? base_p : base_s - (size_t)MPROMPT * DM;
#pragma unroll
        for (int ai = 0; ai < 2; ++ai)
#pragma unroll
            for (int m = 0; m < 4; ++m) { const int row = row0 + ai * 128 + m * 16; const size_t off = (size_t)row * DM + col0; float ss = 0.f;
#pragma unroll
                for (int bj = 0; bj < 2; ++bj) { const f32x4 xa = *(const f32x4*)(base + off + bj * 128), xb = *(const f32x4*)(base + off + bj * 128 + 4);
                    const f32x4 v0 = acc[ai][bj][m][0] + xa, v1 = acc[ai][bj][m][1] + xb;
                    *(f32x4*)(out + off + bj * 128) = v0; *(f32x4*)(out + off + bj * 128 + 4) = v1;
                    if (outb) { u32x4 w; w.x = cvt_pk_bf16(v0[0], v0[1]); w.y = cvt_pk_bf16(v0[2], v0[3]); w.z = cvt_pk_bf16(v1[0], v1[1]); w.w = cvt_pk_bf16(v1[2], v1[3]); *(u32x4*)(outb + off + bj * 128) = w; }
                    ss += (v0[0] * v0[0] + v0[1] * v0[1]) + (v0[2] * v0[2] + v0[3] * v0[3]) + (v1[0] * v1[0] + v1[1] * v1[1]) + (v1[2] * v1[2] + v1[3] * v1[3]); }
                if (ssq) { ss += __shfl_xor(ss, 16); ss += __shfl_xor(ss, 32); if (fq == 0) atomicAdd(ssq + row, ss); } }
    }
};
__device__ __forceinline__ float gelu_tanh(float x) { const float z = 0.7978845608028654f * (x + 0.044715f * x * x * x); return x * __builtin_amdgcn_rcpf(1.0f + __expf(-2.0f * z)); }
template <int CTRL> __device__ __forceinline__ float dpp_f(float old, float src) {
    return __builtin_bit_cast(float, __builtin_amdgcn_update_dpp(__builtin_bit_cast(int, old), __builtin_bit_cast(int, src), CTRL, 0xf, 0xf, false)); }
struct EpiGateVal {
    static constexpr bool PERM = true, AFTER_DRAIN = false;
    bf16_t* ACT; const float* ssq2; const float* conv_w; const float* conv_b; const float* state_conv; float* UHL; float* UHF; float* out_vp; float* out_vs;
    __device__ __forceinline__ void operator()(const f32x4 (&acc)[2][2][4][2], const Unit& u, int wr, int wc, int fr, int fq) const {
        const int lane = threadIdx.x & 63;
        const int c0 = u.pn * 128 + wc * 32 + 8 * fq;
        float w0[8], w1[8], w2[8], cb[8];
#pragma unroll
        for (int e = 0; e < 8; ++e) { w0[e] = conv_w[c0 + e]; w1[e] = conv_w[DFF + c0 + e]; w2[e] = conv_w[2 * DFF + c0 + e]; cb[e] = conv_b[c0 + e]; }
        const bool sample = u.pm >= 64;
#pragma unroll
        for (int ai = 0; ai < 2; ++ai) {
            float uprev[8];
#pragma unroll
            for (int e = 0; e < 8; ++e) uprev[e] = 0.f;
#pragma unroll
            for (int m = 0; m < 4; ++m) { const int row = u.pm * 256 + ai * 128 + wr * 64 + m * 16 + fr;
                const float rs = rsqrtf(ssq2[row] * (1.f / DM) + EPS);
                float uu[8], vv[8], r1[8], r2[8];
#pragma unroll
                for (int e = 0; e < 8; ++e) { uu[e] = acc[ai][0][m][e >> 2][e & 3] * rs; vv[e] = acc[ai][1][m][e >> 2][e & 3] * rs; }
#pragma unroll
                for (int e = 0; e < 8; ++e) { r1[e] = dpp_f<0x111>(dpp_f<0x10F>(0.f, uprev[e]), uu[e]); r2[e] = dpp_f<0x112>(dpp_f<0x10E>(0.f, uprev[e]), uu[e]); }
                float p1[8], p2[8]; bool valid = true;
                if (!sample) {
#pragma unroll
                    for (int e = 0; e < 8; ++e) { p1[e] = r1[e]; p2[e] = r2[e]; }
                    if (m == 0 && fr < 2) { valid = false; const int gi = row >> 6; float* d = UHF + ((size_t)(gi * 2 + fr) * 2) * DFF + c0;
                        *(f32x4*)d = (f32x4){uu[0], uu[1], uu[2], uu[3]}; *(f32x4*)(d + 4) = (f32x4){uu[4], uu[5], uu[6], uu[7]};
                        *(f32x4*)(d + DFF) = (f32x4){vv[0], vv[1], vv[2], vv[3]}; *(f32x4*)(d + DFF + 4) = (f32x4){vv[4], vv[5], vv[6], vv[7]}; }
                    if (m == 3 && fr >= 14) { const int gi = row >> 6; float* d = UHL + (size_t)(gi * 2 + (fr - 14)) * DFF + c0;
                        *(f32x4*)d = (f32x4){uu[0], uu[1], uu[2], uu[3]}; *(f32x4*)(d + 4) = (f32x4){uu[4], uu[5], uu[6], uu[7]};
                        if ((row & 2047) >= 2046) { float* o = out_vp + (size_t)((row >> 11) * 2 + (fr - 14)) * DFF + c0;
                            *(f32x4*)o = (f32x4){uu[0], uu[1], uu[2], uu[3]}; *(f32x4*)(o + 4) = (f32x4){uu[4], uu[5], uu[6], uu[7]}; } }
                } else {
                    const int pos = fr & 7, b = (row - MPROMPT) >> 3; const float* sc = state_conv + (size_t)b * 2 * DFF + c0;
                    float b0[8], b1[8];
#pragma unroll
                    for (int e = 0; e < 8; ++e) { b0[e] = 0.f; b1[e] = 0.f; }
                    if (pos < 2) {
#pragma unroll
                        for (int e = 0; e < 8; ++e) { b0[e] = sc[e]; b1[e] = sc[DFF + e]; } }
#pragma unroll
                    for (int e = 0; e < 8; ++e) { p1[e] = pos >= 1 ? r1[e] : b1[e]; p2[e] = pos >= 2 ? r2[e] : (pos == 1 ? b1[e] : b0[e]); }
                    if (pos >= 6) { float* o = out_vs + (size_t)(b * 2 + (pos - 6)) * DFF + c0;
                        *(f32x4*)o = (f32x4){uu[0], uu[1], uu[2], uu[3]}; *(f32x4*)(o + 4) = (f32x4){uu[4], uu[5], uu[6], uu[7]}; }
                }
                if (valid) { float a[8];
#pragma unroll
                    for (int e = 0; e < 8; ++e) a[e] = gelu_tanh(cb[e] + w0[e] * p2[e] + w1[e] * p1[e] + w2[e] * uu[e]) * vv[e];
                    u32x4 w; w.x = cvt_pk_bf16(a[0], a[1]); w.y = cvt_pk_bf16(a[2], a[3]); w.z = cvt_pk_bf16(a[4], a[5]); w.w = cvt_pk_bf16(a[6], a[7]);
                    *(u32x4*)(ACT + (size_t)row * DFF + c0) = w; }
#pragma unroll
                for (int e = 0; e < 8; ++e) uprev[e] = uu[e];
            }
        }
    }
};
#ifndef LAS
#define LAS __attribute__((address_space(3)))
#endif
#define LDS_BARRIER() do { asm volatile("s_waitcnt lgkmcnt(0)" ::: "memory"); __builtin_amdgcn_s_barrier(); asm volatile("" ::: "memory"); } while (0)
typedef short bf16x8 __attribute__((ext_vector_type(8)));
constexpr int QT_OFF = 0, KT_OFF = 17408, KHT_OFF = 34816, VT_OFF = 53248, SW_OFF = 73984, ST_OFF = 83200, RAWV_OFF = 122368, SM_OFF = 138752;
constexpr int F_DLAST = 0, F_PTOT = 128, F_SG = 640, F_SM = 704, F_SWI = 768, F_SMT = 832, F_SWEND = 896, F_SDEN = 960, F_SSSQ = 1024, F_SCAL = 1152;
__device__ __forceinline__ bf16x8 ldfrag(const LAS unsigned char* base, int stride_b, int row, int kcol) { return *(const LAS bf16x8*)(base + row * stride_b + kcol * 2); }
__device__ __forceinline__ f32x4 mfma16(bf16x8 a, bf16x8 b, f32x4 c) { return __builtin_amdgcn_mfma_f32_16x16x32_bf16(a, b, c, 0, 0, 0); }
__device__ __forceinline__ u32x2 pack4(f32x4 v) { return (u32x2){cvt_pk_bf16(v[0], v[1]), cvt_pk_bf16(v[2], v[3])}; }

template <bool IS_ML>
__device__ __forceinline__ void mixer_item(const Params& p, LAS unsigned char* L, const int sqi, const int h, const bool prompt) {
    const int tid = threadIdx.x, w = __builtin_amdgcn_readfirstlane(tid >> 6), lane = tid & 63, l15 = lane & 15, q4 = lane >> 4;
    const int Lc = prompt ? 64 : 8, nch = prompt ? 32 : 1;
    const int row0 = prompt ? sqi * 2048 : MPROMPT + sqi * 8;
    const bf16_t* PROJ = (const bf16_t*)(p.ws + WS_R1) + (IS_ML ? 2048 : 0) + h * 128;
    bf16_t* AMIX = (bf16_t*)p.out + (size_t)MROWS * DM + (IS_ML ? 512 : 0) + h * 128;
    const float* GATES = (const float*)(p.ws + WS_GATES);
    LAS unsigned char* Qt = L + QT_OFF; LAS unsigned char* Kt = L + KT_OFF; LAS unsigned char* KhT = L + KHT_OFF; LAS unsigned char* VT = L + VT_OFF;
    LAS unsigned char* Sw = L + SW_OFF; LAS unsigned char* ST = L + ST_OFF; LAS unsigned char* rawV = L + RAWV_OFF; LAS float* sm = (LAS float*)(L + SM_OFF);
    constexpr int NV = IS_ML ? 9 : 8;
    const int tt = w & 3, vb = w >> 2;
    const size_t sbase = (size_t)(sqi * 4 + h) * 128 * 128;
    f32x4 sacc[NV];
    float m_prev = 0.f;
#pragma unroll
    for (int vt = 0; vt < NV; ++vt) sacc[vt] = (f32x4){0.f, 0.f, 0.f, 0.f};
    if (!prompt) {
        const float* S0 = IS_ML ? p.in[3] : p.in[2];
#pragma unroll
        for (int vt = 0; vt < 8; ++vt)
#pragma unroll
            for (int j = 0; j < 4; ++j) sacc[vt][j] = S0[sbase + (size_t)(w * 16 + q4 * 4 + j) * 128 + vt * 16 + l15];
        if (IS_ML) { m_prev = p.in[5][sqi * 4 + h];
            if (l15 == 0) {
#pragma unroll
                for (int j = 0; j < 4; ++j) sacc[NV - 1][j] = p.in[4][(size_t)(sqi * 4 + h) * 128 + w * 16 + q4 * 4 + j]; } }
    }
    float gnr[4][4];
    { const float* gn = (IS_ML ? p.in[13] : p.in[10]) + h * 128;
#pragma unroll
        for (int i = 0; i < 4; ++i)
#pragma unroll
            for (int j = 0; j < 4; ++j) gnr[i][j] = gn[(vb * 4 + i) * 16 + q4 * 4 + j]; }
    u32x4 rq[2], rk[2], rv[2];
    auto load_raw = [&](int c) {
#pragma unroll
        for (int i = 0; i < 2; ++i) { const int pc = tid + 512 * i, r = pc >> 4, c8 = pc & 15;
            if (r < Lc) { const bf16_t* src = PROJ + (size_t)(row0 + c * 64 + r) * NPROJ + c8 * 8;
                rq[i] = *(const u32x4*)src; rk[i] = *(const u32x4*)(src + 512); rv[i] = *(const u32x4*)(src + 1024); }
            else { rq[i] = (u32x4){0u, 0u, 0u, 0u}; rk[i] = rq[i]; rv[i] = rq[i]; } }
    };
    load_raw(0);
    LDS_BARRIER();
#pragma unroll
    for (int vt = 0; vt < NV; ++vt) *(LAS u32x2*)(ST + (vt * 16 + l15) * 272 + (w * 16 + q4 * 4) * 2) = pack4(sacc[vt]);
    if (IS_ML) { for (int i = tid; i < 16 * 72; i += 512) *(LAS unsigned short*)(VT + (128 * 72 + i) * 2) = (i < 72) ? (unsigned short)0x3F80 : (unsigned short)0; }
    for (int c = 0; c < nch; ++c) {
#pragma unroll
        for (int i = 0; i < 2; ++i) { const int pc = tid + 512 * i, r = pc >> 4, c8 = pc & 15;
            *(LAS u32x4*)(Qt + r * 272 + c8 * 16) = rq[i]; *(LAS u32x4*)(Kt + r * 272 + c8 * 16) = rk[i]; *(LAS u32x4*)(rawV + r * 256 + c8 * 16) = rv[i]; }
        if (IS_ML && w == 0) {
            const int t = lane; float lf = 0.f, ig = -INFINITY;
            if (t < Lc) { const float* gp = GATES + (size_t)(row0 + c * 64 + t) * 8; ig = gp[h]; lf = gp[4 + h]; }
            float a = lf;
#pragma unroll
            for (int o = 1; o < 64; o <<= 1) { const float x = __shfl_up(a, o); if (lane >= o) a += x; }
            const float g = ig - a; float cm = g;
#pragma unroll
            for (int o = 1; o < 64; o <<= 1) { const float x = __shfl_up(cm, o); if (lane >= o) cm = fmaxf(cm, x); }
            const float M = fmaxf(m_prev, cm), M63 = __shfl(M, 63), a63 = __shfl(a, 63);
            sm[F_SG + t] = g; sm[F_SM + t] = M; sm[F_SWI + t] = __expf(m_prev - M); sm[F_SMT + t] = a + M; sm[F_SWEND + t] = __expf(g - M63);
            if (lane == 0) { sm[F_SCAL + 0] = __expf(m_prev - M63); sm[F_SCAL + 1] = a63 + M63; }
        }
        LDS_BARRIER();
        if (c + 1 < nch) load_raw(c + 1);
        { const int k = tid & 127, part = tid >> 7; unsigned short kh[16];
            if (!IS_ML) {
                float lfv[16], cs[16]; float run = 0.f;
#pragma unroll
                for (int i = 0; i < 16; ++i) { lfv[i] = bf2f(*(const LAS unsigned short*)(Kt + (part * 16 + i) * 272 + k * 2)); run += lfv[i]; cs[i] = run; }
                sm[F_PTOT + part * 128 + k] = run;
                LDS_BARRIER();
                float pre = 0.f, tot = 0.f;
#pragma unroll
                for (int pp = 0; pp < 4; ++pp) { const float x = sm[F_PTOT + pp * 128 + k]; tot += x; if (pp < part) pre += x; }
                if (part == 0) sm[F_DLAST + k] = __expf(tot);
#pragma unroll
                for (int i = 0; i < 16; ++i) { const int s = part * 16 + i; const float b = pre + cs[i], e = __expf(b), r = __builtin_amdgcn_rcpf(e), kk = 1.f - __expf(lfv[i]);
                    LAS unsigned short* qp = (LAS unsigned short*)(Qt + s * 272 + k * 2); *qp = f2bf(bf2f(*qp) * e);
                    *(LAS unsigned short*)(Kt + s * 272 + k * 2) = f2bf(kk * r); kh[i] = f2bf(kk * __expf(tot - b)); }
            } else {
#pragma unroll
                for (int i = 0; i < 16; ++i) { const int s = part * 16 + i; kh[i] = f2bf(bf2f(*(const LAS unsigned short*)(Kt + s * 272 + k * 2)) * sm[F_SWEND + s]); }
            }
            u32x4 w0, w1;
            w0.x = kh[0] | ((unsigned)kh[1] << 16); w0.y = kh[2] | ((unsigned)kh[3] << 16); w0.z = kh[4] | ((unsigned)kh[5] << 16); w0.w = kh[6] | ((unsigned)kh[7] << 16);
            w1.x = kh[8] | ((unsigned)kh[9] << 16); w1.y = kh[10] | ((unsigned)kh[11] << 16); w1.z = kh[12] | ((unsigned)kh[13] << 16); w1.w = kh[14] | ((unsigned)kh[15] << 16);
            *(LAS u32x4*)(KhT + k * 144 + part * 32) = w0; *(LAS u32x4*)(KhT + k * 144 + part * 32 + 16) = w1;
            unsigned short vv[16];
#pragma unroll
            for (int i = 0; i < 16; ++i) vv[i] = *(const LAS unsigned short*)(rawV + (part * 16 + i) * 256 + k * 2);
            w0.x = vv[0] | ((unsigned)vv[1] << 16); w0.y = vv[2] | ((unsigned)vv[3] << 16); w0.z = vv[4] | ((unsigned)vv[5] << 16); w0.w = vv[6] | ((unsigned)vv[7] << 16);
            w1.x = vv[8] | ((unsigned)vv[9] << 16); w1.y = vv[10] | ((unsigned)vv[11] << 16); w1.z = vv[12] | ((unsigned)vv[13] << 16); w1.w = vv[14] | ((unsigned)vv[15] << 16);
            *(LAS u32x4*)(VT + k * 144 + part * 32) = w0; *(LAS u32x4*)(VT + k * 144 + part * 32 + 16) = w1;
        }
        LDS_BARRIER();
        { const int pt = w >> 1;
#pragma unroll
            for (int e = 0; e < 2; ++e) { const int st = 2 * (w & 1) + e; f32x4 pa = (f32x4){0.f, 0.f, 0.f, 0.f};
                if (st <= pt) {
#pragma unroll
                    for (int ks = 0; ks < 4; ++ks) pa = mfma16(ldfrag(Kt, 272, st * 16 + l15, ks * 32 + q4 * 8), ldfrag(Qt, 272, pt * 16 + l15, ks * 32 + q4 * 8), pa); }
                const int t = pt * 16 + l15, s0 = st * 16 + q4 * 4; const float Mt = IS_ML ? sm[F_SM + t] : 0.f;
#pragma unroll
                for (int j = 0; j < 4; ++j) { const int s = s0 + j; float x = pa[j]; if (IS_ML) x *= __expf(sm[F_SG + s] - Mt); pa[j] = (s <= t) ? x : 0.f; }
                *(LAS u32x2*)(Sw + t * 144 + s0 * 2) = pack4(pa); } }
        f32x4 oacc[5];
        { bf16x8 bq[4];
#pragma unroll
            for (int ks = 0; ks < 4; ++ks) bq[ks] = ldfrag(Qt, 272, tt * 16 + l15, ks * 32 + q4 * 8);
            const float wi = IS_ML ? sm[F_SWI + tt * 16 + l15] : 1.f;
#pragma unroll
            for (int i = 0; i < 5; ++i) { oacc[i] = (f32x4){0.f, 0.f, 0.f, 0.f};
                if (i < 4 || (IS_ML && vb == 1)) { const int vt = i < 4 ? vb * 4 + i : 8;
#pragma unroll
                    for (int ks = 0; ks < 4; ++ks) oacc[i] = mfma16(ldfrag(ST, 272, vt * 16 + l15, ks * 32 + q4 * 8), bq[ks], oacc[i]);
                    if (IS_ML) oacc[i] = oacc[i] * wi; } } }
        LDS_BARRIER();
        { bf16x8 bs[2];
#pragma unroll
            for (int ks = 0; ks < 2; ++ks) bs[ks] = ldfrag(Sw, 144, tt * 16 + l15, ks * 32 + q4 * 8);
#pragma unroll
            for (int i = 0; i < 5; ++i) if (i < 4 || (IS_ML && vb == 1)) { const int vt = i < 4 ? vb * 4 + i : 8;
#pragma unroll
                for (int ks = 0; ks < 2; ++ks) oacc[i] = mfma16(ldfrag(VT, 144, vt * 16 + l15, ks * 32 + q4 * 8), bs[ks], oacc[i]); } }
        { bf16x8 ak[2];
#pragma unroll
            for (int ks = 0; ks < 2; ++ks) ak[ks] = ldfrag(KhT, 144, w * 16 + l15, ks * 32 + q4 * 8);
            f32x4 dl;
            if (IS_ML) { const float fe = sm[F_SCAL + 0]; dl = (f32x4){fe, fe, fe, fe}; m_prev = sm[F_SCAL + 1]; }
            else dl = *(const LAS f32x4*)(sm + F_DLAST + w * 16 + q4 * 4);
#pragma unroll
            for (int vt = 0; vt < NV; ++vt) { sacc[vt] = sacc[vt] * dl;
#pragma unroll
                for (int ks = 0; ks < 2; ++ks) sacc[vt] = mfma16(ak[ks], ldfrag(VT, 144, vt * 16 + l15, ks * 32 + q4 * 8), sacc[vt]);
                *(LAS u32x2*)(ST + (vt * 16 + l15) * 272 + (w * 16 + q4 * 4) * 2) = pack4(sacc[vt]); } }
        const int t = tt * 16 + l15;
        if (IS_ML) {
            if (vb == 1 && q4 == 0) sm[F_SDEN + t] = oacc[4][0];
            LDS_BARRIER();
            const float inv = 1.0f / fmaxf(fabsf(sm[F_SDEN + t]), __expf(-sm[F_SMT + t]));
#pragma unroll
            for (int i = 0; i < 4; ++i) oacc[i] = oacc[i] * inv;
        }
        float ss = 0.f;
#pragma unroll
        for (int i = 0; i < 4; ++i) ss += (oacc[i][0] * oacc[i][0] + oacc[i][1] * oacc[i][1]) + (oacc[i][2] * oacc[i][2] + oacc[i][3] * oacc[i][3]);
        ss += __shfl_xor(ss, 16); ss += __shfl_xor(ss, 32);
        if (q4 == 0) sm[F_SSSQ + t * 2 + vb] = ss;
        LDS_BARRIER();
        if (t < Lc) { const float rs = rsqrtf((sm[F_SSSQ + t * 2] + sm[F_SSSQ + t * 2 + 1]) * (1.f / 128.f) + EPS);
            const size_t row = (size_t)row0 + c * 64 + t;
#pragma unroll
            for (int i = 0; i < 4; ++i) { const int v0 = (vb * 4 + i) * 16 + q4 * 4; const u32x2 gt = *(const u32x2*)(PROJ + row * NPROJ + 1536 + v0);
                f32x4 o; o[0] = oacc[i][0] * rs * gnr[i][0] * __uint_as_float(gt.x << 16); o[1] = oacc[i][1] * rs * gnr[i][1] * __uint_as_float(gt.x & 0xffff0000u);
                o[2] = oacc[i][2] * rs * gnr[i][2] * __uint_as_float(gt.y << 16); o[3] = oacc[i][3] * rs * gnr[i][3] * __uint_as_float(gt.y & 0xffff0000u);
                *(u32x2*)(AMIX + row * DM + v0) = pack4(o); } }
    }
    { float* So = p.out + (IS_ML ? (prompt ? O_CP : O_CS) : (prompt ? O_SP : O_SS));
#pragma unroll
        for (int vt = 0; vt < 8; ++vt)
#pragma unroll
            for (int j = 0; j < 4; ++j) So[sbase + (size_t)(w * 16 + q4 * 4 + j) * 128 + vt * 16 + l15] = sacc[vt][j];
        if (IS_ML) { if (l15 == 0) { float* no = p.out + (prompt ? O_NP : O_NS) + (size_t)(sqi * 4 + h) * 128;
#pragma unroll
                for (int j = 0; j < 4; ++j) no[w * 16 + q4 * 4 + j] = sacc[NV - 1][j]; }
            if (tid == 0) p.out[(prompt ? O_MP : O_MS) + sqi * 4 + h] = m_prev; } }
}
__device__ __forceinline__ void mixer_dispatch(const Params& p, LAS unsigned char* L, int it) {
    int g, sqi, h; const bool prompt = it < 64;
    if (prompt) { g = it >> 5; sqi = (it >> 2) & 7; h = it & 3; } else { const int j = it - 64; g = j >> 9; sqi = (j >> 2) & 127; h = j & 3; }
    if (g == 0) mixer_item<false>(p, L, sqi, h, prompt); else mixer_item<true>(p, L, sqi, h, prompt);
}
__device__ __forceinline__ void phase2_chunked(const Params& p, LAS unsigned char* L) {
    const int G = gridDim.x, b = blockIdx.x;
    if (G > 64) { if (b < 64) mixer_dispatch(p, L, b); else for (int it = b; it < 1088; it += G - 64) mixer_dispatch(p, L, it); }
    else for (int it = b; it < 1088; it += G) mixer_dispatch(p, L, it);
}
constexpr size_t WS_SB = WS_X1;
template <bool IS_ML>
__device__ __forceinline__ void prepass_item(const Params& p, LAS unsigned char* L, const int sqi, const int c, const int h, u32x4 (&rq)[2], u32x4 (&rk)[2], u32x4 (&rv)[2], float& gig, float& glf,
                                             const bf16_t* nsrc, const float* ngates) {
    const int tid = threadIdx.x, w = __builtin_amdgcn_readfirstlane(tid >> 6), lane = tid & 63, l15 = lane & 15, q4 = lane >> 4;
    const int row0 = sqi * 2048 + c * 64;
    bf16_t* PROJ = (bf16_t*)(p.ws + WS_R1) + (IS_ML ? 2048 : 0) + h * 128;
    bf16_t* AMIX = (bf16_t*)p.out + (size_t)MROWS * DM + (IS_ML ? 512 : 0) + h * 128;
    float* SB = (float*)(p.ws + WS_SB) + (size_t)((((IS_ML ? 8 : 0) + sqi) * 32 + c) * 4 + h) * 256;
    LAS unsigned char* Qt = L + QT_OFF; LAS unsigned char* Kt = L + KT_OFF; LAS unsigned char* KhT = L + KHT_OFF; LAS unsigned char* VT = L + VT_OFF;
    LAS unsigned char* Sw = L + SW_OFF; LAS unsigned char* rawV = L + RAWV_OFF; LAS float* sm = (LAS float*)(L + SM_OFF);
    const int tt = w & 3, vb = w >> 2;
    LDS_BARRIER();
    if (IS_ML) { for (int i = tid; i < 16 * 72; i += 512) *(LAS unsigned short*)(VT + (128 * 72 + i) * 2) = (i < 72) ? (unsigned short)0x3F80 : (unsigned short)0; }
#pragma unroll
    for (int i = 0; i < 2; ++i) { const int pc = tid + 512 * i, r = pc >> 4, c8 = pc & 15;
        *(LAS u32x4*)(Qt + r * 272 + c8 * 16) = rq[i]; *(LAS u32x4*)(Kt + r * 272 + c8 * 16) = rk[i]; *(LAS u32x4*)(rawV + r * 256 + c8 * 16) = rv[i]; }
    if (IS_ML && w == 0) {
        const int t = lane; const float ig = gig, lf = glf;
        float a = lf;
#pragma unroll
        for (int o = 1; o < 64; o <<= 1) { const float x = __shfl_up(a, o); if (lane >= o) a += x; }
        const float g = ig - a; float cm = g;
#pragma unroll
        for (int o = 1; o < 64; o <<= 1) { const float x = __shfl_up(cm, o); if (lane >= o) cm = fmaxf(cm, x); }
        const float M63 = __shfl(cm, 63);
        sm[F_SG + t] = g; sm[F_SM + t] = cm; sm[F_SWEND + t] = __expf(g - M63);
        SB[64 + t] = cm; SB[128 + t] = a;
    }
    if (nsrc) {
#pragma unroll
        for (int i = 0; i < 2; ++i) { const int pc = tid + 512 * i, r = pc >> 4, c8 = pc & 15; const bf16_t* src = nsrc + (size_t)r * NPROJ + c8 * 8;
            rq[i] = *(const u32x4*)src; rk[i] = *(const u32x4*)(src + 512); rv[i] = *(const u32x4*)(src + 1024); }
        if (ngates && w == 0) { gig = ngates[lane * 8]; glf = ngates[lane * 8 + 4]; } }
    LDS_BARRIER();
    { const int k = tid & 127, part = tid >> 7; unsigned short kh[16];
        if (!IS_ML) {
            float lfv[16], cs[16]; float run = 0.f;
#pragma unroll
            for (int i = 0; i < 16; ++i) { lfv[i] = bf2f(*(const LAS unsigned short*)(Kt + (part * 16 + i) * 272 + k * 2)); run += lfv[i]; cs[i] = run; }
            sm[F_PTOT + part * 128 + k] = run;
            LDS_BARRIER();
            float pre = 0.f, tot = 0.f;
#pragma unroll
            for (int pp = 0; pp < 4; ++pp) { const float x = sm[F_PTOT + pp * 128 + k]; tot += x; if (pp < part) pre += x; }
            if (part == 0) SB[k] = __expf(tot);
#pragma unroll
            for (int i = 0; i < 16; ++i) { const int s = part * 16 + i; const float b = pre + cs[i], e = __expf(b), r = __builtin_amdgcn_rcpf(e), kk = 1.f - __expf(lfv[i]);
                LAS unsigned short* qp = (LAS unsigned short*)(Qt + s * 272 + k * 2); *qp = f2bf(bf2f(*qp) * e);
                *(LAS unsigned short*)(Kt + s * 272 + k * 2) = f2bf(kk * r); kh[i] = f2bf(kk * __expf(tot - b)); }
        } else {
#pragma unroll
            for (int i = 0; i < 16; ++i) { const int s = part * 16 + i; kh[i] = f2bf(bf2f(*(const LAS unsigned short*)(Kt + s * 272 + k * 2)) * sm[F_SWEND + s]); }
        }
        u32x4 w0, w1;
        w0.x = kh[0] | ((unsigned)kh[1] << 16); w0.y = kh[2] | ((unsigned)kh[3] << 16); w0.z = kh[4] | ((unsigned)kh[5] << 16); w0.w = kh[6] | ((unsigned)kh[7] << 16);
        w1.x = kh[8] | ((unsigned)kh[9] << 16); w1.y = kh[10] | ((unsigned)kh[11] << 16); w1.z = kh[12] | ((unsigned)kh[13] << 16); w1.w = kh[14] | ((unsigned)kh[15] << 16);
        *(LAS u32x4*)(KhT + k * 144 + part * 32) = w0; *(LAS u32x4*)(KhT + k * 144 + part * 32 + 16) = w1;
        unsigned short vv[16];
#pragma unroll
        for (int i = 0; i < 16; ++i) vv[i] = *(const LAS unsigned short*)(rawV + (part * 16 + i) * 256 + k * 2);
        w0.x = vv[0] | ((unsigned)vv[1] << 16); w0.y = vv[2] | ((unsigned)vv[3] << 16); w0.z = vv[4] | ((unsigned)vv[5] << 16); w0.w = vv[6] | ((unsigned)vv[7] << 16);
        w1.x = vv[8] | ((unsigned)vv[9] << 16); w1.y = vv[10] | ((unsigned)vv[11] << 16); w1.z = vv[12] | ((unsigned)vv[13] << 16); w1.w = vv[14] | ((unsigned)vv[15] << 16);
        *(LAS u32x4*)(VT + k * 144 + part * 32) = w0; *(LAS u32x4*)(VT + k * 144 + part * 32 + 16) = w1;
    }
    LDS_BARRIER();
    { const int pt = w >> 1;
#pragma unroll
        for (int e = 0; e < 2; ++e) { const int st = 2 * (w & 1) + e; f32x4 pa = (f32x4){0.f, 0.f, 0.f, 0.f};
            if (st <= pt) {
#pragma unroll
                for (int ks = 0; ks < 4; ++ks) pa = mfma16(ldfrag(Kt, 272, st * 16 + l15, ks * 32 + q4 * 8), ldfrag(Qt, 272, pt * 16 + l15, ks * 32 + q4 * 8), pa); }
            const int t = pt * 16 + l15, s0 = st * 16 + q4 * 4; const float Mt = IS_ML ? sm[F_SM + t] : 0.f;
#pragma unroll
            for (int j = 0; j < 4; ++j) { const int s = s0 + j; float x = pa[j]; if (IS_ML) x *= __expf(sm[F_SG + s] - Mt); pa[j] = (s <= t) ? x : 0.f; }
            *(LAS u32x2*)(Sw + t * 144 + s0 * 2) = pack4(pa); } }
#pragma unroll
    for (int i = 0; i < 2; ++i) { const int pc = tid + 512 * i;
        if (!IS_ML) { const int r = pc >> 4, c8 = pc & 15; *(u32x4*)(PROJ + (size_t)(row0 + r) * NPROJ + c8 * 8) = *(const LAS u32x4*)(Qt + r * 272 + c8 * 16); }
        const int k = pc >> 3, s8 = pc & 7; bf16_t* dst = PROJ + (size_t)(row0 + (k >> 1)) * NPROJ + (k & 1) * 64 + s8 * 8;
        *(u32x4*)(dst + 512) = *(const LAS u32x4*)(KhT + k * 144 + s8 * 16); *(u32x4*)(dst + 1024) = *(const LAS u32x4*)(VT + k * 144 + s8 * 16); }
    LDS_BARRIER();
    { bf16x8 bs[2];
#pragma unroll
        for (int ks = 0; ks < 2; ++ks) bs[ks] = ldfrag(Sw, 144, tt * 16 + l15, ks * 32 + q4 * 8);
#pragma unroll
        for (int i = 0; i < 5; ++i) if (i < 4 || (IS_ML && vb == 1)) { const int vt = i < 4 ? vb * 4 + i : 8; f32x4 o = (f32x4){0.f, 0.f, 0.f, 0.f};
#pragma unroll
            for (int ks = 0; ks < 2; ++ks) o = mfma16(ldfrag(VT, 144, vt * 16 + l15, ks * 32 + q4 * 8), bs[ks], o);
            const int t = tt * 16 + l15;
            if (i < 4) *(u32x2*)(AMIX + (size_t)(row0 + t) * DM + vt * 16 + q4 * 4) = pack4(o);
            else if (q4 == 0) SB[t] = o[0]; } }
}
constexpr int C_QT = 0, C_KHT = 17408, C_VT = 35840, C_ST0 = 56576, C_ST1 = 95744, C_SM = 134912;
constexpr int CF_WI = 0, CF_RHO = 64, CF_DEN = 128, CF_EMT = 192, CF_SCAL = 256, CF_SSSQ = 272;
template <bool IS_ML>
__device__ __forceinline__ void chain_run(const Params& p, LAS unsigned char* L, const int sqi, const int h, const bool write_out = true) {
    const int tid = threadIdx.x, w = __builtin_amdgcn_readfirstlane(tid >> 6), lane = tid & 63, l15 = lane & 15, q4 = lane >> 4;
    const int row0 = sqi * 2048;
    const bf16_t* PROJ = (const bf16_t*)(p.ws + WS_R1) + (IS_ML ? 2048 : 0) + h * 128;
    bf16_t* AMIX = (bf16_t*)p.out + (size_t)MROWS * DM + (IS_ML ? 512 : 0) + h * 128;
    const float* SB0 = (const float*)(p.ws + WS_SB) + (size_t)((((IS_ML ? 8 : 0) + sqi) * 32) * 4 + h) * 256;
    LAS unsigned char* Qt = L + C_QT; LAS unsigned char* KhT = L + C_KHT; LAS unsigned char* VT = L + C_VT; LAS float* sm = (LAS float*)(L + C_SM);
    constexpr int NV = IS_ML ? 9 : 8;
    const int tt = w & 3, vb = w >> 2, t = tt * 16 + l15;
    const size_t sbase = (size_t)(sqi * 4 + h) * 128 * 128;
    f32x4 sacc[NV];
#pragma unroll
    for (int vt = 0; vt < NV; ++vt) sacc[vt] = (f32x4){0.f, 0.f, 0.f, 0.f};
    float m_prev = 0.f;
    const float* gn = (IS_ML ? p.in[13] : p.in[10]) + h * 128;
    u32x4 rq[2], rk[2], rv[2]; u32x2 rin[4], rgt[4]; f32x4 dl = (f32x4){0.f, 0.f, 0.f, 0.f}; float s_den = 0.f, s_ml = 0.f, s_a = 0.f;
    auto prefetch_big = [&](int c) {
#pragma unroll
        for (int i = 0; i < 2; ++i) { const int pc = tid + 512 * i; const int r = pc >> 4, c8 = pc & 15;
            rq[i] = *(const u32x4*)(PROJ + (size_t)(row0 + c * 64 + r) * NPROJ + c8 * 8);
            const int k = pc >> 3, s8 = pc & 7; const bf16_t* src = PROJ + (size_t)(row0 + c * 64 + (k >> 1)) * NPROJ + (k & 1) * 64 + s8 * 8;
            rk[i] = *(const u32x4*)(src + 512); rv[i] = *(const u32x4*)(src + 1024); }
    };
    auto prefetch_io = [&](int c) {
        const size_t row = (size_t)row0 + c * 64 + t;
#pragma unroll
        for (int i = 0; i < 4; ++i) { const int v0 = (vb * 4 + i) * 16 + q4 * 4; rin[i] = *(const u32x2*)(AMIX + row * DM + v0); rgt[i] = *(const u32x2*)(PROJ + row * NPROJ + 1536 + v0); }
    };
    auto prefetch_sb = [&](int c, f32x4& dl_, float& d_, float& ml_, float& a_) {
        const float* sb = SB0 + (size_t)c * 1024;
        if (!IS_ML) dl_ = *(const f32x4*)(sb + w * 16 + q4 * 4);
        else if (w == 0) { d_ = sb[lane]; ml_ = sb[64 + lane]; a_ = sb[128 + lane]; }
    };
    prefetch_big(0); prefetch_io(0); prefetch_sb(0, dl, s_den, s_ml, s_a);
    LDS_BARRIER();
#pragma unroll
    for (int vt = 0; vt < NV; ++vt) *(LAS u32x2*)(L + C_ST0 + (vt * 16 + l15) * 272 + (w * 16 + q4 * 4) * 2) = (u32x2){0u, 0u};
    if (IS_ML) { for (int i = tid; i < 16 * 72; i += 512) *(LAS unsigned short*)(VT + (128 * 72 + i) * 2) = (i < 72) ? (unsigned short)0x3F80 : (unsigned short)0; }
    for (int c = 0; c < 32; ++c) {
        LAS unsigned char* STr = L + ((c & 1) ? C_ST1 : C_ST0); LAS unsigned char* STw = L + ((c & 1) ? C_ST0 : C_ST1);
#pragma unroll
        for (int i = 0; i < 2; ++i) { const int pc = tid + 512 * i; const int r = pc >> 4, c8 = pc & 15, k = pc >> 3, s8 = pc & 7;
            *(LAS u32x4*)(Qt + r * 272 + c8 * 16) = rq[i]; *(LAS u32x4*)(KhT + k * 144 + s8 * 16) = rk[i]; *(LAS u32x4*)(VT + k * 144 + s8 * 16) = rv[i]; }
        if (IS_ML && w == 0) {
            const float M = fmaxf(m_prev, s_ml), M63 = __shfl(M, 63), ml63 = __shfl(s_ml, 63), a63 = __shfl(s_a, 63);
            sm[CF_WI + lane] = __expf(m_prev - M); sm[CF_RHO + lane] = __expf(s_ml - M); sm[CF_DEN + lane] = s_den; sm[CF_EMT + lane] = __expf(-(s_a + M));
            if (lane == 0) { sm[CF_SCAL + 0] = __expf(m_prev - M63); sm[CF_SCAL + 1] = __expf(ml63 - M63); sm[CF_SCAL + 2] = a63 + M63; }
        }
        LDS_BARRIER();
        f32x4 ndl = dl; float n_den = 0.f, n_ml = 0.f, n_a = 0.f;
        if (c + 1 < 32) { prefetch_big(c + 1); prefetch_sb(c + 1, ndl, n_den, n_ml, n_a); }
        float wi_t = 1.f, rho_t = 1.f, denl_t = 0.f, emt_t = 0.f, fend = 1.f, sigma = 1.f;
        if (IS_ML) { wi_t = sm[CF_WI + t]; rho_t = sm[CF_RHO + t]; denl_t = sm[CF_DEN + t]; emt_t = sm[CF_EMT + t]; fend = sm[CF_SCAL + 0]; sigma = sm[CF_SCAL + 1]; m_prev = sm[CF_SCAL + 2]; }
        f32x4 oacc[5];
        { bf16x8 bq[4];
#pragma unroll
            for (int ks = 0; ks < 4; ++ks) bq[ks] = ldfrag(Qt, 272, tt * 16 + l15, ks * 32 + q4 * 8);
#pragma unroll
            for (int i = 0; i < 5; ++i) { oacc[i] = (f32x4){0.f, 0.f, 0.f, 0.f};
                if (i < 4 || IS_ML) { const int vt = i < 4 ? vb * 4 + i : 8;
#pragma unroll
                    for (int ks = 0; ks < 4; ++ks) oacc[i] = mfma16(ldfrag(STr, 272, vt * 16 + l15, ks * 32 + q4 * 8), bq[ks], oacc[i]); } } }
        { bf16x8 ak[2];
#pragma unroll
            for (int ks = 0; ks < 2; ++ks) ak[ks] = ldfrag(KhT, 144, w * 16 + l15, ks * 32 + q4 * 8);
#pragma unroll
            for (int vt = 0; vt < NV; ++vt) {
                if (!IS_ML) { sacc[vt] = sacc[vt] * dl;
#pragma unroll
                    for (int ks = 0; ks < 2; ++ks) sacc[vt] = mfma16(ak[ks], ldfrag(VT, 144, vt * 16 + l15, ks * 32 + q4 * 8), sacc[vt]); }
                else { f32x4 uacc = (f32x4){0.f, 0.f, 0.f, 0.f};
#pragma unroll
                    for (int ks = 0; ks < 2; ++ks) uacc = mfma16(ak[ks], ldfrag(VT, 144, vt * 16 + l15, ks * 32 + q4 * 8), uacc);
                    sacc[vt] = sacc[vt] * fend + uacc * sigma; }
                *(LAS u32x2*)(STw + (vt * 16 + l15) * 272 + (w * 16 + q4 * 4) * 2) = pack4(sacc[vt]); } }
        float inv = 1.f;
        if (IS_ML) { const float di = __shfl(oacc[4][0], l15); inv = 1.0f / fmaxf(fabsf(wi_t * di + rho_t * denl_t), emt_t); }
        float ss = 0.f;
#pragma unroll
        for (int i = 0; i < 4; ++i) { f32x4 in; in[0] = __uint_as_float(rin[i].x << 16); in[1] = __uint_as_float(rin[i].x & 0xffff0000u); in[2] = __uint_as_float(rin[i].y << 16); in[3] = __uint_as_float(rin[i].y & 0xffff0000u);
            if (IS_ML) oacc[i] = (oacc[i] * wi_t + in * rho_t) * inv; else oacc[i] = oacc[i] + in;
            ss += (oacc[i][0] * oacc[i][0] + oacc[i][1] * oacc[i][1]) + (oacc[i][2] * oacc[i][2] + oacc[i][3] * oacc[i][3]); }
        ss += __shfl_xor(ss, 16); ss += __shfl_xor(ss, 32);
        LAS float* sq = sm + CF_SSSQ + (c & 1) * 128;
        if (q4 == 0) sq[t * 2 + vb] = ss;
        LDS_BARRIER();
        { const float rs = rsqrtf((sq[t * 2] + sq[t * 2 + 1]) * (1.f / 128.f) + EPS); const size_t row = (size_t)row0 + c * 64 + t;
#pragma unroll
            for (int i = 0; i < 4; ++i) { const int v0 = (vb * 4 + i) * 16 + q4 * 4; const u32x2 gt = rgt[i];
                const f32x4 gv = *(const f32x4*)(gn + v0);
                f32x4 o; o[0] = oacc[i][0] * rs * gv[0] * __uint_as_float(gt.x << 16); o[1] = oacc[i][1] * rs * gv[1] * __uint_as_float(gt.x & 0xffff0000u);
                o[2] = oacc[i][2] * rs * gv[2] * __uint_as_float(gt.y << 16); o[3] = oacc[i][3] * rs * gv[3] * __uint_as_float(gt.y & 0xffff0000u);
                if (write_out) *(u32x2*)(AMIX + row * DM + v0) = pack4(o); } }
        if (c + 1 < 32) prefetch_io(c + 1);
        dl = ndl; s_den = n_den; s_ml = n_ml; s_a = n_a;
    }
    { float* So = p.out + (IS_ML ? O_CP : O_SP);
#pragma unroll
        for (int vt = 0; vt < 8; ++vt)
#pragma unroll
            for (int j = 0; j < 4; ++j) So[sbase + (size_t)(w * 16 + q4 * 4 + j) * 128 + vt * 16 + l15] = sacc[vt][j];
        if (IS_ML) { if (l15 == 0) { float* no = p.out + O_NP + (size_t)(sqi * 4 + h) * 128;
#pragma unroll
                for (int j = 0; j < 4; ++j) no[w * 16 + q4 * 4 + j] = sacc[NV - 1][j]; }
            if (tid == 0) p.out[O_MP + sqi * 4 + h] = m_prev; } }
}
#ifndef SAMPLE_TWICE
#define SAMPLE_TWICE 0
#endif
#ifndef SAMPLE_TWICE
#define SAMPLE_TWICE 0
#endif
#ifndef CHAIN_TWICE
#define CHAIN_TWICE 0
#endif
#ifndef NS_A
#define NS_A 0
#endif
__device__ __forceinline__ void sample_dispatch(const Params& p, LAS unsigned char* L, int j) {
    const int g = j >> 9, sqi = (j >> 2) & 127, h = j & 3;
    if (g == 0) mixer_item<false>(p, L, sqi, h, false); else mixer_item<true>(p, L, sqi, h, false);
}
__device__ __forceinline__ void phase2a(const Params& p, LAS unsigned char* L) {
    const int tid = threadIdx.x, lane = tid & 63, w = tid >> 6;
    u32x4 rq[2], rk[2], rv[2]; float gig = 0.f, glf = 0.f;
    auto slot = [&](int it) -> const bf16_t* { const int g = it >> 10, sqi = (it >> 7) & 7, c = (it >> 2) & 31, h = it & 3; return (const bf16_t*)(p.ws + WS_R1) + (size_t)(sqi * 2048 + c * 64) * NPROJ + (g ? 2048 : 0) + h * 128; };
    auto gptr = [&](int it) -> const float* { const int g = it >> 10, sqi = (it >> 7) & 7, c = (it >> 2) & 31, h = it & 3; return g ? (const float*)(p.ws + WS_GATES) + (size_t)(sqi * 2048 + c * 64) * 8 + h : nullptr; };
    int it = blockIdx.x;
    if (it < 2048) { const bf16_t* s0 = slot(it);
#pragma unroll
        for (int i = 0; i < 2; ++i) { const int pc = tid + 512 * i, r = pc >> 4, c8 = pc & 15; const bf16_t* src = s0 + (size_t)r * NPROJ + c8 * 8;
            rq[i] = *(const u32x4*)src; rk[i] = *(const u32x4*)(src + 512); rv[i] = *(const u32x4*)(src + 1024); }
        const float* g0 = gptr(it); if (g0 && w == 0) { gig = g0[lane * 8]; glf = g0[lane * 8 + 4]; } }
    for (; it < 2048; it += gridDim.x) { const int g = it >> 10, sqi = (it >> 7) & 7, c = (it >> 2) & 31, h = it & 3; const int nx = it + gridDim.x;
        const bf16_t* ns = nx < 2048 ? slot(nx) : nullptr; const float* ng = nx < 2048 ? gptr(nx) : nullptr;
        if (g == 0) prepass_item<false>(p, L, sqi, c, h, rq, rk, rv, gig, glf, ns, ng); else prepass_item<true>(p, L, sqi, c, h, rq, rk, rv, gig, glf, ns, ng); }
}
__device__ __forceinline__ void phase2a_samples(const Params& p, LAS unsigned char* L) {
    for (int it = 2048 + blockIdx.x; it < 2048 + NS_A; it += gridDim.x) { sample_dispatch(p, L, it - 2048); if (SAMPLE_TWICE) sample_dispatch(p, L, it - 2048); }
}
__device__ __forceinline__ void phase2_naive(const Params& p, unsigned char* shm) {
    float* sq = (float*)shm; float* sd = sq + 128; float* si = sd + 128; float* sv = si + 128; float* part = sv + 128; float* denp = part + 512; float* red = denp + 4;
    const int tid = threadIdx.x, v = tid & 127, kq = tid >> 7;
    const bf16_t* PROJ = (const bf16_t*)(p.ws + WS_R1); bf16_t* AMIX = (bf16_t*)p.out + (size_t)MROWS * DM; const float* GATES = (const float*)(p.ws + WS_GATES);
    for (int it = blockIdx.x; it < 1088; it += gridDim.x) {
        int g, sqi, h, T, row0; const bool prompt = it < 64;
        if (prompt) { g = it >> 5; sqi = (it >> 2) & 7; h = it & 3; T = 2048; row0 = sqi * 2048; }
        else { const int j = it - 64; g = j >> 9; sqi = (j >> 2) & 127; h = j & 3; T = 8; row0 = MPROMPT + sqi * 8; }
        float S[32], nst[32]; float mst = 0.f;
        const size_t sbase = ((size_t)(sqi * 4 + h) * 128) * 128;
#pragma unroll
        for (int i = 0; i < 32; ++i) { S[i] = 0.f; nst[i] = 0.f; }
        if (!prompt) { const float* S0 = g == 0 ? p.in[2] : p.in[3];
#pragma unroll
            for (int i = 0; i < 32; ++i) S[i] = S0[sbase + (size_t)(kq * 32 + i) * 128 + v];
            if (g == 1) { mst = p.in[5][sqi * 4 + h];
#pragma unroll
                for (int i = 0; i < 32; ++i) nst[i] = p.in[4][(size_t)(sqi * 4 + h) * 128 + kq * 32 + i]; } }
        const float* gn = (g == 0 ? p.in[10] : p.in[13]) + h * 128;
        for (int t = 0; t < T; ++t) {
            const size_t row = (size_t)row0 + t; const bf16_t* pr = PROJ + row * NPROJ + g * 2048 + h * 128;
            float m_new = 0.f;
            if (g == 0) {
                if (tid < 128) sq[tid] = bf2f(pr[tid]);
                else if (tid < 256) { const float f = __expf(bf2f(pr[512 + tid - 128])); sd[tid - 128] = f; si[tid - 128] = 1.f - f; }
                else if (tid < 384) sv[tid - 256] = bf2f(pr[1024 + tid - 256]);
            } else {
                const float ig = GATES[row * 8 + h], lf = GATES[row * 8 + 4 + h];
                m_new = fmaxf(lf + mst, ig); const float fd = __expf(lf + mst - m_new), ii = __expf(ig - m_new);
                if (tid < 128) sq[tid] = bf2f(pr[tid]);
                else if (tid < 256) { sd[tid - 128] = fd; si[tid - 128] = ii * bf2f(pr[512 + tid - 128]); }
                else if (tid < 384) sv[tid - 256] = bf2f(pr[1024 + tid - 256]);
            }
            __syncthreads();
            const float vv = sv[v]; float acc = 0.f, dacc = 0.f;
#pragma unroll
            for (int i = 0; i < 32; ++i) { const int k = kq * 32 + i; const float d = sd[k], ik = si[k], q = sq[k]; S[i] = d * S[i] + ik * vv; acc += q * S[i]; nst[i] = d * nst[i] + ik; dacc += q * nst[i]; }
            part[kq * 128 + v] = acc; if (v == 0) denp[kq] = dacc;
            __syncthreads();
            float o = 0.f;
            if (tid < 128) { o = (part[tid] + part[128 + tid]) + (part[256 + tid] + part[384 + tid]);
                if (g == 1) { const float den = (denp[0] + denp[1]) + (denp[2] + denp[3]); o = o / fmaxf(fabsf(den), __expf(-m_new)); }
                const float ss = wave_sum(o * o); if ((tid & 63) == 0) red[tid >> 6] = ss; }
            __syncthreads();
            if (tid < 128) { const float tot = red[0] + red[1]; const float gate = bf2f(pr[1536 + tid]);
                AMIX[row * DM + g * 512 + h * 128 + tid] = f2bf(o * rsqrtf(tot * (1.f / 128.f) + EPS) * gn[tid] * gate); }
            mst = m_new;
            __syncthreads();
        }
        float* So = p.out + (g == 0 ? (prompt ? O_SP : O_SS) : (prompt ? O_CP : O_CS));
#pragma unroll
        for (int i = 0; i < 32; ++i) So[sbase + (size_t)(kq * 32 + i) * 128 + v] = S[i];
        if (g == 1 && v == 0) { float* no = p.out + (prompt ? O_NP : O_NS) + (size_t)(sqi * 4 + h) * 128;
#pragma unroll
            for (int i = 0; i < 32; ++i) no[kq * 32 + i] = nst[i];
            if (kq == 0) p.out[(prompt ? O_MP : O_MS) + sqi * 4 + h] = mst; }
    }
}
__device__ __forceinline__ void phase5(const Params& p) {
    const float* UHL = (const float*)(p.ws + WS_UHL); const float* UHF = (const float*)(p.ws + WS_UHF); bf16_t* ACT = (bf16_t*)(p.ws + WS_R1 + R1_ACT);
    const float* cw = p.in[18]; const float* cbp = p.in[19];
    constexpr int NQ = DFF / 4;
    for (int i = blockIdx.x * 512 + threadIdx.x; i < 256 * 2 * NQ; i += gridDim.x * 512) {
        const int cq = i % NQ, j = (i / NQ) & 1, gi = i / (2 * NQ), c = 4 * cq; const int row = gi * 64 + j;
        const bool first = (gi & 31) == 0;
        const f32x4 z = (f32x4){0.f, 0.f, 0.f, 0.f};
        const f32x4 l0 = first ? z : *(const f32x4*)(UHL + (size_t)((gi - 1) * 2 + 0) * DFF + c), l1 = first ? z : *(const f32x4*)(UHL + (size_t)((gi - 1) * 2 + 1) * DFF + c);
        const f32x4 u0 = *(const f32x4*)(UHF + (size_t)((gi * 2 + 0) * 2) * DFF + c);
        const f32x4 uu = *(const f32x4*)(UHF + (size_t)((gi * 2 + j) * 2) * DFF + c), vv = *(const f32x4*)(UHF + (size_t)((gi * 2 + j) * 2 + 1) * DFF + c);
        const f32x4 p2 = j == 0 ? l0 : l1, p1 = j == 0 ? l1 : u0;
        const f32x4 w0 = *(const f32x4*)(cw + c), w1 = *(const f32x4*)(cw + DFF + c), w2 = *(const f32x4*)(cw + 2 * DFF + c), cb = *(const f32x4*)(cbp + c);
        float a[4];
#pragma unroll
        for (int e = 0; e < 4; ++e) a[e] = gelu_tanh(cb[e] + w0[e] * p2[e] + w1[e] * p1[e] + w2[e] * uu[e]) * vv[e];
        *(u32x2*)(ACT + (size_t)row * DFF + c) = (u32x2){cvt_pk_bf16(a[0], a[1]), cvt_pk_bf16(a[2], a[3])};
    }
}
__device__ __forceinline__ void phase7(const Params& p) {
    const float* gf = p.in[21]; float* Y = p.out; const float* X1 = (const float*)(p.ws + WS_X1); const float* PART = (const float*)(p.ws + WS_R1 + R1_X1B);
    const int wave = threadIdx.x >> 6, lane = threadIdx.x & 63;
    f32x4 g[4];
#pragma unroll
    for (int j = 0; j < 4; ++j) g[j] = *(const f32x4*)(gf + 4 * lane + 256 * j);
    auto load_row = [&](int row, f32x4 (&v)[4]) {
        if (row < MPROMPT) {
#pragma unroll
            for (int j = 0; j < 4; ++j) v[j] = *(const f32x4*)(Y + (size_t)row * DM + 4 * lane + 256 * j);
        } else {
#pragma unroll
            for (int j = 0; j < 4; ++j) v[j] = *(const f32x4*)(X1 + (size_t)row * DM + 4 * lane + 256 * j);
#pragma unroll
            for (int sl = 0; sl < 7; ++sl)
#pragma unroll
                for (int j = 0; j < 4; ++j) v[j] = v[j] + *(const f32x4*)(PART + (size_t)sl * (1024 * DM) + (size_t)(row - MPROMPT) * DM + 4 * lane + 256 * j);
        }
    };
    int row = blockIdx.x * 8 + wave; f32x4 v[4];
    if (row < MROWS) load_row(row, v);
    while (row < MROWS) {
        const int nrow = row + gridDim.x * 8; f32x4 nv[4];
#pragma unroll
        for (int j = 0; j < 4; ++j) nv[j] = (f32x4){0.f, 0.f, 0.f, 0.f};
        if (nrow < MROWS) load_row(nrow, nv);
        float s = 0.f;
#pragma unroll
        for (int j = 0; j < 4; ++j) s += (v[j].x * v[j].x + v[j].y * v[j].y) + (v[j].z * v[j].z + v[j].w * v[j].w);
        const float rs = rsqrtf(wave_sum(s) * (1.f / DM) + EPS);
#pragma unroll
        for (int j = 0; j < 4; ++j) *(f32x4*)(Y + (size_t)row * DM + 4 * lane + 256 * j) = v[j] * rs * g[j];
#pragma unroll
        for (int j = 0; j < 4; ++j) v[j] = nv[j];
        row = nrow;
    }
}
#define RUN(ph) (((PHMASK >> (ph)) & 1) && ph_lo <= (ph) && (ph) <= ph_hi)
#define SYNC(ph) do { if (ph_lo <= (ph) && (ph) < ph_hi) { xcd_barrier(xb); } } while (0)
#define TWICE(ph, body) do { body; if ((REPMASK >> (ph)) & 1) { xcd_barrier(xb); body; } } while (0)
__device__ __forceinline__ void run_p1(const Params& p, PG8_LAS unsigned char* lds) { bf16_t* H = (bf16_t*)p.out; bf16_t* PROJ = (bf16_t*)(p.ws + WS_R1);
    pg8::StaticOrder S; S.init(MROWS, NIN, gridDim.x, blockIdx.x); pg8::Gemm g{H, (const bf16_t*)(p.ws + WS_WIN), MROWS, NIN, DM};
    EpiInProj E{PROJ, p.in[9], (float*)(p.ws + WS_GATES), p.in[11], p.in[12]}; pg8::gemm_phase(lds, g, S, E); }
__device__ __forceinline__ void run_p3(const Params& p, PG8_LAS unsigned char* lds) { bf16_t* AMIX = (bf16_t*)p.out + (size_t)MROWS * DM; bf16_t* X1B = (bf16_t*)(p.ws + WS_R1 + R1_X1B); float* X1 = (float*)(p.ws + WS_X1);
    pg8::StaticOrder S; S.init(P3_OVERLAP ? MPROMPT : MROWS, DM, gridDim.x, blockIdx.x);   pg8::Gemm g{AMIX, (const bf16_t*)(p.ws + WS_WOUT), MROWS, DM, DM};
    EpiResid E{p.in[0], p.in[1], X1, X1B, (float*)(p.ws + WS_SSQ2), nullptr}; pg8::gemm_phase(lds, g, S, E); }
struct OneUnit { int pm, pn, ntK;
    __device__ bool next(int i, Unit& u) const { if (i) return false; u.pm = pm; u.pn = pn; u.k0 = 0; u.nt = ntK; return true; }
    __device__ __forceinline__ void a_ready(const Unit&) const {}
    __device__ __forceinline__ void done(const Unit&) const {} };
__device__ __forceinline__ void run_p3_sample(const Params& p, PG8_LAS unsigned char* lds, const int j) {
    bf16_t* AMIX = (bf16_t*)p.out + (size_t)MROWS * DM; bf16_t* X1B = (bf16_t*)p.out; float* X1 = (float*)(p.ws + WS_X1);
    OneUnit S{64 + (j >> 2), j & 3, DM / 64}; pg8::Gemm g{AMIX, (const bf16_t*)(p.ws + WS_WOUT), MROWS, DM, DM};
    EpiResid E{p.in[0], p.in[1], X1, X1B, (float*)(p.ws + WS_SSQ2), nullptr}; pg8::gemm_phase(lds, g, S, E); }
__device__ __forceinline__ void phase2b(const Params& p, PG8_LAS unsigned char* lds, unsigned char* shm) {
    const int b = blockIdx.x, G = gridDim.x;
    if (G >= 96) {
        if (b < 64) { const int g = b >> 5, sqi = (b >> 2) & 7, h = b & 3; if (g == 0) chain_run<false>(p, lds, sqi, h); else chain_run<true>(p, lds, sqi, h); }
        else { for (int j = NS_A + (b - 64); j < 1024; j += G - 64) sample_dispatch(p, lds, j);
            LDS_BARRIER();
            deferred_transposes(p, shm, (b - 64) * 8 + (threadIdx.x >> 6), (G - 64) * 8); }
    } else {
        for (int it = b; it < 64; it += G) { const int g = it >> 5, sqi = (it >> 2) & 7, h = it & 3; if (g == 0) chain_run<false>(p, lds, sqi, h); else chain_run<true>(p, lds, sqi, h); }
        for (int j = NS_A + b; j < 1024; j += G) sample_dispatch(p, lds, j);
        LDS_BARRIER();
        deferred_transposes(p, shm, b * 8 + (threadIdx.x >> 6), G * 8);
    }
}
__device__ __forceinline__ void run_p4(const Params& p, PG8_LAS unsigned char* lds) { bf16_t* X1B = (bf16_t*)(p.ws + WS_R1 + R1_X1B); bf16_t* ACT = (bf16_t*)(p.ws + WS_R1 + R1_ACT);
    pg8::StaticOrder S; S.init(MROWS, NGV, gridDim.x, blockIdx.x); pg8::Gemm g{X1B, (const bf16_t*)(p.ws + WS_WGV), MROWS, NGV, DM};
    EpiGateVal E{ACT, (const float*)(p.ws + WS_SSQ2), p.in[18], p.in[19], p.in[6], (float*)(p.ws + WS_UHL), (float*)(p.ws + WS_UHF), p.out + O_VP, p.out + O_VS}; pg8::gemm_phase(lds, g, S, E); }
struct DownOrder {
    pg8::StaticOrder S; int G, c;
    __device__ void init(int G_, int c_) { G = G_; c = c_; S.init(MPROMPT, DM, G_, c_, DFF); }
    __device__ bool next(int i, Unit& u) const {
        const int L = i * G + c;
        if (L < 256) { pg8::StaticOrder T = S; T.G = 256; T.c = L; return T.next(0, u); }
        const int r = L - 256; if (r >= 112) return false;
        const int s = r % 7, t = r / 7; u.pm = 64 + (t >> 2); u.pn = t & 3; u.k0 = 384 * s; u.nt = s == 6 ? 8 : 6; return true;
    }
    __device__ __forceinline__ void a_ready(const Unit&) const {}
    __device__ __forceinline__ void done(const Unit&) const {}
};
__device__ __forceinline__ void run_p6(const Params& p, PG8_LAS unsigned char* lds) { bf16_t* ACT = (bf16_t*)(p.ws + WS_R1 + R1_ACT); float* X1 = (float*)(p.ws + WS_X1);
    DownOrder S; S.init(gridDim.x, blockIdx.x); pg8::Gemm g{ACT, (const bf16_t*)(p.ws + WS_WD), MROWS, DM, DFF};
    EpiResid E{X1, X1 + (size_t)MPROMPT * DM, p.out, nullptr, nullptr, (float*)(p.ws + WS_R1 + R1_X1B)}; pg8::gemm_phase(lds, g, S, E); }
__global__ __launch_bounds__(512, 2) void fwd_kernel(Params p, int ph_lo, int ph_hi) {
    extern __shared__ __attribute__((aligned(16))) unsigned char shm[];
    PG8_LAS unsigned char* lds = (PG8_LAS unsigned char*)shm;
    cg::grid_group grid = cg::this_grid();
    volatile LAS unsigned* xst = (volatile LAS unsigned*)(lds + LDS_BYTES - 16);
    if (threadIdx.x == 0) { xst[0] = 0u; xst[1] = 0u; }
    __syncthreads();
    XcdBarrier xb = xcd_barrier_post((unsigned*)(p.ws + WS_BAR), xst);
    if (ph_lo < -1000) grid.sync();
    if (RUN(0)) TWICE(0, phase0(p, shm));
    SYNC(0);
    if (RUN(1)) TWICE(1, run_p1(p, lds));
    SYNC(1);
#if NAIVE_MIXER
    if (RUN(2)) phase2_naive(p, shm);
#else
    if (RUN(2)) { phase2a(p, lds); phase2a_samples(p, lds); xcd_barrier(xb); phase2b(p, lds, shm); }
#endif
    SYNC(2);
    if (RUN(3)) run_p3(p, lds);
    SYNC(3);
    if (RUN(4)) TWICE(4, run_p4(p, lds));
    SYNC(4);
    if (RUN(5)) TWICE(5, phase5(p));
    SYNC(5);
    if (RUN(6)) run_p6(p, lds);
    SYNC(6);
    if (RUN(7)) phase7(p);
#if EXTRA_SYNCS
    for (int i = 0; i < EXTRA_SYNCS; ++i) xcd_barrier(xb);
#endif
}
extern "C" void kernel_launch(void* const* d_in, const int* in_sizes, int n_in, void* d_out, int out_size, void* d_ws, size_t ws_size, hipStream_t stream) {
    static int grid = 0;
    if (grid == 0) {
        if (n_in != 22 || ws_size < WS_END) { fprintf(stderr, "kernel_launch: unexpected n_in %d / ws_size %zu (need %zu)\n", n_in, ws_size, (size_t)WS_END); grid = -1; return; }
        int dev = 0, cus = 0, per_cu = 0;
        hipGetDevice(&dev); hipDeviceGetAttribute(&cus, hipDeviceAttributeMultiprocessorCount, dev);
        if (hipFuncSetAttribute((const void*)fwd_kernel, hipFuncAttributeMaxDynamicSharedMemorySize, LDS_BYTES) != hipSuccess) { fprintf(stderr, "kernel_launch: hipFuncSetAttribute failed\n"); grid = -1; return; }
        if (hipOccupancyMaxActiveBlocksPerMultiprocessor(&per_cu, (const void*)fwd_kernel, 512, LDS_BYTES) != hipSuccess || per_cu < 1) { fprintf(stderr, "kernel_launch: occupancy query says %d blocks per CU\n", per_cu); per_cu = 1; }
        (void)hipGetLastError();
        grid = cus;
        fprintf(stderr, "kernel_launch: cus %d per_cu %d grid %d ws %zu\n", cus, per_cu, grid, ws_size);
    }
    if (grid < 0) return;
    Params p{};
    for (int i = 0; i < 22; ++i) p.in[i] = (const float*)d_in[i];
    p.out = (float*)d_out; p.ws = (unsigned char*)d_ws;
    if (hipMemsetAsync((char*)d_ws + WS_BAR, 0, 16384, stream) != hipSuccess) { fprintf(stderr, "kernel_launch: memset of the barrier words failed\n"); return; }
#if ONE_LAUNCH
    int lo = 0, hi = 7; void* args[] = {&p, &lo, &hi};
    hipError_t e = hipLaunchCooperativeKernel((const void*)fwd_kernel, dim3(grid), dim3(512), args, LDS_BYTES, stream);
    if (e != hipSuccess) fprintf(stderr, "cooperative launch failed: %s (grid %d)\n", hipGetErrorString(e), grid);
#else
    for (int ph = 0; ph < 8; ++ph) hipLaunchKernelGGL(fwd_kernel, dim3(grid), dim3(512), LDS_BYTES, stream, p, ph, ph);
#endif
}
```

```cpp
#include <hip/hip_runtime.h>
#include <hip/hip_cooperative_groups.h>
#include <cstdio>
#include <cstdint>
namespace cg = cooperative_groups;
#ifndef ONE_LAUNCH
#define ONE_LAUNCH 1
#endif
#ifndef PHMASK
#define PHMASK 255
#endif
#ifndef NAIVE_MIXER
#define NAIVE_MIXER 0
#endif
#ifndef REPMASK
#define REPMASK 0
#endif
#ifndef EXTRA_SYNCS
#define EXTRA_SYNCS 0
#endif
#ifndef P3_OVERLAP
#define P3_OVERLAP 1
#endif
namespace pg8 {
#define PG8_LAS __attribute__((address_space(3)))
typedef unsigned short bf16_t;
typedef short bf16x8 __attribute__((ext_vector_type(8)));
typedef float f32x4 __attribute__((ext_vector_type(4)));
typedef unsigned u32x4 __attribute__((ext_vector_type(4)));
constexpr int BM = 256, BK = 64, HALF = 128, HTB = HALF * BK * 2  , STAGE_BYTES = 8 * HTB, NXCD = 8, WGM = 8;

__host__ __device__ __forceinline__ int lds_byte(int r, int c) { const int st = (r >> 4) * 2 + (c >> 5), rr = r & 15, cc = c & 31, ob = rr * 64 + cc * 2; return st * 1024 + (ob ^ (((ob >> 9) & 1) << 5)); }
__host__ __device__ __forceinline__ void stage_rc(int b, int& R, int& C) { const int st = b / 1024, sb = b % 1024, swz = sb ^ (((sb >> 9) & 1) << 5); R = (st >> 1) * 16 + swz / 64; C = (st & 1) * 32 + (swz % 64) / 2; }
__host__ __device__ __forceinline__ int perm32(int rho) { const int n = rho >> 4, i = rho & 15; return 8 * (i >> 2) + 4 * n + (i & 3); }

struct Unit { int pm, pn, k0, nt; };
struct Gemm { const bf16_t* A; const bf16_t* Bt; int M, N, K; };

struct StaticOrder {
    int nM, nN, nwg, G, c, ntK;
    __host__ __device__ void init(int M, int N, int G_, int c_, int K_ = 1024) { nM = M / BM; nN = N / BM; nwg = nM * nN; G = G_; c = c_; ntK = K_ / BK; }
    __host__ __device__ bool next(int i, Unit& u) const {
        const long L = (long)i * G + c; if (L >= nwg) return false;
        int wgid = (int)L; { const int q = nwg / NXCD, r = nwg % NXCD, xcd = wgid % NXCD, off = wgid / NXCD; wgid = (xcd < r ? xcd * (q + 1) : r * (q + 1) + (xcd - r) * q) + off; }
        const int nig = WGM * nN, gid = wgid / nig, fm = gid * WGM, gsz = (nM - fm) < WGM ? (nM - fm) : WGM;
        u.pm = fm + ((wgid % nig) % gsz); u.pn = (wgid % nig) / gsz; u.k0 = 0; u.nt = ntK; return true;
    }
    __device__ __forceinline__ void a_ready(const Unit&) const {}
    __device__ __forceinline__ void done(const Unit&) const {}
};

typedef float f32x2_t __attribute__((ext_vector_type(2)));
typedef __bf16 bf16x2_t __attribute__((ext_vector_type(2)));
__device__ __forceinline__ unsigned cvt_pk_bf16(float lo, float hi) { const f32x2_t v = {lo, hi}; return __builtin_bit_cast(unsigned, __builtin_convertvector(v, bf16x2_t)); }
template <class Epi, class Sched>
__device__ __forceinline__ void gemm_phase(PG8_LAS unsigned char* lds, const Gemm g, const Sched& S, const Epi& E) {
    const int tid = threadIdx.x, wid = __builtin_amdgcn_readfirstlane(tid >> 6), lane = tid & 63, wr = wid >> 2, wc = wid & 3, fr = lane & 15, fq = lane >> 4;
    const int K = g.K;
    unsigned voffA[2], voffB[2];
#pragma unroll
    for (int i = 0; i < 2; ++i) { int R, C; stage_rc(tid * 16 + i * 8192, R, C); const int Rb = Epi::PERM ? ((R & ~31) + perm32(R & 31)) : R;
        voffA[i] = (unsigned)(R * K + C) * 2u; voffB[i] = (unsigned)(Rb * K + C) * 2u; }
    const size_t kstep = (size_t)(BK * 2);
    const size_t hstep = (size_t)HALF * K * 2;
    const size_t tstep = 2 * hstep;
    const unsigned ldsw = (unsigned)wid * 1024u;
    const int aoff = lds_byte(wr * 64 + fr, fq * 8), boff = lds_byte(wc * 32 + fr, fq * 8);
#define PG8_SA(b, h) (((b) * 2 + (h)) * HTB)
#define PG8_SB(b, h) ((4 + (b) * 2 + (h)) * HTB)
#define PG8_STAGE(bufoff, gbase, voff) do { _Pragma("unroll") for (int _i = 0; _i < 2; ++_i) \
        __builtin_amdgcn_global_load_lds((const unsigned*)((const char*)(gbase) + (voff)[_i]), (PG8_LAS unsigned*)(lds + (bufoff) + ldsw + _i * 8192), 16, 0, 0); } while (0)
#define PG8_LDA(dst, b, h) do { _Pragma("unroll") for (int m = 0; m < 4; ++m) _Pragma("unroll") for (int k = 0; k < 2; ++k) dst[m][k] = *(const PG8_LAS bf16x8*)(lds + PG8_SA(b, h) + aoff + m * 2048 + k * 1024); } while (0)
#define PG8_LDB(dst, b, h) do { _Pragma("unroll") for (int n = 0; n < 2; ++n) _Pragma("unroll") for (int k = 0; k < 2; ++k) dst[n][k] = *(const PG8_LAS bf16x8*)(lds + PG8_SB(b, h) + boff + n * 2048 + k * 1024); } while (0)
#define PG8_MMA(ai, bj, At, Bt) do { __builtin_amdgcn_s_setprio(1); _Pragma("unroll") for (int m = 0; m < 4; ++m) _Pragma("unroll") for (int n = 0; n < 2; ++n) _Pragma("unroll") for (int k = 0; k < 2; ++k) \
        acc[ai][bj][m][n] = __builtin_amdgcn_mfma_f32_16x16x32_bf16(Bt[n][k], At[m][k], acc[ai][bj][m][n], 0, 0, 0); __builtin_amdgcn_s_setprio(0); } while (0)
#define PG8_WAIT_V(n) asm volatile("s_waitcnt vmcnt(" #n ")" ::: "memory")
#define PG8_WAIT_L(n) asm volatile("s_waitcnt lgkmcnt(" #n ")" ::: "memory")
#define PG8_BAR __builtin_amdgcn_s_barrier()
#define PG8_SCHED __builtin_amdgcn_sched_barrier(0)
    Unit cur, nxt; int ui = 0;
    if (!S.next(0, cur)) return;
    f32x4 acc[2][2][4][2];
#pragma unroll
    for (int a = 0; a < 2; ++a)
#pragma unroll
        for (int b = 0; b < 2; ++b)
#pragma unroll
            for (int m = 0; m < 4; ++m)
#pragma unroll
                for (int n = 0; n < 2; ++n) acc[a][b][m][n] = (f32x4){0.f, 0.f, 0.f, 0.f};
    bf16x8 At[4][2], B0[2][2], B1[2][2];
    const char* cA = (const char*)g.A + (size_t)cur.pm * tstep + (size_t)cur.k0 * 2; const char* cB = (const char*)g.Bt + (size_t)cur.pn * tstep + (size_t)cur.k0 * 2;
    S.a_ready(cur);
    PG8_STAGE(PG8_SB(0, 0), cB, voffB); PG8_STAGE(PG8_SA(0, 0), cA, voffA); PG8_STAGE(PG8_SB(0, 1), cB + hstep, voffB); PG8_STAGE(PG8_SA(0, 1), cA + hstep, voffA);
    if (wr == 1) PG8_BAR;
    PG8_WAIT_V(4); PG8_BAR;
    PG8_STAGE(PG8_SB(1, 0), cB + kstep, voffB); PG8_STAGE(PG8_SA(1, 0), cA + kstep, voffA); PG8_STAGE(PG8_SB(1, 1), cB + hstep + kstep, voffB);
    PG8_WAIT_V(6); PG8_BAR;
    for (;;) {
        const bool has_next = S.next(ui + 1, nxt);
        const char* nA = has_next ? (const char*)g.A + (size_t)nxt.pm * tstep + (size_t)nxt.k0 * 2 : cA; const char* nB = has_next ? (const char*)g.Bt + (size_t)nxt.pn * tstep + (size_t)nxt.k0 * 2 : cB;
        const int nt = cur.nt;
        for (int t = 0; t < nt; t += 2) {
            const bool last = (t == nt - 2);
            const char* a1 = cA + (size_t)(t + 1) * kstep;
            const char* a2 = last ? nA : cA + (size_t)(t + 2) * kstep; const char* b2 = last ? nB : cB + (size_t)(t + 2) * kstep;
            const char* a3 = a2 + kstep; const char* b3 = b2 + kstep;
            if (last && has_next) S.a_ready(nxt);
            PG8_LDB(B0, 0, 0); PG8_SCHED; PG8_LDA(At, 0, 0); PG8_STAGE(PG8_SA(1, 1), a1 + hstep, voffA);
            PG8_WAIT_L(8); PG8_BAR; PG8_WAIT_L(0); PG8_MMA(0, 0, At, B0); PG8_BAR; PG8_SCHED;
            PG8_LDB(B1, 0, 1); PG8_STAGE(PG8_SB(0, 0), b2, voffB);
            PG8_BAR; PG8_WAIT_L(0); PG8_MMA(0, 1, At, B1); PG8_BAR;
            PG8_LDA(At, 0, 1); PG8_STAGE(PG8_SA(0, 0), a2, voffA);
            PG8_BAR; PG8_WAIT_L(0); PG8_MMA(1, 0, At, B0); PG8_BAR; PG8_SCHED;
            PG8_STAGE(PG8_SB(0, 1), b2 + hstep, voffB);
            PG8_WAIT_V(6); PG8_BAR; PG8_MMA(1, 1, At, B1); PG8_BAR;
            PG8_LDB(B0, 1, 0); PG8_SCHED; PG8_LDA(At, 1, 0); PG8_STAGE(PG8_SA(0, 1), a2 + hstep, voffA);
            PG8_WAIT_L(8); PG8_BAR; PG8_WAIT_L(0); PG8_MMA(0, 0, At, B0); PG8_BAR; PG8_SCHED;
            PG8_LDB(B1, 1, 1); PG8_STAGE(PG8_SB(1, 0), b3, voffB);
            PG8_BAR; PG8_WAIT_L(0); PG8_MMA(0, 1, At, B1); PG8_BAR;
            PG8_LDA(At, 1, 1); PG8_STAGE(PG8_SA(1, 0), a3, voffA);
            PG8_BAR; PG8_WAIT_L(0); PG8_MMA(1, 0, At, B0); PG8_BAR; PG8_SCHED;
            PG8_STAGE(PG8_SB(1, 1), b3 + hstep, voffB);
            PG8_WAIT_V(6); PG8_BAR; PG8_MMA(1, 1, At, B1); PG8_BAR;
        }
        if constexpr (!Epi::AFTER_DRAIN) { E(acc, cur, wr, wc, fr, fq); S.done(cur); }
        if (!has_next) break;
#pragma unroll
        for (int a = 0; a < 2; ++a)
#pragma unroll
            for (int b = 0; b < 2; ++b)
#pragma unroll
                for (int m = 0; m < 4; ++m)
#pragma unroll
                    for (int n = 0; n < 2; ++n) acc[a][b][m][n] = (f32x4){0.f, 0.f, 0.f, 0.f};
        cur = nxt; cA = nA; cB = nB; ++ui;
    }
    PG8_WAIT_V(0);
    if (wr == 0) PG8_BAR;
    PG8_BAR;
    if constexpr (Epi::AFTER_DRAIN) { E.fused(acc, cur, wr, wc, fr, fq, lds, wid, lane); S.done(cur); }
#undef PG8_SA
#undef PG8_SB
#undef PG8_STAGE
#undef PG8_LDA
#undef PG8_LDB
#undef PG8_MMA
#undef PG8_WAIT_V
#undef PG8_WAIT_L
#undef PG8_BAR
#undef PG8_SCHED
}

}
#define XB_TMO      128
#define XB_XCNT(j)  (256  + 64 * (j))
#define XB_XSUB(j)  (1280 + 64 * (j))
#define XB_XGEN(j)  (2304 + 64 * (j))
#define XB_TOP      3328
#define XB_TOPGEN   3392
#define XCD_BAR_WORDS 3456
#define XB_SPIN_CAP (1u << 18)
#ifndef LAS
#define LAS __attribute__((address_space(3)))
#endif

__device__ __forceinline__ unsigned xb_ld(unsigned* p)              { return __hip_atomic_load(p, __ATOMIC_RELAXED, __HIP_MEMORY_SCOPE_AGENT); }
__device__ __forceinline__ unsigned xb_add(unsigned* p, unsigned v) { return __hip_atomic_fetch_add(p, v, __ATOMIC_RELAXED, __HIP_MEMORY_SCOPE_AGENT); }
__device__ __forceinline__ unsigned xb_xcc_id() { return (unsigned)__builtin_amdgcn_s_getreg((3 << 11) | 20) & 0xFu; }
#define XB_SPIN(cond, bar) do { unsigned _sp = 0; while (cond) { __builtin_amdgcn_s_sleep(1); \
    if ((++_sp & 255u) == 0u) { if (xb_ld(&(bar)[XB_TMO])) break; if (_sp > XB_SPIN_CAP) { atomicAdd(&(bar)[XB_TMO], 1u); break; } } } } while (0)

struct XcdBarrier {
    unsigned* bar; unsigned x;
    volatile LAS unsigned* st;
};

__device__ __forceinline__ XcdBarrier xcd_barrier_post(unsigned* bar, volatile LAS unsigned* st) {
    XcdBarrier b; b.bar = bar; b.x = xb_xcc_id(); b.st = st;
    if (threadIdx.x == 0) (void)xb_add(&bar[XB_XCNT(b.x)], 1u);
    return b;
}
__device__ __forceinline__ void xcd_barrier_complete(unsigned* bar, unsigned x, unsigned& nloc, unsigned& nx) {
    const unsigned G = gridDim.x * gridDim.y * gridDim.z;
    unsigned sum, cnt, mine, sp = 0u;
    for (;;) {
        sum = 0u; cnt = 0u; mine = 0u;
#pragma unroll
        for (unsigned j = 0; j < 16; ++j) { const unsigned c = xb_ld(&bar[XB_XCNT(j)]); sum += c; cnt += (c > 0u) ? 1u : 0u; mine = (j == x) ? c : mine; }
        if (sum == G) break;
        __builtin_amdgcn_s_sleep(1);
        if ((++sp & 255u) == 0u) { if (xb_ld(&bar[XB_TMO])) break; if (sp > XB_SPIN_CAP) { atomicAdd(&bar[XB_TMO], 1u); break; } }
    }
    nloc = mine > 0u ? mine : 1u; nx = cnt > 0u ? cnt : 1u;
}

__device__ __forceinline__ void xcd_barrier(const XcdBarrier& b) {
    asm volatile("s_waitcnt vmcnt(0)" ::: "memory");
    __syncthreads();
    if (threadIdx.x == 0) {
        unsigned* bar = b.bar;
        __builtin_amdgcn_s_waitcnt(0);
        unsigned nloc = b.st[0], nx = b.st[1];
        if (nloc == 0u) { xcd_barrier_complete(bar, b.x, nloc, nx); b.st[0] = nloc; b.st[1] = nx; }
        const unsigned old = xb_add(&bar[XB_XSUB(b.x)], 1u);
        const unsigned gen = old / nloc;
        if (old + 1u == (gen + 1u) * nloc) {
            __builtin_amdgcn_fence(__ATOMIC_RELEASE, "agent");
            asm volatile("s_waitcnt vmcnt(0)" ::: "memory");
            const unsigned og = xb_add(&bar[XB_TOP], 1u);
            const unsigned tg = og / nx;
            if (og + 1u == (tg + 1u) * nx) xb_add(&bar[XB_TOPGEN], 1u);
            else XB_SPIN(xb_ld(&bar[XB_TOPGEN]) == tg, bar);
            __builtin_amdgcn_fence(__ATOMIC_ACQUIRE, "agent");
            xb_add(&bar[XB_XGEN(b.x)], 1u);
            asm volatile("s_waitcnt vmcnt(0)" ::: "memory");
        } else {
            XB_SPIN(xb_ld(&bar[XB_XGEN(b.x)]) == gen, bar);
            __builtin_amdgcn_fence(__ATOMIC_ACQUIRE, "agent");
            asm volatile("s_waitcnt vmcnt(0)" ::: "memory");
        }
    }
    __syncthreads();
}

using pg8::bf16_t; using pg8::f32x4; using pg8::u32x4; using pg8::Unit; using pg8::cvt_pk_bf16;
typedef unsigned u32x2 __attribute__((ext_vector_type(2)));
constexpr int DM = 1024, MROWS = 17408, MPROMPT = 16384, NPROJ = 4096, INCOLS = 4104, DFF = 2816, NGV = 5632;
constexpr float EPS = 1e-6f;
constexpr size_t O_Y = 0, O_SP = 17825792, O_SS = 18350080, O_CP = 26738688, O_CS = 27262976, O_NP = 35651584, O_NS = 35655680,
                 O_MP = 35721216, O_MS = 35721248, O_VP = 35721760, O_VS = 35766816;
constexpr int NIN = 4352;
constexpr size_t WS_CTL = 0, WS_WIN = 4096, WS_WOUT = WS_WIN + (size_t)NIN * 1024 * 2, WS_WGV = WS_WOUT + 1024 * 1024 * 2, WS_WD = WS_WGV + 5632 * 1024 * 2,
                 WS_GATES = WS_WD + 1024 * 2816 * 2, WS_SSQ2 = WS_GATES + 17408 * 32, WS_SSQ3 = WS_SSQ2 + 17408 * 4, WS_UHL = WS_SSQ3 + 17408 * 4, WS_UHF = WS_UHL + 256 * 2 * 2816 * 4,
                 WS_X1 = WS_UHF + 256 * 4 * 2816 * 4, WS_R1 = WS_X1 + (size_t)17408 * 1024 * 4, WS_BAR = WS_R1 + (size_t)17408 * 4096 * 2, WS_END = WS_BAR + 16384;
static_assert(WS_END <= 268435456, "workspace budget");
constexpr size_t R1_ACT = 0, R1_X1B = (size_t)16384 * 6144;
static_assert((size_t)17408 * 2816 * 2 <= R1_X1B && R1_X1B + (size_t)17408 * 1024 * 2 <= (size_t)17408 * 4096 * 2, "R1 layout");
constexpr int LDS_BYTES = 160 * 1024 - 2048;

struct Params { const float* in[22]; float* out; unsigned char* ws; };

__device__ __forceinline__ float bf2f(unsigned short b) { return __uint_as_float(((unsigned)b) << 16); }
__device__ __forceinline__ unsigned short f2bf(float f) { unsigned u = __float_as_uint(f); u += 0x7fffu + ((u >> 16) & 1u); return (unsigned short)(u >> 16); }
__device__ __forceinline__ float wave_sum(float v) {
#pragma unroll
    for (int o = 1; o < 64; o <<= 1) v += __shfl_xor(v, o);
    return v;
}
__device__ __forceinline__ float sigmoidf_(float x) { return __builtin_amdgcn_rcpf(1.0f + __expf(-x)); }

__device__ __forceinline__ void p0_transpose_item(const float* W, int ldw, int K, bf16_t* WT, int drow0, int k0, int n0, int nmax, const float* kscale, float* scr, int lane) {
    const int ncol = min(n0 + (lane & 31), nmax);
    float v[32];
#pragma unroll
    for (int i = 0; i < 32; ++i) v[i] = W[(size_t)(k0 + 2 * i + (lane >> 5)) * ldw + ncol];
    if (kscale) {
#pragma unroll
        for (int i = 0; i < 32; ++i) v[i] *= kscale[k0 + 2 * i + (lane >> 5)]; }
#pragma unroll
    for (int i = 0; i < 32; ++i) scr[(2 * i + (lane >> 5)) * 33 + (lane & 31)] = v[i];
    asm volatile("s_waitcnt lgkmcnt(0)" ::: "memory");
    const int c = lane & 7;
#pragma unroll
    for (int j = 0; j < 4; ++j) { const int n = (lane >> 3) + 8 * j; const float* s = scr + (8 * c) * 33 + n;
        u32x4 o; o.x = cvt_pk_bf16(s[0 * 33], s[1 * 33]); o.y = cvt_pk_bf16(s[2 * 33], s[3 * 33]); o.z = cvt_pk_bf16(s[4 * 33], s[5 * 33]); o.w = cvt_pk_bf16(s[6 * 33], s[7 * 33]);
        *(u32x4*)(WT + (size_t)(drow0 + n) * K + k0 + 8 * c) = o; }
    asm volatile("s_waitcnt lgkmcnt(0)" ::: "memory");
}

__device__ __forceinline__ void phase0(const Params& p, unsigned char* shm) {
    const int tid = threadIdx.x, wave = tid >> 6, lane = tid & 63;
    float* scr = (float*)(shm + wave * 8704);
    const int gw = blockIdx.x * 8 + wave, NGW = gridDim.x * 8;
    bf16_t* WinT = (bf16_t*)(p.ws + WS_WIN); bf16_t* WoutT = (bf16_t*)(p.ws + WS_WOUT);
    { float* z = (float*)(p.ws + WS_SSQ2); for (int i = blockIdx.x * 512 + tid; i < 2 * MROWS; i += gridDim.x * 512) z[i] = 0.f; }
    if (blockIdx.x == 0 && tid < 64) ((unsigned*)(p.ws + WS_CTL))[tid] = 0u;
    bf16_t* H = (bf16_t*)p.out;
    {   f32x4 g1[4];
#pragma unroll
        for (int j = 0; j < 4; ++j) g1[j] = *(const f32x4*)(p.in[7] + 4 * lane + 256 * j);
        int row = gw; f32x4 v[4];
        if (row < MROWS) { const float* xr = row < MPROMPT ? p.in[0] + (size_t)row * DM : p.in[1] + (size_t)(row - MPROMPT) * DM;
#pragma unroll
            for (int j = 0; j < 4; ++j) v[j] = *(const f32x4*)(xr + 4 * lane + 256 * j); }
        while (row < MROWS) {
            const int nrow = row + NGW; f32x4 nv[4];
#pragma unroll
            for (int j = 0; j < 4; ++j) nv[j] = (f32x4){0.f, 0.f, 0.f, 0.f};
            if (nrow < MROWS) { const float* xr = nrow < MPROMPT ? p.in[0] + (size_t)nrow * DM : p.in[1] + (size_t)(nrow - MPROMPT) * DM;
#pragma unroll
                for (int j = 0; j < 4; ++j) nv[j] = *(const f32x4*)(xr + 4 * lane + 256 * j); }
            float s = 0.f;
#pragma unroll
            for (int j = 0; j < 4; ++j) s += (v[j].x * v[j].x + v[j].y * v[j].y) + (v[j].z * v[j].z + v[j].w * v[j].w);
            const float rs = rsqrtf(wave_sum(s) * (1.f / DM) + EPS);
#pragma unroll
            for (int j = 0; j < 4; ++j) { const f32x4 o = v[j] * rs * g1[j];
                *(u32x2*)(H + (size_t)row * DM + 4 * lane + 256 * j) = (u32x2){cvt_pk_bf16(o.x, o.y), cvt_pk_bf16(o.z, o.w)}; }
#pragma unroll
            for (int j = 0; j < 4; ++j) v[j] = nv[j];
            row = nrow;
        }
    }
    constexpr int I_IN = 16 * 129, I_OUT = 16 * 32, NIT = I_IN + I_OUT;
    for (int it = gw; it < NIT; it += NGW) {
        int r = it;
        if (r < I_IN) { const int kb = r / 129, nb = r % 129; p0_transpose_item(p.in[8], INCOLS, DM, WinT, 32 * nb, 64 * kb, 32 * nb, INCOLS - 1, nullptr, scr, lane); continue; } r -= I_IN;
        { const int kb = r / 32, nb = r % 32; p0_transpose_item(p.in[14], DM, DM, WoutT, 32 * nb, 64 * kb, 32 * nb, DM - 1, nullptr, scr, lane); }
    }
}
__device__ __forceinline__ void deferred_transposes(const Params& p, unsigned char* shm, const int widx, const int nw) {
    const int wave = threadIdx.x >> 6, lane = threadIdx.x & 63;
    float* scr = (float*)(shm + wave * 8704);
    bf16_t* WgvT = (bf16_t*)(p.ws + WS_WGV); bf16_t* WdT = (bf16_t*)(p.ws + WS_WD);
    constexpr int I_G = 16 * 88, I_D = 44 * 32, NIT = 2 * I_G + I_D;
    for (int it = widx; it < NIT; it += nw) {
        int r = it;
        if (r < I_G) { const int kb = r / 88, nb = r % 88, n0 = 32 * nb; p0_transpose_item(p.in[16], DFF, DM, WgvT, 256 * (n0 >> 7) + (n0 & 127), 64 * kb, n0, DFF - 1, p.in[15], scr, lane); continue; } r -= I_G;
        if (r < I_G) { const int kb = r / 88, nb = r % 88, n0 = 32 * nb; p0_transpose_item(p.in[17], DFF, DM, WgvT, 256 * (n0 >> 7) + 128 + (n0 & 127), 64 * kb, n0, DFF - 1, p.in[15], scr, lane); continue; } r -= I_G;
        { const int kb = r / 32, nb = r % 32; p0_transpose_item(p.in[20], DM, DFF, WdT, 32 * nb, 64 * kb, 32 * nb, DM - 1, nullptr, scr, lane); }
    }
}
struct EpiInProj {
    static constexpr bool PERM = true, AFTER_DRAIN = false;
    bf16_t* O; const float* lbl; float* gates; const float* b_ig; const float* b_fg;
    __device__ __forceinline__ void operator()(const f32x4 (&acc)[2][2][4][2], const Unit& u, int wr, int wc, int fr, int fq) const {
        const int seg = u.pn >> 1, row0 = u.pm * 256 + wr * 64 + fr, col0 = u.pn * 256 + wc * 32 + 8 * fq;
        if (seg == 8) {
            if (wc == 0 && fq == 0) {
                float bi[4], bf_[4];
#pragma unroll
                for (int e = 0; e < 4; ++e) { bi[e] = b_ig[e]; bf_[e] = b_fg[e]; }
#pragma unroll
                for (int ai = 0; ai < 2; ++ai)
#pragma unroll
                    for (int m = 0; m < 4; ++m) { float* gp = gates + (size_t)(row0 + ai * 128 + m * 16) * 8; f32x4 a = acc[ai][0][m][0], b = acc[ai][0][m][1];
#pragma unroll
                        for (int e = 0; e < 4; ++e) { a[e] += bi[e]; const float z = b[e] + bf_[e]; b[e] = z > 0.f ? -log1pf(__expf(-z)) : z - log1pf(__expf(z)); }
                        *(f32x4*)gp = a; *(f32x4*)(gp + 4) = b; }
            }
            return;
        }
        float lb[2][8];
        if (seg == 1) {
#pragma unroll
            for (int bj = 0; bj < 2; ++bj)
#pragma unroll
                for (int e = 0; e < 8; ++e) { const int c = col0 + bj * 128 + e - 512; lb[bj][e] = __builtin_amdgcn_rcpf(1.0f + __expf(lbl[512 + c] - lbl[c])); }
        }
#pragma unroll
        for (int ai = 0; ai < 2; ++ai)
#pragma unroll
            for (int m = 0; m < 4; ++m) { bf16_t* rowp = O + (size_t)(row0 + ai * 128 + m * 16) * NPROJ + col0;
#pragma unroll
                for (int bj = 0; bj < 2; ++bj) { float v[8];
#pragma unroll
                    for (int e = 0; e < 8; ++e) v[e] = acc[ai][bj][m][e >> 2][e & 3];
                    if (seg == 1) {
#pragma unroll
                        for (int e = 0; e < 8; ++e) v[e] = __logf(lb[bj][e] + (1.0f - lb[bj][e]) * sigmoidf_(v[e]));
                    } else if (seg == 3) {
#pragma unroll
                        for (int e = 0; e < 8; ++e) v[e] = v[e] * sigmoidf_(v[e]);
                    } else if (seg == 5) {
#pragma unroll
                        for (int e = 0; e < 8; ++e) v[e] = v[e] * 0.08838834764831845f;
                    } else if (seg == 7) {
#pragma unroll
                        for (int e = 0; e < 8; ++e) v[e] = sigmoidf_(v[e]);
                    }
                    u32x4 w; w.x = cvt_pk_bf16(v[0], v[1]); w.y = cvt_pk_bf16(v[2], v[3]); w.z = cvt_pk_bf16(v[4], v[5]); w.w = cvt_pk_bf16(v[6], v[7]);
                    *(u32x4*)(rowp + bj * 128) = w; } }
    }
};
struct EpiResid {
    static constexpr bool PERM = true, AFTER_DRAIN = false;
    const float* base_p; const float* base_s;
    float* out; bf16_t* outb; float* ssq; float* part;
    __device__ __forceinline__ void operator()(const f32x4 (&acc)[2][2][4][2], const Unit& u, int wr, int wc, int fr, int fq) const {
        const int row0 = u.pm * 256 + wr * 64 + fr, col0 = u.pn * 256 + wc * 32 + 8 * fq;
        if (part && u.pm >= 64) { float* pp = part + (size_t)(u.k0 / 384) * (1024 * DM) - (size_t)MPROMPT * DM;
#pragma unroll
            for (int ai = 0; ai < 2; ++ai)
#pragma unroll
                for (int m = 0; m < 4; ++m) { const size_t off = (size_t)(row0 + ai * 128 + m * 16) * DM + col0;
#pragma unroll
                    for (int bj = 0; bj < 2; ++bj) { *(f32x4*)(pp + off + bj * 128) = acc[ai][bj][m][0]; *(f32x4*)(pp + off + bj * 128 + 4) = acc[ai][bj][m][1]; } }
            return; }
        const float* base = u.pm < 64 ? base_p : base_s - (size_t)MPROMPT * DM;
#pragma unroll
        for (int ai = 0; ai < 2; ++ai)
#pragma unroll
            for (int m = 0; m < 4; ++m) { const int row = row0 + ai * 128 + m * 16; const size_t off = (size_t)row * DM + col0; float ss = 0.f;
#pragma unroll
                for (int bj = 0; bj < 2; ++bj) { const f32x4 xa = *(const f32x4*)(base + off + bj * 128), xb = *(const f32x4*)(base + off + bj * 128 + 4);
                    const f32x4 v0 = acc[ai][bj][m][0] + xa, v1 = acc[ai][bj][m][1] + xb;
                    *(f32x4*)(out + off + bj * 128) = v0; *(f32x4*)(out + off + bj * 128 + 4) = v1;
                    if (outb) { u32x4 w; w.x = cvt_pk_bf16(v0[0], v0[1]); w.y = cvt_pk_bf16(v0[2], v0[3]); w.z = cvt_pk_bf16(v1[0], v1[1]); w.w = cvt_pk_bf16(v1[2], v1[3]); *(u32x4*)(outb + off + bj * 128) = w; }
                    ss += (v0[0] * v0[0] + v0[1] * v0[1]) + (v0[2] * v0[2] + v0[3] * v0[3]) + (v1[0] * v1[0] + v1[1] * v1[1]) + (v1[2] * v1[2] + v1[3] * v1[3]); }
                if (ssq) { ss += __shfl_xor(ss, 16); ss += __shfl_xor(ss, 32); if (fq == 0) atomicAdd(ssq + row, ss); } }
    }
};
__device__ __forceinline__ float gelu_tanh(float x) { const float z = 0.7978845608028654f * (x + 0.044715f * x * x * x); return x * __builtin_amdgcn_rcpf(1.0f + __expf(-2.0f * z)); }
template <int CTRL> __device__ __forceinline__ float dpp_f(float old, float src) {
    return __builtin_bit_cast(float, __builtin_amdgcn_update_dpp(__builtin_bit_cast(int, old), __builtin_bit_cast(int, src), CTRL, 0xf, 0xf, false)); }
struct EpiGateVal {
    static constexpr bool PERM = true, AFTER_DRAIN = false;
    bf16_t* ACT; const float* ssq2; const float* conv_w; const float* conv_b; const float* state_conv; float* UHL; float* UHF; float* out_vp; float* out_vs;
    __device__ __forceinline__ void operator()(const f32x4 (&acc)[2][2][4][2], const Unit& u, int wr, int wc, int fr, int fq) const {
        const int lane = threadIdx.x & 63;
        const int c0 = u.pn * 128 + wc * 32 + 8 * fq;
        float w0[8], w1[8], w2[8], cb[8];
#pragma unroll
        for (int e = 0; e < 8; ++e) { w0[e] = conv_w[c0 + e]; w1[e] = conv_w[DFF + c0 + e]; w2[e] = conv_w[2 * DFF + c0 + e]; cb[e] = conv_b[c0 + e]; }
        const bool sample = u.pm >= 64;
#pragma unroll
        for (int ai = 0; ai < 2; ++ai) {
            float uprev[8];
#pragma unroll
            for (int e = 0; e < 8; ++e) uprev[e] = 0.f;
#pragma unroll
            for (int m = 0; m < 4; ++m) { const int row = u.pm * 256 + ai * 128 + wr * 64 + m * 16 + fr;
                const float rs = rsqrtf(ssq2[row] * (1.f / DM) + EPS);
                float uu[8], vv[8], r1[8], r2[8];
#pragma unroll
                for (int e = 0; e < 8; ++e) { uu[e] = acc[ai][0][m][e >> 2][e & 3] * rs; vv[e] = acc[ai][1][m][e >> 2][e & 3] * rs; }
#pragma unroll
                for (int e = 0; e < 8; ++e) { r1[e] = dpp_f<0x111>(dpp_f<0x10F>(0.f, uprev[e]), uu[e]); r2[e] = dpp_f<0x112>(dpp_f<0x10E>(0.f, uprev[e]), uu[e]); }
                float p1[8], p2[8]; bool valid = true;
                if (!sample) {
#pragma unroll
                    for (int e = 0; e < 8; ++e) { p1[e] = r1[e]; p2[e] = r2[e]; }
                    if (m == 0 && fr < 2) { valid = false; const int gi = row >> 6; float* d = UHF + ((size_t)(gi * 2 + fr) * 2) * DFF + c0;
                        *(f32x4*)d = (f32x4){uu[0], uu[1], uu[2], uu[3]}; *(f32x4*)(d + 4) = (f32x4){uu[4], uu[5], uu[6], uu[7]};
                        *(f32x4*)(d + DFF) = (f32x4){vv[0], vv[1], vv[2], vv[3]}; *(f32x4*)(d + DFF + 4) = (f32x4){vv[4], vv[5], vv[6], vv[7]}; }
                    if (m == 3 && fr >= 14) { const int gi = row >> 6; float* d = UHL + (size_t)(gi * 2 + (fr - 14)) * DFF + c0;
                        *(f32x4*)d = (f32x4){uu[0], uu[1], uu[2], uu[3]}; *(f32x4*)(d + 4) = (f32x4){uu[4], uu[5], uu[6], uu[7]};
                        if ((row & 2047) >= 2046) { float* o = out_vp + (size_t)((row >> 11) * 2 + (fr - 14)) * DFF + c0;
                            *(f32x4*)o = (f32x4){uu[0], uu[1], uu[2], uu[3]}; *(f32x4*)(o + 4) = (f32x4){uu[4], uu[5], uu[6], uu[7]}; } }
                } else {
                    const int pos = fr & 7, b = (row - MPROMPT) >> 3; const float* sc = state_conv + (size_t)b * 2 * DFF + c0;
                    float b0[8], b1[8];
#pragma unroll
                    for (int e = 0; e < 8; ++e) { b0[e] = 0.f; b1[e] = 0.f; }
                    if (pos < 2) {
#pragma unroll
                        for (int e = 0; e < 8; ++e) { b0[e] = sc[e]; b1[e] = sc[DFF + e]; } }
#pragma unroll
                    for (int e = 0; e < 8; ++e) { p1[e] = pos >= 1 ? r1[e] : b1[e]; p2[e] = pos >= 2 ? r2[e] : (pos == 1 ? b1[e] : b0[e]); }
                    if (pos >= 6) { float* o = out_vs + (size_t)(b * 2 + (pos - 6)) * DFF + c0;
                        *(f32x4*)o = (f32x4){uu[0], uu[1], uu[2], uu[3]}; *(f32x4*)(o + 4) = (f32x4){uu[4], uu[5], uu[6], uu[7]}; }
                }
                if (valid) { float a[8];
#pragma unroll
                    for (int e = 0; e < 8; ++e) a[e] = gelu_tanh(cb[e] + w0[e] * p2[e] + w1[e] * p1[e] + w2[e] * uu[e]) * vv[e];
                    u32x4 w; w.x = cvt_pk_bf16(a[0], a[1]); w.y = cvt_pk_bf16(a[2], a[3]); w.z = cvt_pk_bf16(a[4], a[5]); w.w = cvt_pk_bf16(a[6], a[7]);
                    *(u32x4*)(ACT + (size_t)row * DFF + c0) = w; }
#pragma unroll
                for (int e = 0; e < 8; ++e) uprev[e] = uu[e];
            }
        }
    }
};
#ifndef LAS
#define LAS __attribute__((address_space(3)))
#endif
#define LDS_BARRIER() do { asm volatile("s_waitcnt lgkmcnt(0)" ::: "memory"); __builtin_amdgcn_s_barrier(); asm volatile("" ::: "memory"); } while (0)
typedef short bf16x8 __attribute__((ext_vector_type(8)));
constexpr int QT_OFF = 0, KT_OFF = 17408, KHT_OFF = 34816, VT_OFF = 53248, SW_OFF = 73984, ST_OFF = 83200, RAWV_OFF = 122368, SM_OFF = 138752;
constexpr int F_DLAST = 0, F_PTOT = 128, F_SG = 640, F_SM = 704, F_SWI = 768, F_SMT = 832, F_SWEND = 896, F_SDEN = 960, F_SSSQ = 1024, F_SCAL = 1152;
__device__ __forceinline__ bf16x8 ldfrag(const LAS unsigned char* base, int stride_b, int row, int kcol) { return *(const LAS bf16x8*)(base + row * stride_b + kcol * 2); }
__device__ __forceinline__ f32x4 mfma16(bf16x8 a, bf16x8 b, f32x4 c) { return __builtin_amdgcn_mfma_f32_16x16x32_bf16(a, b, c, 0, 0, 0); }
__device__ __forceinline__ u32x2 pack4(f32x4 v) { return (u32x2){cvt_pk_bf16(v[0], v[1]), cvt_pk_bf16(v[2], v[3])}; }

template <bool IS_ML>
__device__ __forceinline__ void mixer_item(const Params& p, LAS unsigned char* L, const int sqi, const int h, const bool prompt) {
    const int tid = threadIdx.x, w = __builtin_amdgcn_readfirstlane(tid >> 6), lane = tid & 63, l15 = lane & 15, q4 = lane >> 4;
    const int Lc = prompt ? 64 : 8, nch = prompt ? 32 : 1;
    const int row0 = prompt ? sqi * 2048 : MPROMPT + sqi * 8;
    const bf16_t* PROJ = (const bf16_t*)(p.ws + WS_R1) + (IS_ML ? 2048 : 0) + h * 128;
    bf16_t* AMIX = (bf16_t*)p.out + (size_t)MROWS * DM + (IS_ML ? 512 : 0) + h * 128;
    const float* GATES = (const float*)(p.ws + WS_GATES);
    LAS unsigned char* Qt = L + QT_OFF; LAS unsigned char* Kt = L + KT_OFF; LAS unsigned char* KhT = L + KHT_OFF; LAS unsigned char* VT = L + VT_OFF;
    LAS unsigned char* Sw = L + SW_OFF; LAS unsigned char* ST = L + ST_OFF; LAS unsigned char* rawV = L + RAWV_OFF; LAS float* sm = (LAS float*)(L + SM_OFF);
    constexpr int NV = IS_ML ? 9 : 8;
    const int tt = w & 3, vb = w >> 2;
    const size_t sbase = (size_t)(sqi * 4 + h) * 128 * 128;
    f32x4 sacc[NV];
    float m_prev = 0.f;
#pragma unroll
    for (int vt = 0; vt < NV; ++vt) sacc[vt] = (f32x4){0.f, 0.f, 0.f, 0.f};
    if (!prompt) {
        const float* S0 = IS_ML ? p.in[3] : p.in[2];
#pragma unroll
        for (int vt = 0; vt < 8; ++vt)
#pragma unroll
            for (int j = 0; j < 4; ++j) sacc[vt][j] = S0[sbase + (size_t)(w * 16 + q4 * 4 + j) * 128 + vt * 16 + l15];
        if (IS_ML) { m_prev = p.in[5][sqi * 4 + h];
            if (l15 == 0) {
#pragma unroll
                for (int j = 0; j < 4; ++j) sacc[NV - 1][j] = p.in[4][(size_t)(sqi * 4 + h) * 128 + w * 16 + q4 * 4 + j]; } }
    }
    float gnr[4][4];
    { const float* gn = (IS_ML ? p.in[13] : p.in[10]) + h * 128;
#pragma unroll
        for (int i = 0; i < 4; ++i)
#pragma unroll
            for (int j = 0; j < 4; ++j) gnr[i][j] = gn[(vb * 4 + i) * 16 + q4 * 4 + j]; }
    u32x4 rq[2], rk[2], rv[2];
    auto load_raw = [&](int c) {
#pragma unroll
        for (int i = 0; i < 2; ++i) { const int pc = tid + 512 * i, r = pc >> 4, c8 = pc & 15;
            if (r < Lc) { const bf16_t* src = PROJ + (size_t)(row0 + c * 64 + r) * NPROJ + c8 * 8;
                rq[i] = *(const u32x4*)src; rk[i] = *(const u32x4*)(src + 512); rv[i] = *(const u32x4*)(src + 1024); }
            else { rq[i] = (u32x4){0u, 0u, 0u, 0u}; rk[i] = rq[i]; rv[i] = rq[i]; } }
    };
    load_raw(0);
    LDS_BARRIER();
#pragma unroll
    for (int vt = 0; vt < NV; ++vt) *(LAS u32x2*)(ST + (vt * 16 + l15) * 272 + (w * 16 + q4 * 4) * 2) = pack4(sacc[vt]);
    if (IS_ML) { for (int i = tid; i < 16 * 72; i += 512) *(LAS unsigned short*)(VT + (128 * 72 + i) * 2) = (i < 72) ? (unsigned short)0x3F80 : (unsigned short)0; }
    for (int c = 0; c < nch; ++c) {
#pragma unroll
        for (int i = 0; i < 2; ++i) { const int pc = tid + 512 * i, r = pc >> 4, c8 = pc & 15;
            *(LAS u32x4*)(Qt + r * 272 + c8 * 16) = rq[i]; *(LAS u32x4*)(Kt + r * 272 + c8 * 16) = rk[i]; *(LAS u32x4*)(rawV + r * 256 + c8 * 16) = rv[i]; }
        if (IS_ML && w == 0) {
            const int t = lane; float lf = 0.f, ig = -INFINITY;
            if (t < Lc) { const float* gp = GATES + (size_t)(row0 + c * 64 + t) * 8; ig = gp[h]; lf = gp[4 + h]; }
            float a = lf;
#pragma unroll
            for (int o = 1; o < 64; o <<= 1) { const float x = __shfl_up(a, o); if (lane >= o) a += x; }
            const float g = ig - a; float cm = g;
#pragma unroll
            for (int o = 1; o < 64; o <<= 1) { const float x = __shfl_up(cm, o); if (lane >= o) cm = fmaxf(cm, x); }
            const float M = fmaxf(m_prev, cm), M63 = __shfl(M, 63), a63 = __shfl(a, 63);
            sm[F_SG + t] = g; sm[F_SM + t] = M; sm[F_SWI + t] = __expf(m_prev - M); sm[F_SMT + t] = a + M; sm[F_SWEND + t] = __expf(g - M63);
            if (lane == 0) { sm[F_SCAL + 0] = __expf(m_prev - M63); sm[F_SCAL + 1] = a63 + M63; }
        }
        LDS_BARRIER();
        if (c + 1 < nch) load_raw(c + 1);
        { const int k = tid & 127, part = tid >> 7; unsigned short kh[16];
            if (!IS_ML) {
                float lfv[16], cs[16]; float run = 0.f;
#pragma unroll
                for (int i = 0; i < 16; ++i) { lfv[i] = bf2f(*(const LAS unsigned short*)(Kt + (part * 16 + i) * 272 + k * 2)); run += lfv[i]; cs[i] = run; }
                sm[F_PTOT + part * 128 + k] = run;
                LDS_BARRIER();
                float pre = 0.f, tot = 0.f;
#pragma unroll
                for (int pp = 0; pp < 4; ++pp) { const float x = sm[F_PTOT + pp * 128 + k]; tot += x; if (pp < part) pre += x; }
                if (part == 0) sm[F_DLAST + k] = __expf(tot);
#pragma unroll
                for (int i = 0; i < 16; ++i) { const int s = part * 16 + i; const float b = pre + cs[i], e = __expf(b), r = __builtin_amdgcn_rcpf(e), kk = 1.f - __expf(lfv[i]);
                    LAS unsigned short* qp = (LAS unsigned short*)(Qt + s * 272 + k * 2); *qp = f2bf(bf2f(*qp) * e);
                    *(LAS unsigned short*)(Kt + s * 272 + k * 2) = f2bf(kk * r); kh[i] = f2bf(kk * __expf(tot - b)); }
            } else {
#pragma unroll
                for (int i = 0; i < 16; ++i) { const int s = part * 16 + i; kh[i] = f2bf(bf2f(*(const LAS unsigned short*)(Kt + s * 272 + k * 2)) * sm[F_SWEND + s]); }
            }
            u32x4 w0, w1;
            w0.x = kh[0] | ((unsigned)kh[1] << 16); w0.y = kh[2] | ((unsigned)kh[3] << 16); w0.z = kh[4] | ((unsigned)kh[5] << 16); w0.w = kh[6] | ((unsigned)kh[7] << 16);
            w1.x = kh[8] | ((unsigned)kh[9] << 16); w1.y = kh[10] | ((unsigned)kh[11] << 16); w1.z = kh[12] | ((unsigned)kh[13] << 16); w1.w = kh[14] | ((unsigned)kh[15] << 16);
            *(LAS u32x4*)(KhT + k * 144 + part * 32) = w0; *(LAS u32x4*)(KhT + k * 144 + part * 32 + 16) = w1;
            unsigned short vv[16];
#pragma unroll
            for (int i = 0; i < 16; ++i) vv[i] = *(const LAS unsigned short*)(rawV + (part * 16 + i) * 256 + k * 2);
            w0.x = vv[0] | ((unsigned)vv[1] << 16); w0.y = vv[2] | ((unsigned)vv[3] << 16); w0.z = vv[4] | ((unsigned)vv[5] << 16); w0.w = vv[6] | ((unsigned)vv[7] << 16);
            w1.x = vv[8] | ((unsigned)vv[9] << 16); w1.y = vv[10] | ((unsigned)vv[11] << 16); w1.z = vv[12] | ((unsigned)vv[13] << 16); w1.w = vv[14] | ((unsigned)vv[15] << 16);
            *(LAS u32x4*)(VT + k * 144 + part * 32) = w0; *(LAS u32x4*)(VT + k * 144 + part * 32 + 16) = w1;
        }
        LDS_BARRIER();
        { const int pt = w >> 1;
#pragma unroll
            for (int e = 0; e < 2; ++e) { const int st = 2 * (w & 1) + e; f32x4 pa = (f32x4){0.f, 0.f, 0.f, 0.f};
                if (st <= pt) {
#pragma unroll
                    for (int ks = 0; ks < 4; ++ks) pa = mfma16(ldfrag(Kt, 272, st * 16 + l15, ks * 32 + q4 * 8), ldfrag(Qt, 272, pt * 16 + l15, ks * 32 + q4 * 8), pa); }
                const int t = pt * 16 + l15, s0 = st * 16 + q4 * 4; const float Mt = IS_ML ? sm[F_SM + t] : 0.f;
#pragma unroll
                for (int j = 0; j < 4; ++j) { const int s = s0 + j; float x = pa[j]; if (IS_ML) x *= __expf(sm[F_SG + s] - Mt); pa[j] = (s <= t) ? x : 0.f; }
                *(LAS u32x2*)(Sw + t * 144 + s0 * 2) = pack4(pa); } }
        f32x4 oacc[5];
        { bf16x8 bq[4];
#pragma unroll
            for (int ks = 0; ks < 4; ++ks) bq[ks] = ldfrag(Qt, 272, tt * 16 + l15, ks * 32 + q4 * 8);
            const float wi = IS_ML ? sm[F_SWI + tt * 16 + l15] : 1.f;
#pragma unroll
            for (int i = 0; i < 5; ++i) { oacc[i] = (f32x4){0.f, 0.f, 0.f, 0.f};
                if (i < 4 || (IS_ML && vb == 1)) { const int vt = i < 4 ? vb * 4 + i : 8;
#pragma unroll
                    for (int ks = 0; ks < 4; ++ks) oacc[i] = mfma16(ldfrag(ST, 272, vt * 16 + l15, ks * 32 + q4 * 8), bq[ks], oacc[i]);
                    if (IS_ML) oacc[i] = oacc[i] * wi; } } }
        LDS_BARRIER();
        { bf16x8 bs[2];
#pragma unroll
            for (int ks = 0; ks < 2; ++ks) bs[ks] = ldfrag(Sw, 144, tt * 16 + l15, ks * 32 + q4 * 8);
#pragma unroll
            for (int i = 0; i < 5; ++i) if (i < 4 || (IS_ML && vb == 1)) { const int vt = i < 4 ? vb * 4 + i : 8;
#pragma unroll
                for (int ks = 0; ks < 2; ++ks) oacc[i] = mfma16(ldfrag(VT, 144, vt * 16 + l15, ks * 32 + q4 * 8), bs[ks], oacc[i]); } }
        { bf16x8 ak[2];
#pragma unroll
            for (int ks = 0; ks < 2; ++ks) ak[ks] = ldfrag(KhT, 144, w * 16 + l15, ks * 32 + q4 * 8);
            f32x4 dl;
            if (IS_ML) { const float fe = sm[F_SCAL + 0]; dl = (f32x4){fe, fe, fe, fe}; m_prev = sm[F_SCAL + 1]; }
            else dl = *(const LAS f32x4*)(sm + F_DLAST + w * 16 + q4 * 4);
#pragma unroll
            for (int vt = 0; vt < NV; ++vt) { sacc[vt] = sacc[vt] * dl;
#pragma unroll
                for (int ks = 0; ks < 2; ++ks) sacc[vt] = mfma16(ak[ks], ldfrag(VT, 144, vt * 16 + l15, ks * 32 + q4 * 8), sacc[vt]);
                *(LAS u32x2*)(ST + (vt * 16 + l15) * 272 + (w * 16 + q4 * 4) * 2) = pack4(sacc[vt]); } }
        const int t = tt * 16 + l15;
        if (IS_ML) {
            if (vb == 1 && q4 == 0) sm[F_SDEN + t] = oacc[4][0];
            LDS_BARRIER();
            const float inv = 1.0f / fmaxf(fabsf(sm[F_SDEN + t]), __expf(-sm[F_SMT + t]));
#pragma unroll
            for (int i = 0; i < 4; ++i) oacc[i] = oacc[i] * inv;
        }
        float ss = 0.f;
#pragma unroll
        for (int i = 0; i < 4; ++i) ss += (oacc[i][0] * oacc[i][0] + oacc[i][1] * oacc[i][1]) + (oacc[i][2] * oacc[i][2] + oacc[i][3] * oacc[i][3]);
        ss += __shfl_xor(ss, 16); ss += __shfl_xor(ss, 32);
        if (q4 == 0) sm[F_SSSQ + t * 2 + vb] = ss;
        LDS_BARRIER();
        if (t < Lc) { const float rs = rsqrtf((sm[F_SSSQ + t * 2] + sm[F_SSSQ + t * 2 + 1]) * (1.f / 128.f) + EPS);
            const size_t row = (size_t)row0 + c * 64 + t;
#pragma unroll
            for (int i = 0; i < 4; ++i) { const int v0 = (vb * 4 + i) * 16 + q4 * 4; const u32x2 gt = *(const u32x2*)(PROJ + row * NPROJ + 1536 + v0);
                f32x4 o; o[0] = oacc[i][0] * rs * gnr[i][0] * __uint_as_float(gt.x << 16); o[1] = oacc[i][1] * rs * gnr[i][1] * __uint_as_float(gt.x & 0xffff0000u);
                o[2] = oacc[i][2] * rs * gnr[i][2] * __uint_as_float(gt.y << 16); o[3] = oacc[i][3] * rs * gnr[i][3] * __uint_as_float(gt.y & 0xffff0000u);
                *(u32x2*)(AMIX + row * DM + v0) = pack4(o); } }
    }
    { float* So = p.out + (IS_ML ? (prompt ? O_CP : O_CS) : (prompt ? O_SP : O_SS));
#pragma unroll
        for (int vt = 0; vt < 8; ++vt)
#pragma unroll
            for (int j = 0; j < 4; ++j) So[sbase + (size_t)(w * 16 + q4 * 4 + j) * 128 + vt * 16 + l15] = sacc[vt][j];
        if (IS_ML) { if (l15 == 0) { float* no = p.out + (prompt ? O_NP : O_NS) + (size_t)(sqi * 4 + h) * 128;
#pragma unroll
                for (int j = 0; j < 4; ++j) no[w * 16 + q4 * 4 + j] = sacc[NV - 1][j]; }
            if (tid == 0) p.out[(prompt ? O_MP : O_MS) + sqi * 4 + h] = m_prev; } }
}
__device__ __forceinline__ void mixer_dispatch(const Params& p, LAS unsigned char* L, int it) {
    int g, sqi, h; const bool prompt = it < 64;
    if (prompt) { g = it >> 5; sqi = (it >> 2) & 7; h = it & 3; } else { const int j = it - 64; g = j >> 9; sqi = (j >> 2) & 127; h = j & 3; }
    if (g == 0) mixer_item<false>(p, L, sqi, h, prompt); else mixer_item<true>(p, L, sqi, h, prompt);
}
__device__ __forceinline__ void phase2_chunked(const Params& p, LAS unsigned char* L) {
    const int G = gridDim.x, b = blockIdx.x;
    if (G > 64) { if (b < 64) mixer_dispatch(p, L, b); else for (int it = b; it < 1088; it += G - 64) mixer_dispatch(p, L, it); }
    else for (int it = b; it < 1088; it += G) mixer_dispatch(p, L, it);
}
constexpr size_t WS_SB = WS_X1;
template <bool IS_ML>
__device__ __forceinline__ void prepass_item(const Params& p, LAS unsigned char* L, const int sqi, const int c, const int h, u32x4 (&rq)[2], u32x4 (&rk)[2], u32x4 (&rv)[2], float& gig, float& glf,
                                             const bf16_t* nsrc, const float* ngates) {
    const int tid = threadIdx.x, w = __builtin_amdgcn_readfirstlane(tid >> 6), lane = tid & 63, l15 = lane & 15, q4 = lane >> 4;
    const int row0 = sqi * 2048 + c * 64;
    bf16_t* PROJ = (bf16_t*)(p.ws + WS_R1) + (IS_ML ? 2048 : 0) + h * 128;
    bf16_t* AMIX = (bf16_t*)p.out + (size_t)MROWS * DM + (IS_ML ? 512 : 0) + h * 128;
    float* SB = (float*)(p.ws + WS_SB) + (size_t)((((IS_ML ? 8 : 0) + sqi) * 32 + c) * 4 + h) * 256;
    LAS unsigned char* Qt = L + QT_OFF; LAS unsigned char* Kt = L + KT_OFF; LAS unsigned char* KhT = L + KHT_OFF; LAS unsigned char* VT = L + VT_OFF;
    LAS unsigned char* Sw = L + SW_OFF; LAS unsigned char* rawV = L + RAWV_OFF; LAS float* sm = (LAS float*)(L + SM_OFF);
    const int tt = w & 3, vb = w >> 2;
    LDS_BARRIER();
    if (IS_ML) { for (int i = tid; i < 16 * 72; i += 512) *(LAS unsigned short*)(VT + (128 * 72 + i) * 2) = (i < 72) ? (unsigned short)0x3F80 : (unsigned short)0; }
#pragma unroll
    for (int i = 0; i < 2; ++i) { const int pc = tid + 512 * i, r = pc >> 4, c8 = pc & 15;
        *(LAS u32x4*)(Qt + r * 272 + c8 * 16) = rq[i]; *(LAS u32x4*)(Kt + r * 272 + c8 * 16) = rk[i]; *(LAS u32x4*)(rawV + r * 256 + c8 * 16) = rv[i]; }
    if (IS_ML && w == 0) {
        const int t = lane; const float ig = gig, lf = glf;
        float a = lf;
#pragma unroll
        for (int o = 1; o < 64; o <<= 1) { const float x = __shfl_up(a, o); if (lane >= o) a += x; }
        const float g = ig - a; float cm = g;
#pragma unroll
        for (int o = 1; o < 64; o <<= 1) { const float x = __shfl_up(cm, o); if (lane >= o) cm = fmaxf(cm, x); }
        const float M63 = __shfl(cm, 63);
        sm[F_SG + t] = g; sm[F_SM + t] = cm; sm[F_SWEND + t] = __expf(g - M63);
        SB[64 + t] = cm; SB[128 + t] = a;
    }
    if (nsrc) {
#pragma unroll
        for (int i = 0; i < 2; ++i) { const int pc = tid + 512 * i, r = pc >> 4, c8 = pc & 15; const bf16_t* src = nsrc + (size_t)r * NPROJ + c8 * 8;
            rq[i] = *(const u32x4*)src; rk[i] = *(const u32x4*)(src + 512); rv[i] = *(const u32x4*)(src + 1024); }
        if (ngates && w == 0) { gig = ngates[lane * 8]; glf = ngates[lane * 8 + 4]; } }
    LDS_BARRIER();
    { const int k = tid & 127, part = tid >> 7; unsigned short kh[16];
        if (!IS_ML) {
            float lfv[16], cs[16]; float run = 0.f;
#pragma unroll
            for (int i = 0; i < 16; ++i) { lfv[i] = bf2f(*(const LAS unsigned short*)(Kt + (part * 16 + i) * 272 + k * 2)); run += lfv[i]; cs[i] = run; }
            sm[F_PTOT + part * 128 + k] = run;
            LDS_BARRIER();
            float pre = 0.f, tot = 0.f;
#pragma unroll
            for (int pp = 0; pp < 4; ++pp) { const float x = sm[F_PTOT + pp * 128 + k]; tot += x; if (pp < part) pre += x; }
            if (part == 0) SB[k] = __expf(tot);
#pragma unroll
            for (int i = 0; i < 16; ++i) { const int s = part * 16 + i; const float b = pre + cs[i], e = __expf(b), r = __builtin_amdgcn_rcpf(e), kk = 1.f - __expf(lfv[i]);
                LAS unsigned short* qp = (LAS unsigned short*)(Qt + s * 272 + k * 2); *qp = f2bf(bf2f(*qp) * e);
                *(LAS unsigned short*)(Kt + s * 272 + k * 2) = f2bf(kk * r); kh[i] = f2bf(kk * __expf(tot - b)); }
        } else {
#pragma unroll
            for (int i = 0; i < 16; ++i) { const int s = part * 16 + i; kh[i] = f2bf(bf2f(*(const LAS unsigned short*)(Kt + s * 272 + k * 2)) * sm[F_SWEND + s]); }
        }
        u32x4 w0, w1;
        w0.x = kh[0] | ((unsigned)kh[1] << 16); w0.y = kh[2] | ((unsigned)kh[3] << 16); w0.z = kh[4] | ((unsigned)kh[5] << 16); w0.w = kh[6] | ((unsigned)kh[7] << 16);
        w1.x = kh[8] | ((unsigned)kh[9] << 16); w1.y = kh[10] | ((unsigned)kh[11] << 16); w1.z = kh[12] | ((unsigned)kh[13] << 16); w1.w = kh[14] | ((unsigned)kh[15] << 16);
        *(LAS u32x4*)(KhT + k * 144 + part * 32) = w0; *(LAS u32x4*)(KhT + k * 144 + part * 32 + 16) = w1;
        unsigned short vv[16];
#pragma unroll
        for (int i = 0; i < 16; ++i) vv[i] = *(const LAS unsigned short*)(rawV + (part * 16 + i) * 256 + k * 2);
        w0.x = vv[0] | ((unsigned)vv[1] << 16); w0.y = vv[2] | ((unsigned)vv[3] << 16); w0.z = vv[4] | ((unsigned)vv[5] << 16); w0.w = vv[6] | ((unsigned)vv[7] << 16);
        w1.x = vv[8] | ((unsigned)vv[9] << 16); w1.y = vv[10] | ((unsigned)vv[11] << 16); w1.z = vv[12] | ((unsigned)vv[13] << 16); w1.w = vv[14] | ((unsigned)vv[15] << 16);
        *(LAS u32x4*)(VT + k * 144 + part * 32) = w0; *(LAS u32x4*)(VT + k * 144 + part * 32 + 16) = w1;
    }
    LDS_BARRIER();
    { const int pt = w >> 1;
#pragma unroll
        for (int e = 0; e < 2; ++e) { const int st = 2 * (w & 1) + e; f32x4 pa = (f32x4){0.f, 0.f, 0.f, 0.f};
            if (st <= pt) {
#pragma unroll
                for (int ks = 0; ks < 4; ++ks) pa = mfma16(ldfrag(Kt, 272, st * 16 + l15, ks * 32 + q4 * 8), ldfrag(Qt, 272, pt * 16 + l15, ks * 32 + q4 * 8), pa); }
            const int t = pt * 16 + l15, s0 = st * 16 + q4 * 4; const float Mt = IS_ML ? sm[F_SM + t] : 0.f;
#pragma unroll
            for (int j = 0; j < 4; ++j) { const int s = s0 + j; float x = pa[j]; if (IS_ML) x *= __expf(sm[F_SG + s] - Mt); pa[j] = (s <= t) ? x : 0.f; }
            *(LAS u32x2*)(Sw + t * 144 + s0 * 2) = pack4(pa); } }
#pragma unroll
    for (int i = 0; i < 2; ++i) { const int pc = tid + 512 * i;
        if (!IS_ML) { const int r = pc >> 4, c8 = pc & 15; *(u32x4*)(PROJ + (size_t)(row0 + r) * NPROJ + c8 * 8) = *(const LAS u32x4*)(Qt + r * 272 + c8 * 16); }
        const int k = pc >> 3, s8 = pc & 7; bf16_t* dst = PROJ + (size_t)(row0 + (k >> 1)) * NPROJ + (k & 1) * 64 + s8 * 8;
        *(u32x4*)(dst + 512) = *(const LAS u32x4*)(KhT + k * 144 + s8 * 16); *(u32x4*)(dst + 1024) = *(const LAS u32x4*)(VT + k * 144 + s8 * 16); }
    LDS_BARRIER();
    { bf16x8 bs[2];
#pragma unroll
        for (int ks = 0; ks < 2; ++ks) bs[ks] = ldfrag(Sw, 144, tt * 16 + l15, ks * 32 + q4 * 8);
#pragma unroll
        for (int i = 0; i < 5; ++i) if (i < 4 || (IS_ML && vb == 1)) { const int vt = i < 4 ? vb * 4 + i : 8; f32x4 o = (f32x4){0.f, 0.f, 0.f, 0.f};
#pragma unroll
            for (int ks = 0; ks < 2; ++ks) o = mfma16(ldfrag(VT, 144, vt * 16 + l15, ks * 32 + q4 * 8), bs[ks], o);
            const int t = tt * 16 + l15;
            if (i < 4) *(u32x2*)(AMIX + (size_t)(row0 + t) * DM + vt * 16 + q4 * 4) = pack4(o);
            else if (q4 == 0) SB[t] = o[0]; } }
}
constexpr int C_QT = 0, C_KHT = 17408, C_VT = 35840, C_ST0 = 56576, C_ST1 = 95744, C_SM = 134912;
constexpr int CF_WI = 0, CF_RHO = 64, CF_DEN = 128, CF_EMT = 192, CF_SCAL = 256, CF_SSSQ = 272;
template <bool IS_ML>
__device__ __forceinline__ void chain_run(const Params& p, LAS unsigned char* L, const int sqi, const int h, const bool write_out = true) {
    const int tid = threadIdx.x, w = __builtin_amdgcn_readfirstlane(tid >> 6), lane = tid & 63, l15 = lane & 15, q4 = lane >> 4;
    const int row0 = sqi * 2048;
    const bf16_t* PROJ = (const bf16_t*)(p.ws + WS_R1) + (IS_ML ? 2048 : 0) + h * 128;
    bf16_t* AMIX = (bf16_t*)p.out + (size_t)MROWS * DM + (IS_ML ? 512 : 0) + h * 128;
    const float* SB0 = (const float*)(p.ws + WS_SB) + (size_t)((((IS_ML ? 8 : 0) + sqi) * 32) * 4 + h) * 256;
    LAS unsigned char* Qt = L + C_QT; LAS unsigned char* KhT = L + C_KHT; LAS unsigned char* VT = L + C_VT; LAS float* sm = (LAS float*)(L + C_SM);
    constexpr int NV = IS_ML ? 9 : 8;
    const int tt = w & 3, vb = w >> 2, t = tt * 16 + l15;
    const size_t sbase = (size_t)(sqi * 4 + h) * 128 * 128;
    f32x4 sacc[NV];
#pragma unroll
    for (int vt = 0; vt < NV; ++vt) sacc[vt] = (f32x4){0.f, 0.f, 0.f, 0.f};
    float m_prev = 0.f;
    const float* gn = (IS_ML ? p.in[13] : p.in[10]) + h * 128;
    u32x4 rq[2], rk[2], rv[2]; u32x2 rin[4], rgt[4]; f32x4 dl = (f32x4){0.f, 0.f, 0.f, 0.f}; float s_den = 0.f, s_ml = 0.f, s_a = 0.f;
    auto prefetch_big = [&](int c) {
#pragma unroll
        for (int i = 0; i < 2; ++i) { const int pc = tid + 512 * i; const int r = pc >> 4, c8 = pc & 15;
            rq[i] = *(const u32x4*)(PROJ + (size_t)(row0 + c * 64 + r) * NPROJ + c8 * 8);
            const int k = pc >> 3, s8 = pc & 7; const bf16_t* src = PROJ + (size_t)(row0 + c * 64 + (k >> 1)) * NPROJ + (k & 1) * 64 + s8 * 8;
            rk[i] = *(const u32x4*)(src + 512); rv[i] = *(const u32x4*)(src + 1024); }
    };
    auto prefetch_io = [&](int c) {
        const size_t row = (size_t)row0 + c * 64 + t;
#pragma unroll
        for (int i = 0; i < 4; ++i) { const int v0 = (vb * 4 + i) * 16 + q4 * 4; rin[i] = *(const u32x2*)(AMIX + row * DM + v0); rgt[i] = *(const u32x2*)(PROJ + row * NPROJ + 1536 + v0); }
    };
    auto prefetch_sb = [&](int c, f32x4& dl_, float& d_, float& ml_, float& a_) {
        const float* sb = SB0 + (size_t)c * 1024;
        if (!IS_ML) dl_ = *(const f32x4*)(sb + w * 16 + q4 * 4);
        else if (w == 0) { d_ = sb[lane]; ml_ = sb[64 + lane]; a_ = sb[128 + lane]; }
    };
    prefetch_big(0); prefetch_io(0); prefetch_sb(0, dl, s_den, s_ml, s_a);
    LDS_BARRIER();
#pragma unroll
    for (int vt = 0; vt < NV; ++vt) *(LAS u32x2*)(L + C_ST0 + (vt * 16 + l15) * 272 + (w * 16 + q4 * 4) * 2) = (u32x2){0u, 0u};
    if (IS_ML) { for (int i = tid; i < 16 * 72; i += 512) *(LAS unsigned short*)(VT + (128 * 72 + i) * 2) = (i < 72) ? (unsigned short)0x3F80 : (unsigned short)0; }
    for (int c = 0; c < 32; ++c) {
        LAS unsigned char* STr = L + ((c & 1) ? C_ST1 : C_ST0); LAS unsigned char* STw = L + ((c & 1) ? C_ST0 : C_ST1);
#pragma unroll
        for (int i = 0; i < 2; ++i) { const int pc = tid + 512 * i; const int r = pc >> 4, c8 = pc & 15, k = pc >> 3, s8 = pc & 7;
            *(LAS u32x4*)(Qt + r * 272 + c8 * 16) = rq[i]; *(LAS u32x4*)(KhT + k * 144 + s8 * 16) = rk[i]; *(LAS u32x4*)(VT + k * 144 + s8 * 16) = rv[i]; }
        if (IS_ML && w == 0) {
            const float M = fmaxf(m_prev, s_ml), M63 = __shfl(M, 63), ml63 = __shfl(s_ml, 63), a63 = __shfl(s_a, 63);
            sm[CF_WI + lane] = __expf(m_prev - M); sm[CF_RHO + lane] = __expf(s_ml - M); sm[CF_DEN + lane] = s_den; sm[CF_EMT + lane] = __expf(-(s_a + M));
            if (lane == 0) { sm[CF_SCAL + 0] = __expf(m_prev - M63); sm[CF_SCAL + 1] = __expf(ml63 - M63); sm[CF_SCAL + 2] = a63 + M63; }
        }
        LDS_BARRIER();
        f32x4 ndl = dl; float n_den = 0.f, n_ml = 0.f, n_a = 0.f;
        if (c + 1 < 32) { prefetch_big(c + 1); prefetch_sb(c + 1, ndl, n_den, n_ml, n_a); }
        float wi_t = 1.f, rho_t = 1.f, denl_t = 0.f, emt_t = 0.f, fend = 1.f, sigma = 1.f;
        if (IS_ML) { wi_t = sm[CF_WI + t]; rho_t = sm[CF_RHO + t]; denl_t = sm[CF_DEN + t]; emt_t = sm[CF_EMT + t]; fend = sm[CF_SCAL + 0]; sigma = sm[CF_SCAL + 1]; m_prev = sm[CF_SCAL + 2]; }
        f32x4 oacc[5];
        { bf16x8 bq[4];
#pragma unroll
            for (int ks = 0; ks < 4; ++ks) bq[ks] = ldfrag(Qt, 272, tt * 16 + l15, ks * 32 + q4 * 8);
#pragma unroll
            for (int i = 0; i < 5; ++i) { oacc[i] = (f32x4){0.f, 0.f, 0.f, 0.f};
                if (i < 4 || IS_ML) { const int vt = i < 4 ? vb * 4 + i : 8;
#pragma unroll
                    for (int ks = 0; ks < 4; ++ks) oacc[i] = mfma16(ldfrag(STr, 272, vt * 16 + l15, ks * 32 + q4 * 8), bq[ks], oacc[i]); } } }
        { bf16x8 ak[2];
#pragma unroll
            for (int ks = 0; ks < 2; ++ks) ak[ks] = ldfrag(KhT, 144, w * 16 + l15, ks * 32 + q4 * 8);
#pragma unroll
            for (int vt = 0; vt < NV; ++vt) {
                if (!IS_ML) { sacc[vt] = sacc[vt] * dl;
#pragma unroll
                    for (int ks = 0; ks < 2; ++ks) sacc[vt] = mfma16(ak[ks], ldfrag(VT, 144, vt * 16 + l15, ks * 32 + q4 * 8), sacc[vt]); }
                else { f32x4 uacc = (f32x4){0.f, 0.f, 0.f, 0.f};
#pragma unroll
                    for (int ks = 0; ks < 2; ++ks) uacc = mfma16(ak[ks], ldfrag(VT, 144, vt * 16 + l15, ks * 32 + q4 * 8), uacc);
                    sacc[vt] = sacc[vt] * fend + uacc * sigma; }
                *(LAS u32x2*)(STw + (vt * 16 + l15) * 272 + (w * 16 + q4 * 4) * 2) = pack4(sacc[vt]); } }
        float inv = 1.f;
        if (IS_ML) { const float di = __shfl(oacc[4][0], l15); inv = 1.0f / fmaxf(fabsf(wi_t * di + rho_t * denl_t), emt_t); }
        float ss = 0.f;
#pragma unroll
        for (int i = 0; i < 4; ++i) { f32x4 in; in[0] = __uint_as_float(rin[i].x << 16); in[1] = __uint_as_float(rin[i].x & 0xffff0000u); in[2] = __uint_as_float(rin[i].y << 16); in[3] = __uint_as_float(rin[i].y & 0xffff0000u);
            if (IS_ML) oacc[i] = (oacc[i] * wi_t + in * rho_t) * inv; else oacc[i] = oacc[i] + in;
            ss += (oacc[i][0] * oacc[i][0] + oacc[i][1] * oacc[i][1]) + (oacc[i][2] * oacc[i][2] + oacc[i][3] * oacc[i][3]); }
        ss += __shfl_xor(ss, 16); ss += __shfl_xor(ss, 32);
        LAS float* sq = sm + CF_SSSQ + (c & 1) * 128;
        if (q4 == 0) sq[t * 2 + vb] = ss;
        LDS_BARRIER();
        { const float rs = rsqrtf((sq[t * 2] + sq[t * 2 + 1]) * (1.f / 128.f) + EPS); const size_t row = (size_t)row0 + c * 64 + t;
#pragma unroll
            for (int i = 0; i < 4; ++i) { const int v0 = (vb * 4 + i) * 16 + q4 * 4; const u32x2 gt = rgt[i];
                const f32x4 gv = *(const f32x4*)(gn + v0);
                f32x4 o; o[0] = oacc[i][0] * rs * gv[0] * __uint_as_float(gt.x << 16); o[1] = oacc[i][1] * rs * gv[1] * __uint_as_float(gt.x & 0xffff0000u);
                o[2] = oacc[i][2] * rs * gv[2] * __uint_as_float(gt.y << 16); o[3] = oacc[i][3] * rs * gv[3] * __uint_as_float(gt.y & 0xffff0000u);
                if (write_out) *(u32x2*)(AMIX + row * DM + v0) = pack4(o); } }
        if (c + 1 < 32) prefetch_io(c + 1);
        dl = ndl; s_den = n_den; s_ml = n_ml; s_a = n_a;
    }
    { float* So = p.out + (IS_ML ? O_CP : O_SP);
#pragma unroll
        for (int vt = 0; vt < 8; ++vt)
#pragma unroll
            for (int j = 0; j < 4; ++j) So[sbase + (size_t)(w * 16 + q4 * 4 + j) * 128 + vt * 16 + l15] = sacc[vt][j];
        if (IS_ML) { if (l15 == 0) { float* no = p.out + O_NP + (size_t)(sqi * 4 + h) * 128;
#pragma unroll
                for (int j = 0; j < 4; ++j) no[w * 16 + q4 * 4 + j] = sacc[NV - 1][j]; }
            if (tid == 0) p.out[O_MP + sqi * 4 + h] = m_prev; } }
}
#ifndef SAMPLE_TWICE
#define SAMPLE_TWICE 0
#endif
#ifndef SAMPLE_TWICE
#define SAMPLE_TWICE 0
#endif
#ifndef CHAIN_TWICE
#define CHAIN_TWICE 0
#endif
#ifndef NS_A
#define NS_A 0
#endif
__device__ __forceinline__ void sample_dispatch(const Params& p, LAS unsigned char* L, int j) {
    const int g = j >> 9, sqi = (j >> 2) & 127, h = j & 3;
    if (g == 0) mixer_item<false>(p, L, sqi, h, false); else mixer_item<true>(p, L, sqi, h, false);
}
__device__ __forceinline__ void phase2a(const Params& p, LAS unsigned char* L) {
    const int tid = threadIdx.x, lane = tid & 63, w = tid >> 6;
    u32x4 rq[2], rk[2], rv[2]; float gig = 0.f, glf = 0.f;
    auto slot = [&](int it) -> const bf16_t* { const int g = it >> 10, sqi = (it >> 7) & 7, c = (it >> 2) & 31, h = it & 3; return (const bf16_t*)(p.ws + WS_R1) + (size_t)(sqi * 2048 + c * 64) * NPROJ + (g ? 2048 : 0) + h * 128; };
    auto gptr = [&](int it) -> const float* { const int g = it >> 10, sqi = (it >> 7) & 7, c = (it >> 2) & 31, h = it & 3; return g ? (const float*)(p.ws + WS_GATES) + (size_t)(sqi * 2048 + c * 64) * 8 + h : nullptr; };
    int it = blockIdx.x;
    if (it < 2048) { const bf16_t* s0 = slot(it);
#pragma unroll
        for (int i = 0; i < 2; ++i) { const int pc = tid + 512 * i, r = pc >> 4, c8 = pc & 15; const bf16_t* src = s0 + (size_t)r * NPROJ + c8 * 8;
            rq[i] = *(const u32x4*)src; rk[i] = *(const u32x4*)(src + 512); rv[i] = *(const u32x4*)(src + 1024); }
        const float* g0 = gptr(it); if (g0 && w == 0) { gig = g0[lane * 8]; glf = g0[lane * 8 + 4]; } }
    for (; it < 2048; it += gridDim.x) { const int g = it >> 10, sqi = (it >> 7) & 7, c = (it >> 2) & 31, h = it & 3; const int nx = it + gridDim.x;
        const bf16_t* ns = nx < 2048 ? slot(nx) : nullptr; const float* ng = nx < 2048 ? gptr(nx) : nullptr;
        if (g == 0) prepass_item<false>(p, L, sqi, c, h, rq, rk, rv, gig, glf, ns, ng); else prepass_item<true>(p, L, sqi, c, h, rq, rk, rv, gig, glf, ns, ng); }
}
__device__ __forceinline__ void phase2a_samples(const Params& p, LAS unsigned char* L) {
    for (int it = 2048 + blockIdx.x; it < 2048 + NS_A; it += gridDim.x) { sample_dispatch(p, L, it - 2048); if (SAMPLE_TWICE) sample_dispatch(p, L, it - 2048); }
}
__device__ __forceinline__ void phase2_naive(const Params& p, unsigned char* shm) {
    float* sq = (float*)shm; float* sd = sq + 128; float* si = sd + 128; float* sv = si + 128; float* part = sv + 128; float* denp = part + 512; float* red = denp + 4;
    const int tid = threadIdx.x, v = tid & 127, kq = tid >> 7;
    const bf16_t* PROJ = (const bf16_t*)(p.ws + WS_R1); bf16_t* AMIX = (bf16_t*)p.out + (size_t)MROWS * DM; const float* GATES = (const float*)(p.ws + WS_GATES);
    for (int it = blockIdx.x; it < 1088; it += gridDim.x) {
        int g, sqi, h, T, row0; const bool prompt = it < 64;
        if (prompt) { g = it >> 5; sqi = (it >> 2) & 7; h = it & 3; T = 2048; row0 = sqi * 2048; }
        else { const int j = it - 64; g = j >> 9; sqi = (j >> 2) & 127; h = j & 3; T = 8; row0 = MPROMPT + sqi * 8; }
        float S[32], nst[32]; float mst = 0.f;
        const size_t sbase = ((size_t)(sqi * 4 + h) * 128) * 128;
#pragma unroll
        for (int i = 0; i < 32; ++i) { S[i] = 0.f; nst[i] = 0.f; }
        if (!prompt) { const float* S0 = g == 0 ? p.in[2] : p.in[3];
#pragma unroll
            for (int i = 0; i < 32; ++i) S[i] = S0[sbase + (size_t)(kq * 32 + i) * 128 + v];
            if (g == 1) { mst = p.in[5][sqi * 4 + h];
#pragma unroll
                for (int i = 0; i < 32; ++i) nst[i] = p.in[4][(size_t)(sqi * 4 + h) * 128 + kq * 32 + i]; } }
        const float* gn = (g == 0 ? p.in[10] : p.in[13]) + h * 128;
        for (int t = 0; t < T; ++t) {
            const size_t row = (size_t)row0 + t; const bf16_t* pr = PROJ + row * NPROJ + g * 2048 + h * 128;
            float m_new = 0.f;
            if (g == 0) {
                if (tid < 128) sq[tid] = bf2f(pr[tid]);
                else if (tid < 256) { const float f = __expf(bf2f(pr[512 + tid - 128])); sd[tid - 128] = f; si[tid - 128] = 1.f - f; }
                else if (tid < 384) sv[tid - 256] = bf2f(pr[1024 + tid - 256]);
            } else {
                const float ig = GATES[row * 8 + h], lf = GATES[row * 8 + 4 + h];
                m_new = fmaxf(lf + mst, ig); const float fd = __expf(lf + mst - m_new), ii = __expf(ig - m_new);
                if (tid < 128) sq[tid] = bf2f(pr[tid]);
                else if (tid < 256) { sd[tid - 128] = fd; si[tid - 128] = ii * bf2f(pr[512 + tid - 128]); }
                else if (tid < 384) sv[tid - 256] = bf2f(pr[1024 + tid - 256]);
            }
            __syncthreads();
            const float vv = sv[v]; float acc = 0.f, dacc = 0.f;
#pragma unroll
            for (int i = 0; i < 32; ++i) { const int k = kq * 32 + i; const float d = sd[k], ik = si[k], q = sq[k]; S[i] = d * S[i] + ik * vv; acc += q * S[i]; nst[i] = d * nst[i] + ik; dacc += q * nst[i]; }
            part[kq * 128 + v] = acc; if (v == 0) denp[kq] = dacc;
            __syncthreads();
            float o = 0.f;
            if (tid < 128) { o = (part[tid] + part[128 + tid]) + (part[256 + tid] + part[384 + tid]);
                if (g == 1) { const float den = (denp[0] + denp[1]) + (denp[2] + denp[3]); o = o / fmaxf(fabsf(den), __expf(-m_new)); }
                const float ss = wave_sum(o * o); if ((tid & 63) == 0) red[tid >> 6] = ss; }
            __syncthreads();
            if (tid < 128) { const float tot = red[0] + red[1]; const float gate = bf2f(pr[1536 + tid]);
                AMIX[row * DM + g * 512 + h * 128 + tid] = f2bf(o * rsqrtf(tot * (1.f / 128.f) + EPS) * gn[tid] * gate); }
            mst = m_new;
            __syncthreads();
        }
        float* So = p.out + (g == 0 ? (prompt ? O_SP : O_SS) : (prompt ? O_CP : O_CS));
#pragma unroll
        for (int i = 0; i < 32; ++i) So[sbase + (size_t)(kq * 32 + i) * 128 + v] = S[i];
        if (g == 1 && v == 0) { float* no = p.out + (prompt ? O_NP : O_NS) + (size_t)(sqi * 4 + h) * 128;
#pragma unroll
            for (int i = 0; i < 32; ++i) no[kq * 32 + i] = nst[i];
            if (kq == 0) p.out[(prompt ? O_MP : O_MS) + sqi * 4 + h] = mst; }
    }
}
__device__ __forceinline__ void phase5(const Params& p) {
    const float* UHL = (const float*)(p.ws + WS_UHL); const float* UHF = (const float*)(p.ws + WS_UHF); bf16_t* ACT = (bf16_t*)(p.ws + WS_R1 + R1_ACT);
    const float* cw = p.in[18]; const float* cbp = p.in[19];
    constexpr int NQ = DFF / 4;
    for (int i = blockIdx.x * 512 + threadIdx.x; i < 256 * 2 * NQ; i += gridDim.x * 512) {
        const int cq = i % NQ, j = (i / NQ) & 1, gi = i / (2 * NQ), c = 4 * cq; const int row = gi * 64 + j;
        const bool first = (gi & 31) == 0;
        const f32x4 z = (f32x4){0.f, 0.f, 0.f, 0.f};
        const f32x4 l0 = first ? z : *(const f32x4*)(UHL + (size_t)((gi - 1) * 2 + 0) * DFF + c), l1 = first ? z : *(const f32x4*)(UHL + (size_t)((gi - 1) * 2 + 1) * DFF + c);
        const f32x4 u0 = *(const f32x4*)(UHF + (size_t)((gi * 2 + 0) * 2) * DFF + c);
        const f32x4 uu = *(const f32x4*)(UHF + (size_t)((gi * 2 + j) * 2) * DFF + c), vv = *(const f32x4*)(UHF + (size_t)((gi * 2 + j) * 2 + 1) * DFF + c);
        const f32x4 p2 = j == 0 ? l0 : l1, p1 = j == 0 ? l1 : u0;
        const f32x4 w0 = *(const f32x4*)(cw + c), w1 = *(const f32x4*)(cw + DFF + c), w2 = *(const f32x4*)(cw + 2 * DFF + c), cb = *(const f32x4*)(cbp + c);
        float a[4];
#pragma unroll
        for (int e = 0; e < 4; ++e) a[e] = gelu_tanh(cb[e] + w0[e] * p2[e] + w1[e] * p1[e] + w2[e] * uu[e]) * vv[e];
        *(u32x2*)(ACT + (size_t)row * DFF + c) = (u32x2){cvt_pk_bf16(a[0], a[1]), cvt_pk_bf16(a[2], a[3])};
    }
}
__device__ __forceinline__ void phase7(const Params& p) {
    const float* gf = p.in[21]; float* Y = p.out; const float* X1 = (const float*)(p.ws + WS_X1); const float* PART = (const float*)(p.ws + WS_R1 + R1_X1B);
    const int wave = threadIdx.x >> 6, lane = threadIdx.x & 63;
    f32x4 g[4];
#pragma unroll
    for (int j = 0; j < 4; ++j) g[j] = *(const f32x4*)(gf + 4 * lane + 256 * j);
    auto load_row = [&](int row, f32x4 (&v)[4]) {
        if (row < MPROMPT) {
#pragma unroll
            for (int j = 0; j < 4; ++j) v[j] = *(const f32x4*)(Y + (size_t)row * DM + 4 * lane + 256 * j);
        } else {
#pragma unroll
            for (int j = 0; j < 4; ++j) v[j] = *(const f32x4*)(X1 + (size_t)row * DM + 4 * lane + 256 * j);
#pragma unroll
            for (int sl = 0; sl < 7; ++sl)
#pragma unroll
                for (int j = 0; j < 4; ++j) v[j] = v[j] + *(const f32x4*)(PART + (size_t)sl * (1024 * DM) + (size_t)(row - MPROMPT) * DM + 4 * lane + 256 * j);
        }
    };
    int row = blockIdx.x * 8 + wave; f32x4 v[4];
    if (row < MROWS) load_row(row, v);
    while (row < MROWS) {
        const int nrow = row + gridDim.x * 8; f32x4 nv[4];
#pragma unroll
        for (int j = 0; j < 4; ++j) nv[j] = (f32x4){0.f, 0.f, 0.f, 0.f};
        if (nrow < MROWS) load_row(nrow, nv);
        float s = 0.f;
#pragma unroll
        for (int j = 0; j < 4; ++j) s += (v[j].x * v[j].x + v[j].y * v[j].y) + (v[j].z * v[j].z + v[j].w * v[j].w);
        const float rs = rsqrtf(wave_sum(s) * (1.f / DM) + EPS);
#pragma unroll
        for (int j = 0; j < 4; ++j) *(f32x4*)(Y + (size_t)row * DM + 4 * lane + 256 * j) = v[j] * rs * g[j];
#pragma unroll
        for (int j = 0; j < 4; ++j) v[j] = nv[j];
        row = nrow;
    }
}
#define RUN(ph) (((PHMASK >> (ph)) & 1) && ph_lo <= (ph) && (ph) <= ph_hi)
#define SYNC(ph) do { if (ph_lo <= (ph) && (ph) < ph_hi) { xcd_barrier(xb); } } while (0)
#define TWICE(ph, body) do { body; if ((REPMASK >> (ph)) & 1) { xcd_barrier(xb); body; } } while (0)
__device__ __forceinline__ void run_p1(const Params& p, PG8_LAS unsigned char* lds) { bf16_t* H = (bf16_t*)p.out; bf16_t* PROJ = (bf16_t*)(p.ws + WS_R1);
    pg8::StaticOrder S; S.init(MROWS, NIN, gridDim.x, blockIdx.x); pg8::Gemm g{H, (const bf16_t*)(p.ws + WS_WIN), MROWS, NIN, DM};
    EpiInProj E{PROJ, p.in[9], (float*)(p.ws + WS_GATES), p.in[11], p.in[12]}; pg8::gemm_phase(lds, g, S, E); }
__device__ __forceinline__ void run_p3(const Params& p, PG8_LAS unsigned char* lds) { bf16_t* AMIX = (bf16_t*)p.out + (size_t)MROWS * DM; bf16_t* X1B = (bf16_t*)(p.ws + WS_R1 + R1_X1B); float* X1 = (float*)(p.ws + WS_X1);
    pg8::StaticOrder S; S.init((P3_OVERLAP && gridDim.x >= 96) ? MPROMPT : MROWS, DM, gridDim.x, blockIdx.x);   pg8::Gemm g{AMIX, (const bf16_t*)(p.ws + WS_WOUT), MROWS, DM, DM};
    EpiResid E{p.in[0], p.in[1], X1, X1B, (float*)(p.ws + WS_SSQ2), nullptr}; pg8::gemm_phase(lds, g, S, E); }
struct OneUnit { int pm, pn, ntK;
    __device__ bool next(int i, Unit& u) const { if (i) return false; u.pm = pm; u.pn = pn; u.k0 = 0; u.nt = ntK; return true; }
    __device__ __forceinline__ void a_ready(const Unit&) const {}
    __device__ __forceinline__ void done(const Unit&) const {} };
__device__ __forceinline__ void run_p3_sample(const Params& p, PG8_LAS unsigned char* lds, const int j) {
    bf16_t* AMIX = (bf16_t*)p.out + (size_t)MROWS * DM; bf16_t* X1B = (bf16_t*)(p.ws + WS_R1 + R1_X1B); float* X1 = (float*)(p.ws + WS_X1);
    OneUnit S{64 + (j >> 2), j & 3, DM / 64}; pg8::Gemm g{AMIX, (const bf16_t*)(p.ws + WS_WOUT), MROWS, DM, DM};
    EpiResid E{p.in[0], p.in[1], X1, X1B, (float*)(p.ws + WS_SSQ2), nullptr}; pg8::gemm_phase(lds, g, S, E); }
__device__ __forceinline__ void phase2b(const Params& p, PG8_LAS unsigned char* lds, unsigned char* shm) {
    const int b = blockIdx.x, G = gridDim.x;
    if (G >= 96) {
        if (b < 64) { const int g = b >> 5, sqi = (b >> 2) & 7, h = b & 3; if (g == 0) chain_run<false>(p, lds, sqi, h); else chain_run<true>(p, lds, sqi, h); }
        else { for (int j = NS_A + (b - 64); j < 1024; j += G - 64) sample_dispatch(p, lds, j);
            LDS_BARRIER();
            deferred_transposes(p, shm, (b - 64) * 8 + (threadIdx.x >> 6), (G - 64) * 8);
            if (P3_OVERLAP) {
                unsigned* cnt = (unsigned*)(p.ws + WS_CTL) + 32;
                asm volatile("s_waitcnt vmcnt(0)" ::: "memory");
                __syncthreads();
                if (threadIdx.x == 0) { __builtin_amdgcn_fence(__ATOMIC_RELEASE, "agent"); asm volatile("s_waitcnt vmcnt(0)" ::: "memory");
                    __hip_atomic_fetch_add(cnt, 1u, __ATOMIC_RELAXED, __HIP_MEMORY_SCOPE_AGENT); }
                if (b < 80) {
                    if (threadIdx.x == 0) { unsigned sp = 0; const unsigned want = (unsigned)(G - 64);
                        while (__hip_atomic_load(cnt, __ATOMIC_RELAXED, __HIP_MEMORY_SCOPE_AGENT) < want) { __builtin_amdgcn_s_sleep(8); if (++sp > (1u << 22)) break; }
                        __builtin_amdgcn_fence(__ATOMIC_ACQUIRE, "agent"); asm volatile("s_waitcnt vmcnt(0)" ::: "memory"); }
                    __syncthreads();
                    run_p3_sample(p, lds, b - 64);
                }
            } }
    } else {
        for (int it = b; it < 64; it += G) { const int g = it >> 5, sqi = (it >> 2) & 7, h = it & 3; if (g == 0) chain_run<false>(p, lds, sqi, h); else chain_run<true>(p, lds, sqi, h); }
        for (int j = NS_A + b; j < 1024; j += G) sample_dispatch(p, lds, j);
        LDS_BARRIER();
        deferred_transposes(p, shm, b * 8 + (threadIdx.x >> 6), G * 8);
    }
}
__device__ __forceinline__ void run_p4(const Params& p, PG8_LAS unsigned char* lds) { bf16_t* X1B = (bf16_t*)(p.ws + WS_R1 + R1_X1B); bf16_t* ACT = (bf16_t*)(p.ws + WS_R1 + R1_ACT);
    pg8::StaticOrder S; S.init(MROWS, NGV, gridDim.x, blockIdx.x); pg8::Gemm g{X1B, (const bf16_t*)(p.ws + WS_WGV), MROWS, NGV, DM};
    EpiGateVal E{ACT, (const float*)(p.ws + WS_SSQ2), p.in[18], p.in[19], p.in[6], (float*)(p.ws + WS_UHL), (float*)(p.ws + WS_UHF), p.out + O_VP, p.out + O_VS}; pg8::gemm_phase(lds, g, S, E); }
struct DownOrder {
    pg8::StaticOrder S; int G, c;
    __device__ void init(int G_, int c_) { G = G_; c = c_; S.init(MPROMPT, DM, G_, c_, DFF); }
    __device__ bool next(int i, Unit& u) const {
        const int L = i * G + c;
        if (L < 256) { pg8::StaticOrder T = S; T.G = 256; T.c = L; return T.next(0, u); }
        const int r = L - 256; if (r >= 112) return false;
        const int s = r % 7, t = r / 7; u.pm = 64 + (t >> 2); u.pn = t & 3; u.k0 = 384 * s; u.nt = s == 6 ? 8 : 6; return true;
    }
    __device__ __forceinline__ void a_ready(const Unit&) const {}
    __device__ __forceinline__ void done(const Unit&) const {}
};
__device__ __forceinline__ void run_p6(const Params& p, PG8_LAS unsigned char* lds) { bf16_t* ACT = (bf16_t*)(p.ws + WS_R1 + R1_ACT); float* X1 = (float*)(p.ws + WS_X1);
    DownOrder S; S.init(gridDim.x, blockIdx.x); pg8::Gemm g{ACT, (const bf16_t*)(p.ws + WS_WD), MROWS, DM, DFF};
    EpiResid E{X1, X1 + (size_t)MPROMPT * DM, p.out, nullptr, nullptr, (float*)(p.ws + WS_R1 + R1_X1B)}; pg8::gemm_phase(lds, g, S, E); }
__global__ __launch_bounds__(512, 2) void fwd_kernel(Params p, int ph_lo, int ph_hi) {
    extern __shared__ __attribute__((aligned(16))) unsigned char shm[];
    PG8_LAS unsigned char* lds = (PG8_LAS unsigned char*)shm;
    cg::grid_group grid = cg::this_grid();
    volatile LAS unsigned* xst = (volatile LAS unsigned*)(lds + LDS_BYTES - 16);
    if (threadIdx.x == 0) { xst[0] = 0u; xst[1] = 0u; }
    __syncthreads();
    XcdBarrier xb = xcd_barrier_post((unsigned*)(p.ws + WS_BAR), xst);
    if (ph_lo < -1000) grid.sync();
    if (RUN(0)) TWICE(0, phase0(p, shm));
    SYNC(0);
    if (RUN(1)) TWICE(1, run_p1(p, lds));
    SYNC(1);
#if NAIVE_MIXER
    if (RUN(2)) phase2_naive(p, shm);
#else
    if (RUN(2)) { phase2a(p, lds); phase2a_samples(p, lds); xcd_barrier(xb); phase2b(p, lds, shm); }
#endif
    SYNC(2);
    if (RUN(3)) run_p3(p, lds);
    SYNC(3);
    if (RUN(4)) TWICE(4, run_p4(p, lds));
    SYNC(4);
    if (RUN(5)) TWICE(5, phase5(p));
    SYNC(5);
    if (RUN(6)) run_p6(p, lds);
    SYNC(6);
    if (RUN(7)) phase7(p);
#if EXTRA_SYNCS
    for (int i = 0; i < EXTRA_SYNCS; ++i) xcd_barrier(xb);
#endif
}
extern "C" void kernel_launch(void* const* d_in, const int* in_sizes, int n_in, void* d_out, int out_size, void* d_ws, size_t ws_size, hipStream_t stream) {
    static int grid = 0;
    if (grid == 0) {
        if (n_in != 22 || ws_size < WS_END) { fprintf(stderr, "kernel_launch: unexpected n_in %d / ws_size %zu (need %zu)\n", n_in, ws_size, (size_t)WS_END); grid = -1; return; }
        int dev = 0, cus = 0, per_cu = 0;
        hipGetDevice(&dev); hipDeviceGetAttribute(&cus, hipDeviceAttributeMultiprocessorCount, dev);
        if (hipFuncSetAttribute((const void*)fwd_kernel, hipFuncAttributeMaxDynamicSharedMemorySize, LDS_BYTES) != hipSuccess) { fprintf(stderr, "kernel_launch: hipFuncSetAttribute failed\n"); grid = -1; return; }
        if (hipOccupancyMaxActiveBlocksPerMultiprocessor(&per_cu, (const void*)fwd_kernel, 512, LDS_BYTES) != hipSuccess || per_cu < 1) { fprintf(stderr, "kernel_launch: occupancy query says %d blocks per CU\n", per_cu); per_cu = 1; }
        (void)hipGetLastError();
        grid = cus;
        fprintf(stderr, "kernel_launch: cus %d per_cu %d grid %d ws %zu\n", cus, per_cu, grid, ws_size);
    }
    if (grid < 0) return;
    Params p{};
    for (int i = 0; i < 22; ++i) p.in[i] = (const float*)d_in[i];
    p.out = (float*)d_out; p.ws = (unsigned char*)d_ws;
    if (hipMemsetAsync((char*)d_ws + WS_BAR, 0, 16384, stream) != hipSuccess) { fprintf(stderr, "kernel_launch: memset of the barrier words failed\n"); return; }
#if ONE_LAUNCH
    int lo = 0, hi = 7; void* args[] = {&p, &lo, &hi};
    hipError_t e = hipLaunchCooperativeKernel((const void*)fwd_kernel, dim3(grid), dim3(512), args, LDS_BYTES, stream);
    if (e != hipSuccess) fprintf(stderr, "cooperative launch failed: %s (grid %d)\n", hipGetErrorString(e), grid);
#else
    for (int ph = 0; ph < 8; ++ph) hipLaunchKernelGGL(fwd_kernel, dim3(grid), dim3(512), LDS_BYTES, stream, p, ph, ph);
#endif
}
```

```cpp
#include <hip/hip_runtime.h>
#include <hip/hip_cooperative_groups.h>
#include <cstdio>
#include <cstdint>
namespace cg = cooperative_groups;
#ifndef ONE_LAUNCH
#define ONE_LAUNCH 1
#endif
#ifndef PHMASK
#define PHMASK 255
#endif
#ifndef NAIVE_MIXER
#define NAIVE_MIXER 0
#endif
#ifndef REPMASK
#define REPMASK 0
#endif
#ifndef EXTRA_SYNCS
#define EXTRA_SYNCS 0
#endif
#ifndef P3_OVERLAP
#define P3_OVERLAP 1
#endif
namespace pg8 {
#define PG8_LAS __attribute__((address_space(3)))
typedef unsigned short bf16_t;
typedef short bf16x8 __attribute__((ext_vector_type(8)));
typedef float f32x4 __attribute__((ext_vector_type(4)));
typedef unsigned u32x4 __attribute__((ext_vector_type(4)));
constexpr int BM = 256, BK = 64, HALF = 128, HTB = HALF * BK * 2  , STAGE_BYTES = 8 * HTB, NXCD = 8, WGM = 8;

__host__ __device__ __forceinline__ int lds_byte(int r, int c) { const int st = (r >> 4) * 2 + (c >> 5), rr = r & 15, cc = c & 31, ob = rr * 64 + cc * 2; return st * 1024 + (ob ^ (((ob >> 9) & 1) << 5)); }
__host__ __device__ __forceinline__ void stage_rc(int b, int& R, int& C) { const int st = b / 1024, sb = b % 1024, swz = sb ^ (((sb >> 9) & 1) << 5); R = (st >> 1) * 16 + swz / 64; C = (st & 1) * 32 + (swz % 64) / 2; }
__host__ __device__ __forceinline__ int perm32(int rho) { const int n = rho >> 4, i = rho & 15; return 8 * (i >> 2) + 4 * n + (i & 3); }

struct Unit { int pm, pn, k0, nt; };
struct Gemm { const bf16_t* A; const bf16_t* Bt; int M, N, K; };

struct StaticOrder {
    int nM, nN, nwg, G, c, ntK;
    __host__ __device__ void init(int M, int N, int G_, int c_, int K_ = 1024) { nM = M / BM; nN = N / BM; nwg = nM * nN; G = G_; c = c_; ntK = K_ / BK; }
    __host__ __device__ bool next(int i, Unit& u) const {
        const long L = (long)i * G + c; if (L >= nwg) return false;
        int wgid = (int)L; { const int q = nwg / NXCD, r = nwg % NXCD, xcd = wgid % NXCD, off = wgid / NXCD; wgid = (xcd < r ? xcd * (q + 1) : r * (q + 1) + (xcd - r) * q) + off; }
        const int nig = WGM * nN, gid = wgid / nig, fm = gid * WGM, gsz = (nM - fm) < WGM ? (nM - fm) : WGM;
        u.pm = fm + ((wgid % nig) % gsz); u.pn = (wgid % nig) / gsz; u.k0 = 0; u.nt = ntK; return true;
    }
    __device__ __forceinline__ void a_ready(const Unit&) const {}
    __device__ __forceinline__ void done(const Unit&) const {}
};

typedef float f32x2_t __attribute__((ext_vector_type(2)));
typedef __bf16 bf16x2_t __attribute__((ext_vector_type(2)));
__device__ __forceinline__ unsigned cvt_pk_bf16(float lo, float hi) { const f32x2_t v = {lo, hi}; return __builtin_bit_cast(unsigned, __builtin_convertvector(v, bf16x2_t)); }
template <class Epi, class Sched>
__device__ __forceinline__ void gemm_phase(PG8_LAS unsigned char* lds, const Gemm g, const Sched& S, const Epi& E) {
    const int tid = threadIdx.x, wid = __builtin_amdgcn_readfirstlane(tid >> 6), lane = tid & 63, wr = wid >> 2, wc = wid & 3, fr = lane & 15, fq = lane >> 4;
    const int K = g.K;
    unsigned voffA[2], voffB[2];
#pragma unroll
    for (int i = 0; i < 2; ++i) { int R, C; stage_rc(tid * 16 + i * 8192, R, C); const int Rb = Epi::PERM ? ((R & ~31) + perm32(R & 31)) : R;
        voffA[i] = (unsigned)(R * K + C) * 2u; voffB[i] = (unsigned)(Rb * K + C) * 2u; }
    const size_t kstep = (size_t)(BK * 2);
    const size_t hstep = (size_t)HALF * K * 2;
    const size_t tstep = 2 * hstep;
    const unsigned ldsw = (unsigned)wid * 1024u;
    const int aoff = lds_byte(wr * 64 + fr, fq * 8), boff = lds_byte(wc * 32 + fr, fq * 8);
#define PG8_SA(b, h) (((b) * 2 + (h)) * HTB)
#define PG8_SB(b, h) ((4 + (b) * 2 + (h)) * HTB)
#define PG8_STAGE(bufoff, gbase, voff) do { _Pragma("unroll") for (int _i = 0; _i < 2; ++_i) \
        __builtin_amdgcn_global_load_lds((const unsigned*)((const char*)(gbase) + (voff)[_i]), (PG8_LAS unsigned*)(lds + (bufoff) + ldsw + _i * 8192), 16, 0, 0); } while (0)
#define PG8_LDA(dst, b, h) do { _Pragma("unroll") for (int m = 0; m < 4; ++m) _Pragma("unroll") for (int k = 0; k < 2; ++k) dst[m][k] = *(const PG8_LAS bf16x8*)(lds + PG8_SA(b, h) + aoff + m * 2048 + k * 1024); } while (0)
#define PG8_LDB(dst, b, h) do { _Pragma("unroll") for (int n = 0; n < 2; ++n) _Pragma("unroll") for (int k = 0; k < 2; ++k) dst[n][k] = *(const PG8_LAS bf16x8*)(lds + PG8_SB(b, h) + boff + n * 2048 + k * 1024); } while (0)
#define PG8_MMA(ai, bj, At, Bt) do { __builtin_amdgcn_s_setprio(1); _Pragma("unroll") for (int m = 0; m < 4; ++m) _Pragma("unroll") for (int n = 0; n < 2; ++n) _Pragma("unroll") for (int k = 0; k < 2; ++k) \
        acc[ai][bj][m][n] = __builtin_amdgcn_mfma_f32_16x16x32_bf16(Bt[n][k], At[m][k], acc[ai][bj][m][n], 0, 0, 0); __builtin_amdgcn_s_setprio(0); } while (0)
#define PG8_WAIT_V(n) asm volatile("s_waitcnt vmcnt(" #n ")" ::: "memory")
#define PG8_WAIT_L(n) asm volatile("s_waitcnt lgkmcnt(" #n ")" ::: "memory")
#define PG8_BAR __builtin_amdgcn_s_barrier()
#define PG8_SCHED __builtin_amdgcn_sched_barrier(0)
    Unit cur, nxt; int ui = 0;
    if (!S.next(0, cur)) return;
    f32x4 acc[2][2][4][2];
#pragma unroll
    for (int a = 0; a < 2; ++a)
#pragma unroll
        for (int b = 0; b < 2; ++b)
#pragma unroll
            for (int m = 0; m < 4; ++m)
#pragma unroll
                for (int n = 0; n < 2; ++n) acc[a][b][m][n] = (f32x4){0.f, 0.f, 0.f, 0.f};
    bf16x8 At[4][2], B0[2][2], B1[2][2];
    const char* cA = (const char*)g.A + (size_t)cur.pm * tstep + (size_t)cur.k0 * 2; const char* cB = (const char*)g.Bt + (size_t)cur.pn * tstep + (size_t)cur.k0 * 2;
    S.a_ready(cur);
    PG8_STAGE(PG8_SB(0, 0), cB, voffB); PG8_STAGE(PG8_SA(0, 0), cA, voffA); PG8_STAGE(PG8_SB(0, 1), cB + hstep, voffB); PG8_STAGE(PG8_SA(0, 1), cA + hstep, voffA);
    if (wr == 1) PG8_BAR;
    PG8_WAIT_V(4); PG8_BAR;
    PG8_STAGE(PG8_SB(1, 0), cB + kstep, voffB); PG8_STAGE(PG8_SA(1, 0), cA + kstep, voffA); PG8_STAGE(PG8_SB(1, 1), cB + hstep + kstep, voffB);
    PG8_WAIT_V(6); PG8_BAR;
    for (;;) {
        const bool has_next = S.next(ui + 1, nxt);
        const char* nA = has_next ? (const char*)g.A + (size_t)nxt.pm * tstep + (size_t)nxt.k0 * 2 : cA; const char* nB = has_next ? (const char*)g.Bt + (size_t)nxt.pn * tstep + (size_t)nxt.k0 * 2 : cB;
        const int nt = cur.nt;
        for (int t = 0; t < nt; t += 2) {
            const bool last = (t == nt - 2);
            const char* a1 = cA + (size_t)(t + 1) * kstep;
            const char* a2 = last ? nA : cA + (size_t)(t + 2) * kstep; const char* b2 = last ? nB : cB + (size_t)(t + 2) * kstep;
            const char* a3 = a2 + kstep; const char* b3 = b2 + kstep;
            if (last && has_next) S.a_ready(nxt);
            PG8_LDB(B0, 0, 0); PG8_SCHED; PG8_LDA(At, 0, 0); PG8_STAGE(PG8_SA(1, 1), a1 + hstep, voffA);
            PG8_WAIT_L(8); PG8_BAR; PG8_WAIT_L(0); PG8_MMA(0, 0, At, B0); PG8_BAR; PG8_SCHED;
            PG8_LDB(B1, 0, 1); PG8_STAGE(PG8_SB(0, 0), b2, voffB);
            PG8_BAR; PG8_WAIT_L(0); PG8_MMA(0, 1, At, B1); PG8_BAR;
            PG8_LDA(At, 0, 1); PG8_STAGE(PG8_SA(0, 0), a2, voffA);
            PG8_BAR; PG8_WAIT_L(0); PG8_MMA(1, 0, At, B0); PG8_BAR; PG8_SCHED;
            PG8_STAGE(PG8_SB(0, 1), b2 + hstep, voffB);
            PG8_WAIT_V(6); PG8_BAR; PG8_MMA(1, 1, At, B1); PG8_BAR;
            PG8_LDB(B0, 1, 0); PG8_SCHED; PG8_LDA(At, 1, 0); PG8_STAGE(PG8_SA(0, 1), a2 + hstep, voffA);
            PG8_WAIT_L(8); PG8_BAR; PG8_WAIT_L(0); PG8_MMA(0, 0, At, B0); PG8_BAR; PG8_SCHED;
            PG8_LDB(B1, 1, 1); PG8_STAGE(PG8_SB(1, 0), b3, voffB);
            PG8_BAR; PG8_WAIT_L(0); PG8_MMA(0, 1, At, B1); PG8_BAR;
            PG8_LDA(At, 1, 1); PG8_STAGE(PG8_SA(1, 0), a3, voffA);
            PG8_BAR; PG8_WAIT_L(0); PG8_MMA(1, 0, At, B0); PG8_BAR; PG8_SCHED;
            PG8_STAGE(PG8_SB(1, 1), b3 + hstep, voffB);
            PG8_WAIT_V(6); PG8_BAR; PG8_MMA(1, 1, At, B1); PG8_BAR;
        }
        if constexpr (!Epi::AFTER_DRAIN) { E(acc, cur, wr, wc, fr, fq); S.done(cur); }
        if (!has_next) break;
#pragma unroll
        for (int a = 0; a < 2; ++a)
#pragma unroll
            for (int b = 0; b < 2; ++b)
#pragma unroll
                for (int m = 0; m < 4; ++m)
#pragma unroll
                    for (int n = 0; n < 2; ++n) acc[a][b][m][n] = (f32x4){0.f, 0.f, 0.f, 0.f};
        cur = nxt; cA = nA; cB = nB; ++ui;
    }
    PG8_WAIT_V(0);
    if (wr == 0) PG8_BAR;
    PG8_BAR;
    if constexpr (Epi::AFTER_DRAIN) { E.fused(acc, cur, wr, wc, fr, fq, lds, wid, lane); S.done(cur); }
#undef PG8_SA
#undef PG8_SB
#undef PG8_STAGE
#undef PG8_LDA
#undef PG8_LDB
#undef PG8_MMA
#undef PG8_WAIT_V
#undef PG8_WAIT_L
#undef PG8_BAR
#undef PG8_SCHED
}

}
#define XB_TMO      128
#define XB_XCNT(j)  (256  + 64 * (j))
#define XB_XSUB(j)  (1280 + 64 * (j))
#define XB_XGEN(j)  (2304 + 64 * (j))
#define XB_TOP      3328
#define XB_TOPGEN   3392
#define XCD_BAR_WORDS 3456
#define XB_SPIN_CAP (1u << 18)
#ifndef LAS
#define LAS __attribute__((address_space(3)))
#endif

__device__ __forceinline__ unsigned xb_ld(unsigned* p)              { return __hip_atomic_load(p, __ATOMIC_RELAXED, __HIP_MEMORY_SCOPE_AGENT); }
__device__ __forceinline__ unsigned xb_add(unsigned* p, unsigned v) { return __hip_atomic_fetch_add(p, v, __ATOMIC_RELAXED, __HIP_MEMORY_SCOPE_AGENT); }
__device__ __forceinline__ unsigned xb_xcc_id() { return (unsigned)__builtin_amdgcn_s_getreg((3 << 11) | 20) & 0xFu; }
#define XB_SPIN(cond, bar) do { unsigned _sp = 0; while (cond) { __builtin_amdgcn_s_sleep(1); \
    if ((++_sp & 255u) == 0u) { if (xb_ld(&(bar)[XB_TMO])) break; if (_sp > XB_SPIN_CAP) { atomicAdd(&(bar)[XB_TMO], 1u); break; } } } } while (0)

struct XcdBarrier {
    unsigned* bar; unsigned x;
    volatile LAS unsigned* st;
};

__device__ __forceinline__ XcdBarrier xcd_barrier_post(unsigned* bar, volatile LAS unsigned* st) {
    XcdBarrier b; b.bar = bar; b.x = xb_xcc_id(); b.st = st;
    if (threadIdx.x == 0) (void)xb_add(&bar[XB_XCNT(b.x)], 1u);
    return b;
}
__device__ __forceinline__ void xcd_barrier_complete(unsigned* bar, unsigned x, unsigned& nloc, unsigned& nx) {
    const unsigned G = gridDim.x * gridDim.y * gridDim.z;
    unsigned sum, cnt, mine, sp = 0u;
    for (;;) {
        sum = 0u; cnt = 0u; mine = 0u;
#pragma unroll
        for (unsigned j = 0; j < 16; ++j) { const unsigned c = xb_ld(&bar[XB_XCNT(j)]); sum += c; cnt += (c > 0u) ? 1u : 0u; mine = (j == x) ? c : mine; }
        if (sum == G) break;
        __builtin_amdgcn_s_sleep(1);
        if ((++sp & 255u) == 0u) { if (xb_ld(&bar[XB_TMO])) break; if (sp > XB_SPIN_CAP) { atomicAdd(&bar[XB_TMO], 1u); break; } }
    }
    nloc = mine > 0u ? mine : 1u; nx = cnt > 0u ? cnt : 1u;
}

__device__ __forceinline__ void xcd_barrier(const XcdBarrier& b) {
    asm volatile("s_waitcnt vmcnt(0)" ::: "memory");
    __syncthreads();
    if (threadIdx.x == 0) {
        unsigned* bar = b.bar;
        __builtin_amdgcn_s_waitcnt(0);
        unsigned nloc = b.st[0], nx = b.st[1];
        if (nloc == 0u) { xcd_barrier_complete(bar, b.x, nloc, nx); b.st[0] = nloc; b.st[1] = nx; }
        const unsigned old = xb_add(&bar[XB_XSUB(b.x)], 1u);
        const unsigned gen = old / nloc;
        if (old + 1u == (gen + 1u) * nloc) {
            __builtin_amdgcn_fence(__ATOMIC_RELEASE, "agent");
            asm volatile("s_waitcnt vmcnt(0)" ::: "memory");
            const unsigned og = xb_add(&bar[XB_TOP], 1u);
            const unsigned tg = og / nx;
            if (og + 1u == (tg + 1u) * nx) xb_add(&bar[XB_TOPGEN], 1u);
            else XB_SPIN(xb_ld(&bar[XB_TOPGEN]) == tg, bar);
            __builtin_amdgcn_fence(__ATOMIC_ACQUIRE, "agent");
            xb_add(&bar[XB_XGEN(b.x)], 1u);
            asm volatile("s_waitcnt vmcnt(0)" ::: "memory");
        } else {
            XB_SPIN(xb_ld(&bar[XB_XGEN(b.x)]) == gen, bar);
            __builtin_amdgcn_fence(__ATOMIC_ACQUIRE, "agent");
            asm volatile("s_waitcnt vmcnt(0)" ::: "memory");
        }
    }
    __syncthreads();
}

using pg8::bf16_t; using pg8::f32x4; using pg8::u32x4; using pg8::Unit; using pg8::cvt_pk_bf16;
typedef unsigned u32x2 __attribute__((ext_vector_type(2)));
constexpr int DM = 1024, MROWS = 17408, MPROMPT = 16384, NPROJ = 4096, INCOLS = 4104, DFF = 2816, NGV = 5632;
constexpr float EPS = 1e-6f;
constexpr size_t O_Y = 0, O_SP = 17825792, O_SS = 18350080, O_CP = 26738688, O_CS = 27262976, O_NP = 35651584, O_NS = 35655680,
                 O_MP = 35721216, O_MS = 35721248, O_VP = 35721760, O_VS = 35766816;
constexpr int NIN = 4352;
constexpr size_t WS_CTL = 0, WS_WIN = 4096, WS_WOUT = WS_WIN + (size_t)NIN * 1024 * 2, WS_WGV = WS_WOUT + 1024 * 1024 * 2, WS_WD = WS_WGV + 5632 * 1024 * 2,
                 WS_GATES = WS_WD + 1024 * 2816 * 2, WS_SSQ2 = WS_GATES + 17408 * 32, WS_SSQ3 = WS_SSQ2 + 17408 * 4, WS_UHL = WS_SSQ3 + 17408 * 4, WS_UHF = WS_UHL + 256 * 2 * 2816 * 4,
                 WS_X1 = WS_UHF + 256 * 4 * 2816 * 4, WS_R1 = WS_X1 + (size_t)17408 * 1024 * 4, WS_BAR = WS_R1 + (size_t)17408 * 4096 * 2, WS_END = WS_BAR + 16384;
static_assert(WS_END <= 268435456, "workspace budget");
constexpr size_t R1_ACT = 0, R1_X1B = (size_t)16384 * 6144;
static_assert((size_t)17408 * 2816 * 2 <= R1_X1B && R1_X1B + (size_t)17408 * 1024 * 2 <= (size_t)17408 * 4096 * 2, "R1 layout");
constexpr int LDS_BYTES = 160 * 1024 - 2048;

struct Params { const float* in[22]; float* out; unsigned char* ws; };

__device__ __forceinline__ float bf2f(unsigned short b) { return __uint_as_float(((unsigned)b) << 16); }
__device__ __forceinline__ unsigned short f2bf(float f) { unsigned u = __float_as_uint(f); u += 0x7fffu + ((u >> 16) & 1u); return (unsigned short)(u >> 16); }
__device__ __forceinline__ float wave_sum(float v) {
#pragma unroll
    for (int o = 1; o < 64; o <<= 1) v += __shfl_xor(v, o);
    return v;
}
__device__ __forceinline__ float sigmoidf_(float x) { return __builtin_amdgcn_rcpf(1.0f + __expf(-x)); }

__device__ __forceinline__ void p0_transpose_item(const float* W, int ldw, int K, bf16_t* WT, int drow0, int k0, int n0, int nmax, const float* kscale, float* scr, int lane) {
    const int ncol = min(n0 + (lane & 31), nmax);
    float v[32];
#pragma unroll
    for (int i = 0; i < 32; ++i) v[i] = W[(size_t)(k0 + 2 * i + (lane >> 5)) * ldw + ncol];
    if (kscale) {
#pragma unroll
        for (int i = 0; i < 32; ++i) v[i] *= kscale[k0 + 2 * i + (lane >> 5)]; }
#pragma unroll
    for (int i = 0; i < 32; ++i) scr[(2 * i + (lane >> 5)) * 33 + (lane & 31)] = v[i];
    asm volatile("s_waitcnt lgkmcnt(0)" ::: "memory");
    const int c = lane & 7;
#pragma unroll
    for (int j = 0; j < 4; ++j) { const int n = (lane >> 3) + 8 * j; const float* s = scr + (8 * c) * 33 + n;
        u32x4 o; o.x = cvt_pk_bf16(s[0 * 33], s[1 * 33]); o.y = cvt_pk_bf16(s[2 * 33], s[3 * 33]); o.z = cvt_pk_bf16(s[4 * 33], s[5 * 33]); o.w = cvt_pk_bf16(s[6 * 33], s[7 * 33]);
        *(u32x4*)(WT + (size_t)(drow0 + n) * K + k0 + 8 * c) = o; }
    asm volatile("s_waitcnt lgkmcnt(0)" ::: "memory");
}

__device__ __forceinline__ void phase0(const Params& p, unsigned char* shm) {
    const int tid = threadIdx.x, wave = tid >> 6, lane = tid & 63;
    float* scr = (float*)(shm + wave * 8704);
    const int gw = blockIdx.x * 8 + wave, NGW = gridDim.x * 8;
    bf16_t* WinT = (bf16_t*)(p.ws + WS_WIN); bf16_t* WoutT = (bf16_t*)(p.ws + WS_WOUT);
    { float* z = (float*)(p.ws + WS_SSQ2); for (int i = blockIdx.x * 512 + tid; i < 2 * MROWS; i += gridDim.x * 512) z[i] = 0.f; }
    if (blockIdx.x == 0 && tid < 64) ((unsigned*)(p.ws + WS_CTL))[tid] = 0u;
    bf16_t* H = (bf16_t*)p.out;
    {   f32x4 g1[4];
#pragma unroll
        for (int j = 0; j < 4; ++j) g1[j] = *(const f32x4*)(p.in[7] + 4 * lane + 256 * j);
        int row = gw; f32x4 v[4];
        if (row < MROWS) { const float* xr = row < MPROMPT ? p.in[0] + (size_t)row * DM : p.in[1] + (size_t)(row - MPROMPT) * DM;
#pragma unroll
            for (int j = 0; j < 4; ++j) v[j] = *(const f32x4*)(xr + 4 * lane + 256 * j); }
        while (row < MROWS) {
            const int nrow = row + NGW; f32x4 nv[4];
#pragma unroll
            for (int j = 0; j < 4; ++j) nv[j] = (f32x4){0.f, 0.f, 0.f, 0.f};
            if (nrow < MROWS) { const float* xr = nrow < MPROMPT ? p.in[0] + (size_t)nrow * DM : p.in[1] + (size_t)(nrow - MPROMPT) * DM;
#pragma unroll
                for (int j = 0; j < 4; ++j) nv[j] = *(const f32x4*)(xr + 4 * lane + 256 * j); }
            float s = 0.f;
#pragma unroll
            for (int j = 0; j < 4; ++j) s += (v[j].x * v[j].x + v[j].y * v[j].y) + (v[j].z * v[j].z + v[j].w * v[j].w);
            const float rs = rsqrtf(wave_sum(s) * (1.f / DM) + EPS);
#pragma unroll
            for (int j = 0; j < 4; ++j) { const f32x4 o = v[j] * rs * g1[j];
                *(u32x2*)(H + (size_t)row * DM + 4 * lane + 256 * j) = (u32x2){cvt_pk_bf16(o.x, o.y), cvt_pk_bf16(o.z, o.w)}; }
#pragma unroll
            for (int j = 0; j < 4; ++j) v[j] = nv[j];
            row = nrow;
        }
    }
    constexpr int I_IN = 16 * 129, I_OUT = 16 * 32, NIT = I_IN + I_OUT;
    for (int it = gw; it < NIT; it += NGW) {
        int r = it;
        if (r < I_IN) { const int kb = r / 129, nb = r % 129; p0_transpose_item(p.in[8], INCOLS, DM, WinT, 32 * nb, 64 * kb, 32 * nb, INCOLS - 1, nullptr, scr, lane); continue; } r -= I_IN;
        { const int kb = r / 32, nb = r % 32; p0_transpose_item(p.in[14], DM, DM, WoutT, 32 * nb, 64 * kb, 32 * nb, DM - 1, nullptr, scr, lane); }
    }
}
__device__ __forceinline__ void deferred_transposes(const Params& p, unsigned char* shm, const int widx, const int nw) {
    const int wave = threadIdx.x >> 6, lane = threadIdx.x & 63;
    float* scr = (float*)(shm + wave * 8704);
    bf16_t* WgvT = (bf16_t*)(p.ws + WS_WGV); bf16_t* WdT = (bf16_t*)(p.ws + WS_WD);
    constexpr int I_G = 16 * 88, I_D = 44 * 32, NIT = 2 * I_G + I_D;
    for (int it = widx; it < NIT; it += nw) {
        int r = it;
        if (r < I_G) { const int kb = r / 88, nb = r % 88, n0 = 32 * nb; p0_transpose_item(p.in[16], DFF, DM, WgvT, 256 * (n0 >> 7) + (n0 & 127), 64 * kb, n0, DFF - 1, p.in[15], scr, lane); continue; } r -= I_G;
        if (r < I_G) { const int kb = r / 88, nb = r % 88, n0 = 32 * nb; p0_transpose_item(p.in[17], DFF, DM, WgvT, 256 * (n0 >> 7) + 128 + (n0 & 127), 64 * kb, n0, DFF - 1, p.in[15], scr, lane); continue; } r -= I_G;
        { const int kb = r / 32, nb = r % 32; p0_transpose_item(p.in[20], DM, DFF, WdT, 32 * nb, 64 * kb, 32 * nb, DM - 1, nullptr, scr, lane); }
    }
}
struct EpiInProj {
    static constexpr bool PERM = true, AFTER_DRAIN = false;
    bf16_t* O; const float* lbl; float* gates; const float* b_ig; const float* b_fg;
    __device__ __forceinline__ void operator()(const f32x4 (&acc)[2][2][4][2], const Unit& u, int wr, int wc, int fr, int fq) const {
        const int seg = u.pn >> 1, row0 = u.pm * 256 + wr * 64 + fr, col0 = u.pn * 256 + wc * 32 + 8 * fq;
        if (seg == 8) {
            if (wc == 0 && fq == 0) {
                float bi[4], bf_[4];
#pragma unroll
                for (int e = 0; e < 4; ++e) { bi[e] = b_ig[e]; bf_[e] = b_fg[e]; }
#pragma unroll
                for (int ai = 0; ai < 2; ++ai)
#pragma unroll
                    for (int m = 0; m < 4; ++m) { float* gp = gates + (size_t)(row0 + ai * 128 + m * 16) * 8; f32x4 a = acc[ai][0][m][0], b = acc[ai][0][m][1];
#pragma unroll
                        for (int e = 0; e < 4; ++e) { a[e] += bi[e]; const float z = b[e] + bf_[e]; b[e] = z > 0.f ? -log1pf(__expf(-z)) : z - log1pf(__expf(z)); }
                        *(f32x4*)gp = a; *(f32x4*)(gp + 4) = b; }
            }
            return;
        }
        float lb[2][8];
        if (seg == 1) {
#pragma unroll
            for (int bj = 0; bj < 2; ++bj)
#pragma unroll
                for (int e = 0; e < 8; ++e) { const int c = col0 + bj * 128 + e - 512; lb[bj][e] = __builtin_amdgcn_rcpf(1.0f + __expf(lbl[512 + c] - lbl[c])); }
        }
#pragma unroll
        for (int ai = 0; ai < 2; ++ai)
#pragma unroll
            for (int m = 0; m < 4; ++m) { bf16_t* rowp = O + (size_t)(row0 + ai * 128 + m * 16) * NPROJ + col0;
#pragma unroll
                for (int bj = 0; bj < 2; ++bj) { float v[8];
#pragma unroll
                    for (int e = 0; e < 8; ++e) v[e] = acc[ai][bj][m][e >> 2][e & 3];
                    if (seg == 1) {
#pragma unroll
                        for (int e = 0; e < 8; ++e) v[e] = __logf(lb[bj][e] + (1.0f - lb[bj][e]) * sigmoidf_(v[e]));
                    } else if (seg == 3) {
#pragma unroll
                        for (int e = 0; e < 8; ++e) v[e] = v[e] * sigmoidf_(v[e]);
                    } else if (seg == 5) {
#pragma unroll
                        for (int e = 0; e < 8; ++e) v[e] = v[e] * 0.08838834764831845f;
                    } else if (seg == 7) {
#pragma unroll
                        for (int e = 0; e < 8; ++e) v[e] = sigmoidf_(v[e]);
                    }
                    u32x4 w; w.x = cvt_pk_bf16(v[0], v[1]); w.y = cvt_pk_bf16(v[2], v[3]); w.z = cvt_pk_bf16(v[4], v[5]); w.w = cvt_pk_bf16(v[6], v[7]);
                    *(u32x4*)(rowp + bj * 128) = w; } }
    }
};
struct EpiResid {
    static constexpr bool PERM = true, AFTER_DRAIN = false;
    const float* base_p; const float* base_s;
    float* out; bf16_t* outb; float* ssq; float* part;
    __device__ __forceinline__ void operator()(const f32x4 (&acc)[2][2][4][2], const Unit& u, int wr, int wc, int fr, int fq) const {
        const int row0 = u.pm * 256 + wr * 64 + fr, col0 = u.pn * 256 + wc * 32 + 8 * fq;
        if (part && u.pm >= 64) { float* pp = part + (size_t)(u.k0 / 384) * (1024 * DM) - (size_t)MPROMPT * DM;
#pragma unroll
            for (int ai = 0; ai < 2; ++ai)
#pragma unroll
                for (int m = 0; m < 4; ++m) { const size_t off = (size_t)(row0 + ai * 128 + m * 16) * DM + col0;
#pragma unroll
                    for (int bj = 0; bj < 2; ++bj) { *(f32x4*)(pp + off + bj * 128) = acc[ai][bj][m][0]; *(f32x4*)(pp + off + bj * 128 + 4) = acc[ai][bj][m][1]; } }
            return; }
        const float* base = u.pm < 64 ? base_p : base_s - (size_t)MPROMPT * DM;
#pragma unroll
        for (int ai = 0; ai < 2; ++ai)
#pragma unroll
            for (int m = 0; m < 4; ++m) { const int row = row0 + ai * 128 + m * 16; const size_t off = (size_t)row * DM + col0; float ss = 0.f;
#pragma unroll
                for (int bj = 0; bj < 2; ++bj) { const f32x4 xa = *(const f32x4*)(base + off + bj * 128), xb = *(const f32x4*)(base + off + bj * 128 + 4);
                    const f32x4 v0 = acc[ai][bj][m][0] + xa, v1 = acc[ai][bj][m][1] + xb;
                    *(f32x4*)(out + off + bj * 128) = v0; *(f32x4*)(out + off + bj * 128 + 4) = v1;
                    if (outb) { u32x4 w; w.x = cvt_pk_bf16(v0[0], v0[1]); w.y = cvt_pk_bf16(v0[2], v0[3]); w.z = cvt_pk_bf16(v1[0], v1[1]); w.w = cvt_pk_bf16(v1[2], v1[3]); *(u32x4*)(outb + off + bj * 128) = w; }
                    ss += (v0[0] * v0[0] + v0[1] * v0[1]) + (v0[2] * v0[2] + v0[3] * v0[3]) + (v1[0] * v1[0] + v1[1] * v1[1]) + (v1[2] * v1[2] + v1[3] * v1[3]); }
                if (ssq) { ss += __shfl_xor(ss, 16); ss += __shfl_xor(ss, 32); if (fq == 0) atomicAdd(ssq + row, ss); } }
    }
};
typedef float f32x2v __attribute__((ext_vector_type(2)));
__device__ __forceinline__ float gelu_tanh(float x) { const float z = 0.7978845608028654f * (x + 0.044715f * x * x * x); return x * __builtin_amdgcn_rcpf(1.0f + __expf(-2.0f * z)); }
template <int CTRL> __device__ __forceinline__ float dpp_f(float old, float src) {
    return __builtin_bit_cast(float, __builtin_amdgcn_update_dpp(__builtin_bit_cast(int, old), __builtin_bit_cast(int, src), CTRL, 0xf, 0xf, false)); }
struct EpiGateVal {
    static constexpr bool PERM = true, AFTER_DRAIN = false;
    bf16_t* ACT; const float* ssq2; const float* conv_w; const float* conv_b; const float* state_conv; float* UHL; float* UHF; float* out_vp; float* out_vs;
    __device__ __forceinline__ void operator()(const f32x4 (&acc)[2][2][4][2], const Unit& u, int wr, int wc, int fr, int fq) const {
        const int lane = threadIdx.x & 63;
        const int c0 = u.pn * 128 + wc * 32 + 8 * fq;
        float w0[8], w1[8], w2[8], cb[8];
#pragma unroll
        for (int e = 0; e < 8; ++e) { w0[e] = conv_w[c0 + e]; w1[e] = conv_w[DFF + c0 + e]; w2[e] = conv_w[2 * DFF + c0 + e]; cb[e] = conv_b[c0 + e]; }
        const bool sample = u.pm >= 64;
#pragma unroll
        for (int ai = 0; ai < 2; ++ai) {
            float uprev[8];
#pragma unroll
            for (int e = 0; e < 8; ++e) uprev[e] = 0.f;
#pragma unroll
            for (int m = 0; m < 4; ++m) { const int row = u.pm * 256 + ai * 128 + wr * 64 + m * 16 + fr;
                const float rs = rsqrtf(ssq2[row] * (1.f / DM) + EPS);
                float uu[8], vv[8], r1[8], r2[8];
#pragma unroll
                for (int e = 0; e < 8; ++e) { uu[e] = acc[ai][0][m][e >> 2][e & 3] * rs; vv[e] = acc[ai][1][m][e >> 2][e & 3] * rs; }
#pragma unroll
                for (int e = 0; e < 8; ++e) { r1[e] = dpp_f<0x111>(dpp_f<0x10F>(0.f, uprev[e]), uu[e]); r2[e] = dpp_f<0x112>(dpp_f<0x10E>(0.f, uprev[e]), uu[e]); }
                float p1[8], p2[8]; bool valid = true;
                if (!sample) {
#pragma unroll
                    for (int e = 0; e < 8; ++e) { p1[e] = r1[e]; p2[e] = r2[e]; }
                    if (m == 0 && fr < 2) { valid = false; const int gi = row >> 6; float* d = UHF + ((size_t)(gi * 2 + fr) * 2) * DFF + c0;
                        *(f32x4*)d = (f32x4){uu[0], uu[1], uu[2], uu[3]}; *(f32x4*)(d + 4) = (f32x4){uu[4], uu[5], uu[6], uu[7]};
                        *(f32x4*)(d + DFF) = (f32x4){vv[0], vv[1], vv[2], vv[3]}; *(f32x4*)(d + DFF + 4) = (f32x4){vv[4], vv[5], vv[6], vv[7]}; }
                    if (m == 3 && fr >= 14) { const int gi = row >> 6; float* d = UHL + (size_t)(gi * 2 + (fr - 14)) * DFF + c0;
                        *(f32x4*)d = (f32x4){uu[0], uu[1], uu[2], uu[3]}; *(f32x4*)(d + 4) = (f32x4){uu[4], uu[5], uu[6], uu[7]};
                        if ((row & 2047) >= 2046) { float* o = out_vp + (size_t)((row >> 11) * 2 + (fr - 14)) * DFF + c0;
                            *(f32x4*)o = (f32x4){uu[0], uu[1], uu[2], uu[3]}; *(f32x4*)(o + 4) = (f32x4){uu[4], uu[5], uu[6], uu[7]}; } }
                } else {
                    const int pos = fr & 7, b = (row - MPROMPT) >> 3; const float* sc = state_conv + (size_t)b * 2 * DFF + c0;
                    float b0[8], b1[8];
#pragma unroll
                    for (int e = 0; e < 8; ++e) { b0[e] = 0.f; b1[e] = 0.f; }
                    if (pos < 2) {
#pragma unroll
                        for (int e = 0; e < 8; ++e) { b0[e] = sc[e]; b1[e] = sc[DFF + e]; } }
#pragma unroll
                    for (int e = 0; e < 8; ++e) { p1[e] = pos >= 1 ? r1[e] : b1[e]; p2[e] = pos >= 2 ? r2[e] : (pos == 1 ? b1[e] : b0[e]); }
                    if (pos >= 6) { float* o = out_vs + (size_t)(b * 2 + (pos - 6)) * DFF + c0;
                        *(f32x4*)o = (f32x4){uu[0], uu[1], uu[2], uu[3]}; *(f32x4*)(o + 4) = (f32x4){uu[4], uu[5], uu[6], uu[7]}; }
                }
                if (valid) { float a[8];
#pragma unroll
                    for (int e = 0; e < 8; e += 2) {
                        const f32x2v xv = (f32x2v){cb[e], cb[e + 1]} + (f32x2v){w0[e], w0[e + 1]} * (f32x2v){p2[e], p2[e + 1]} + (f32x2v){w1[e], w1[e + 1]} * (f32x2v){p1[e], p1[e + 1]} + (f32x2v){w2[e], w2[e + 1]} * (f32x2v){uu[e], uu[e + 1]};
                        const f32x2v ar = xv * ((xv * xv) * (-0.10294324f) + (-2.30220820f));
                        f32x2v ex; ex.x = __builtin_amdgcn_exp2f(ar.x); ex.y = __builtin_amdgcn_exp2f(ar.y);
                        const f32x2v dn = ex + 1.0f; f32x2v rc; rc.x = __builtin_amdgcn_rcpf(dn.x); rc.y = __builtin_amdgcn_rcpf(dn.y);
                        const f32x2v o = (xv * rc) * (f32x2v){vv[e], vv[e + 1]}; a[e] = o.x; a[e + 1] = o.y; }
                    u32x4 w; w.x = cvt_pk_bf16(a[0], a[1]); w.y = cvt_pk_bf16(a[2], a[3]); w.z = cvt_pk_bf16(a[4], a[5]); w.w = cvt_pk_bf16(a[6], a[7]);
                    *(u32x4*)(ACT + (size_t)row * DFF + c0) = w; }
#pragma unroll
                for (int e = 0; e < 8; ++e) uprev[e] = uu[e];
            }
        }
    }
};
#ifndef LAS
#define LAS __attribute__((address_space(3)))
#endif
#define LDS_BARRIER() do { asm volatile("s_waitcnt lgkmcnt(0)" ::: "memory"); __builtin_amdgcn_s_barrier(); asm volatile("" ::: "memory"); } while (0)
typedef short bf16x8 __attribute__((ext_vector_type(8)));
constexpr int QT_OFF = 0, KT_OFF = 17408, KHT_OFF = 34816, VT_OFF = 53248, SW_OFF = 73984, ST_OFF = 83200, RAWV_OFF = 122368, SM_OFF = 138752;
constexpr int F_DLAST = 0, F_PTOT = 128, F_SG = 640, F_SM = 704, F_SWI = 768, F_SMT = 832, F_SWEND = 896, F_SDEN = 960, F_SSSQ = 1024, F_SCAL = 1152;
__device__ __forceinline__ bf16x8 ldfrag(const LAS unsigned char* base, int stride_b, int row, int kcol) { return *(const LAS bf16x8*)(base + row * stride_b + kcol * 2); }
__device__ __forceinline__ f32x4 mfma16(bf16x8 a, bf16x8 b, f32x4 c) { return __builtin_amdgcn_mfma_f32_16x16x32_bf16(a, b, c, 0, 0, 0); }
__device__ __forceinline__ u32x2 pack4(f32x4 v) { return (u32x2){cvt_pk_bf16(v[0], v[1]), cvt_pk_bf16(v[2], v[3])}; }

template <bool IS_ML>
__device__ __forceinline__ void mixer_item(const Params& p, LAS unsigned char* L, const int sqi, const int h, const bool prompt) {
    const int tid = threadIdx.x, w = __builtin_amdgcn_readfirstlane(tid >> 6), lane = tid & 63, l15 = lane & 15, q4 = lane >> 4;
    const int Lc = prompt ? 64 : 8, nch = prompt ? 32 : 1;
    const int row0 = prompt ? sqi * 2048 : MPROMPT + sqi * 8;
    const bf16_t* PROJ = (const bf16_t*)(p.ws + WS_R1) + (IS_ML ? 2048 : 0) + h * 128;
    bf16_t* AMIX = (bf16_t*)p.out + (size_t)MROWS * DM + (IS_ML ? 512 : 0) + h * 128;
    const float* GATES = (const float*)(p.ws + WS_GATES);
    LAS unsigned char* Qt = L + QT_OFF; LAS unsigned char* Kt = L + KT_OFF; LAS unsigned char* KhT = L + KHT_OFF; LAS unsigned char* VT = L + VT_OFF;
    LAS unsigned char* Sw = L + SW_OFF; LAS unsigned char* ST = L + ST_OFF; LAS unsigned char* rawV = L + RAWV_OFF; LAS float* sm = (LAS float*)(L + SM_OFF);
    constexpr int NV = IS_ML ? 9 : 8;
    const int tt = w & 3, vb = w >> 2;
    const size_t sbase = (size_t)(sqi * 4 + h) * 128 * 128;
    f32x4 sacc[NV];
    float m_prev = 0.f;
#pragma unroll
    for (int vt = 0; vt < NV; ++vt) sacc[vt] = (f32x4){0.f, 0.f, 0.f, 0.f};
    if (!prompt) {
        const float* S0 = IS_ML ? p.in[3] : p.in[2];
#pragma unroll
        for (int vt = 0; vt < 8; ++vt)
#pragma unroll
            for (int j = 0; j < 4; ++j) sacc[vt][j] = S0[sbase + (size_t)(w * 16 + q4 * 4 + j) * 128 + vt * 16 + l15];
        if (IS_ML) { m_prev = p.in[5][sqi * 4 + h];
            if (l15 == 0) {
#pragma unroll
                for (int j = 0; j < 4; ++j) sacc[NV - 1][j] = p.in[4][(size_t)(sqi * 4 + h) * 128 + w * 16 + q4 * 4 + j]; } }
    }
    float gnr[4][4];
    { const float* gn = (IS_ML ? p.in[13] : p.in[10]) + h * 128;
#pragma unroll
        for (int i = 0; i < 4; ++i)
#pragma unroll
            for (int j = 0; j < 4; ++j) gnr[i][j] = gn[(vb * 4 + i) * 16 + q4 * 4 + j]; }
    u32x4 rq[2], rk[2], rv[2];
    auto load_raw = [&](int c) {
#pragma unroll
        for (int i = 0; i < 2; ++i) { const int pc = tid + 512 * i, r = pc >> 4, c8 = pc & 15;
            if (r < Lc) { const bf16_t* src = PROJ + (size_t)(row0 + c * 64 + r) * NPROJ + c8 * 8;
                rq[i] = *(const u32x4*)src; rk[i] = *(const u32x4*)(src + 512); rv[i] = *(const u32x4*)(src + 1024); }
            else { rq[i] = (u32x4){0u, 0u, 0u, 0u}; rk[i] = rq[i]; rv[i] = rq[i]; } }
    };
    load_raw(0);
    LDS_BARRIER();
#pragma unroll
    for (int vt = 0; vt < NV; ++vt) *(LAS u32x2*)(ST + (vt * 16 + l15) * 272 + (w * 16 + q4 * 4) * 2) = pack4(sacc[vt]);
    if (IS_ML) { for (int i = tid; i < 16 * 72; i += 512) *(LAS unsigned short*)(VT + (128 * 72 + i) * 2) = (i < 72) ? (unsigned short)0x3F80 : (unsigned short)0; }
    for (int c = 0; c < nch; ++c) {
#pragma unroll
        for (int i = 0; i < 2; ++i) { const int pc = tid + 512 * i, r = pc >> 4, c8 = pc & 15;
            *(LAS u32x4*)(Qt + r * 272 + c8 * 16) = rq[i]; *(LAS u32x4*)(Kt + r * 272 + c8 * 16) = rk[i]; *(LAS u32x4*)(rawV + r * 256 + c8 * 16) = rv[i]; }
        if (IS_ML && w == 0) {
            const int t = lane; float lf = 0.f, ig = -INFINITY;
            if (t < Lc) { const float* gp = GATES + (size_t)(row0 + c * 64 + t) * 8; ig = gp[h]; lf = gp[4 + h]; }
            float a = lf;
#pragma unroll
            for (int o = 1; o < 64; o <<= 1) { const float x = __shfl_up(a, o); if (lane >= o) a += x; }
            const float g = ig - a; float cm = g;
#pragma unroll
            for (int o = 1; o < 64; o <<= 1) { const float x = __shfl_up(cm, o); if (lane >= o) cm = fmaxf(cm, x); }
            const float M = fmaxf(m_prev, cm), M63 = __shfl(M, 63), a63 = __shfl(a, 63);
            sm[F_SG + t] = g; sm[F_SM + t] = M; sm[F_SWI + t] = __expf(m_prev - M); sm[F_SMT + t] = a + M; sm[F_SWEND + t] = __expf(g - M63);
            if (lane == 0) { sm[F_SCAL + 0] = __expf(m_prev - M63); sm[F_SCAL + 1] = a63 + M63; }
        }
        LDS_BARRIER();
        if (c + 1 < nch) load_raw(c + 1);
        { const int k = tid & 127, part = tid >> 7; unsigned short kh[16];
            if (!IS_ML) {
                float lfv[16], cs[16]; float run = 0.f;
#pragma unroll
                for (int i = 0; i < 16; ++i) { lfv[i] = bf2f(*(const LAS unsigned short*)(Kt + (part * 16 + i) * 272 + k * 2)); run += lfv[i]; cs[i] = run; }
                sm[F_PTOT + part * 128 + k] = run;
                LDS_BARRIER();
                float pre = 0.f, tot = 0.f;
#pragma unroll
                for (int pp = 0; pp < 4; ++pp) { const float x = sm[F_PTOT + pp * 128 + k]; tot += x; if (pp < part) pre += x; }
                if (part == 0) sm[F_DLAST + k] = __expf(tot);
#pragma unroll
                for (int i = 0; i < 16; ++i) { const int s = part * 16 + i; const float b = pre + cs[i], e = __expf(b), r = __builtin_amdgcn_rcpf(e), kk = 1.f - __expf(lfv[i]);
                    LAS unsigned short* qp = (LAS unsigned short*)(Qt + s * 272 + k * 2); *qp = f2bf(bf2f(*qp) * e);
                    *(LAS unsigned short*)(Kt + s * 272 + k * 2) = f2bf(kk * r); kh[i] = f2bf(kk * __expf(tot - b)); }
            } else {
#pragma unroll
                for (int i = 0; i < 16; ++i) { const int s = part * 16 + i; kh[i] = f2bf(bf2f(*(const LAS unsigned short*)(Kt + s * 272 + k * 2)) * sm[F_SWEND + s]); }
            }
            u32x4 w0, w1;
            w0.x = kh[0] | ((unsigned)kh[1] << 16); w0.y = kh[2] | ((unsigned)kh[3] << 16); w0.z = kh[4] | ((unsigned)kh[5] << 16); w0.w = kh[6] | ((unsigned)kh[7] << 16);
            w1.x = kh[8] | ((unsigned)kh[9] << 16); w1.y = kh[10] | ((unsigned)kh[11] << 16); w1.z = kh[12] | ((unsigned)kh[13] << 16); w1.w = kh[14] | ((unsigned)kh[15] << 16);
            *(LAS u32x4*)(KhT + k * 144 + part * 32) = w0; *(LAS u32x4*)(KhT + k * 144 + part * 32 + 16) = w1;
            unsigned short vv[16];
#pragma unroll
            for (int i = 0; i < 16; ++i) vv[i] = *(const LAS unsigned short*)(rawV + (part * 16 + i) * 256 + k * 2);
            w0.x = vv[0] | ((unsigned)vv[1] << 16); w0.y = vv[2] | ((unsigned)vv[3] << 16); w0.z = vv[4] | ((unsigned)vv[5] << 16); w0.w = vv[6] | ((unsigned)vv[7] << 16);
            w1.x = vv[8] | ((unsigned)vv[9] << 16); w1.y = vv[10] | ((unsigned)vv[11] << 16); w1.z = vv[12] | ((unsigned)vv[13] << 16); w1.w = vv[14] | ((unsigned)vv[15] << 16);
            *(LAS u32x4*)(VT + k * 144 + part * 32) = w0; *(LAS u32x4*)(VT + k * 144 + part * 32 + 16) = w1;
        }
        LDS_BARRIER();
        { const int pt = w >> 1;
#pragma unroll
            for (int e = 0; e < 2; ++e) { const int st = 2 * (w & 1) + e; f32x4 pa = (f32x4){0.f, 0.f, 0.f, 0.f};
                if (st <= pt) {
#pragma unroll
                    for (int ks = 0; ks < 4; ++ks) pa = mfma16(ldfrag(Kt, 272, st * 16 + l15, ks * 32 + q4 * 8), ldfrag(Qt, 272, pt * 16 + l15, ks * 32 + q4 * 8), pa); }
                const int t = pt * 16 + l15, s0 = st * 16 + q4 * 4; const float Mt = IS_ML ? sm[F_SM + t] : 0.f;
#pragma unroll
                for (int j = 0; j < 4; ++j) { const int s = s0 + j; float x = pa[j]; if (IS_ML) x *= __expf(sm[F_SG + s] - Mt); pa[j] = (s <= t) ? x : 0.f; }
                *(LAS u32x2*)(Sw + t * 144 + s0 * 2) = pack4(pa); } }
        f32x4 oacc[5];
        { bf16x8 bq[4];
#pragma unroll
            for (int ks = 0; ks < 4; ++ks) bq[ks] = ldfrag(Qt, 272, tt * 16 + l15, ks * 32 + q4 * 8);
            const float wi = IS_ML ? sm[F_SWI + tt * 16 + l15] : 1.f;
#pragma unroll
            for (int i = 0; i < 5; ++i) { oacc[i] = (f32x4){0.f, 0.f, 0.f, 0.f};
                if (i < 4 || (IS_ML && vb == 1)) { const int vt = i < 4 ? vb * 4 + i : 8;
#pragma unroll
                    for (int ks = 0; ks < 4; ++ks) oacc[i] = mfma16(ldfrag(ST, 272, vt * 16 + l15, ks * 32 + q4 * 8), bq[ks], oacc[i]);
                    if (IS_ML) oacc[i] = oacc[i] * wi; } } }
        LDS_BARRIER();
        { bf16x8 bs[2];
#pragma unroll
            for (int ks = 0; ks < 2; ++ks) bs[ks] = ldfrag(Sw, 144, tt * 16 + l15, ks * 32 + q4 * 8);
#pragma unroll
            for (int i = 0; i < 5; ++i) if (i < 4 || (IS_ML && vb == 1)) { const int vt = i < 4 ? vb * 4 + i : 8;
#pragma unroll
                for (int ks = 0; ks < 2; ++ks) oacc[i] = mfma16(ldfrag(VT, 144, vt * 16 + l15, ks * 32 + q4 * 8), bs[ks], oacc[i]); } }
        { bf16x8 ak[2];
#pragma unroll
            for (int ks = 0; ks < 2; ++ks) ak[ks] = ldfrag(KhT, 144, w * 16 + l15, ks * 32 + q4 * 8);
            f32x4 dl;
            if (IS_ML) { const float fe = sm[F_SCAL + 0]; dl = (f32x4){fe, fe, fe, fe}; m_prev = sm[F_SCAL + 1]; }
            else dl = *(const LAS f32x4*)(sm + F_DLAST + w * 16 + q4 * 4);
#pragma unroll
            for (int vt = 0; vt < NV; ++vt) { sacc[vt] = sacc[vt] * dl;
#pragma unroll
                for (int ks = 0; ks < 2; ++ks) sacc[vt] = mfma16(ak[ks], ldfrag(VT, 144, vt * 16 + l15, ks * 32 + q4 * 8), sacc[vt]);
                *(LAS u32x2*)(ST + (vt * 16 + l15) * 272 + (w * 16 + q4 * 4) * 2) = pack4(sacc[vt]); } }
        const int t = tt * 16 + l15;
        if (IS_ML) {
            if (vb == 1 && q4 == 0) sm[F_SDEN + t] = oacc[4][0];
            LDS_BARRIER();
            const float inv = 1.0f / fmaxf(fabsf(sm[F_SDEN + t]), __expf(-sm[F_SMT + t]));
#pragma unroll
            for (int i = 0; i < 4; ++i) oacc[i] = oacc[i] * inv;
        }
        float ss = 0.f;
#pragma unroll
        for (int i = 0; i < 4; ++i) ss += (oacc[i][0] * oacc[i][0] + oacc[i][1] * oacc[i][1]) + (oacc[i][2] * oacc[i][2] + oacc[i][3] * oacc[i][3]);
        ss += __shfl_xor(ss, 16); ss += __shfl_xor(ss, 32);
        if (q4 == 0) sm[F_SSSQ + t * 2 + vb] = ss;
        LDS_BARRIER();
        if (t < Lc) { const float rs = rsqrtf((sm[F_SSSQ + t * 2] + sm[F_SSSQ + t * 2 + 1]) * (1.f / 128.f) + EPS);
            const size_t row = (size_t)row0 + c * 64 + t;
#pragma unroll
            for (int i = 0; i < 4; ++i) { const int v0 = (vb * 4 + i) * 16 + q4 * 4; const u32x2 gt = *(const u32x2*)(PROJ + row * NPROJ + 1536 + v0);
                f32x4 o; o[0] = oacc[i][0] * rs * gnr[i][0] * __uint_as_float(gt.x << 16); o[1] = oacc[i][1] * rs * gnr[i][1] * __uint_as_float(gt.x & 0xffff0000u);
                o[2] = oacc[i][2] * rs * gnr[i][2] * __uint_as_float(gt.y << 16); o[3] = oacc[i][3] * rs * gnr[i][3] * __uint_as_float(gt.y & 0xffff0000u);
                *(u32x2*)(AMIX + row * DM + v0) = pack4(o); } }
    }
    { float* So = p.out + (IS_ML ? (prompt ? O_CP : O_CS) : (prompt ? O_SP : O_SS));
#pragma unroll
        for (int vt = 0; vt < 8; ++vt)
#pragma unroll
            for (int j = 0; j < 4; ++j) So[sbase + (size_t)(w * 16 + q4 * 4 + j) * 128 + vt * 16 + l15] = sacc[vt][j];
        if (IS_ML) { if (l15 == 0) { float* no = p.out + (prompt ? O_NP : O_NS) + (size_t)(sqi * 4 + h) * 128;
#pragma unroll
                for (int j = 0; j < 4; ++j) no[w * 16 + q4 * 4 + j] = sacc[NV - 1][j]; }
            if (tid == 0) p.out[(prompt ? O_MP : O_MS) + sqi * 4 + h] = m_prev; } }
}
__device__ __forceinline__ void mixer_dispatch(const Params& p, LAS unsigned char* L, int it) {
    int g, sqi, h; const bool prompt = it < 64;
    if (prompt) { g = it >> 5; sqi = (it >> 2) & 7; h = it & 3; } else { const int j = it - 64; g = j >> 9; sqi = (j >> 2) & 127; h = j & 3; }
    if (g == 0) mixer_item<false>(p, L, sqi, h, prompt); else mixer_item<true>(p, L, sqi, h, prompt);
}
__device__ __forceinline__ void phase2_chunked(const Params& p, LAS unsigned char* L) {
    const int G = gridDim.x, b = blockIdx.x;
    if (G > 64) { if (b < 64) mixer_dispatch(p, L, b); else for (int it = b; it < 1088; it += G - 64) mixer_dispatch(p, L, it); }
    else for (int it = b; it < 1088; it += G) mixer_dispatch(p, L, it);
}
constexpr size_t WS_SB = WS_X1;
template <bool IS_ML>
__device__ __forceinline__ void prepass_item(const Params& p, LAS unsigned char* L, const int sqi, const int c, const int h, u32x4 (&rq)[2], u32x4 (&rk)[2], u32x4 (&rv)[2], float& gig, float& glf,
                                             const bf16_t* nsrc, const float* ngates) {
    const int tid = threadIdx.x, w = __builtin_amdgcn_readfirstlane(tid >> 6), lane = tid & 63, l15 = lane & 15, q4 = lane >> 4;
    const int row0 = sqi * 2048 + c * 64;
    bf16_t* PROJ = (bf16_t*)(p.ws + WS_R1) + (IS_ML ? 2048 : 0) + h * 128;
    bf16_t* AMIX = (bf16_t*)p.out + (size_t)MROWS * DM + (IS_ML ? 512 : 0) + h * 128;
    float* SB = (float*)(p.ws + WS_SB) + (size_t)((((IS_ML ? 8 : 0) + sqi) * 32 + c) * 4 + h) * 256;
    LAS unsigned char* Qt = L + QT_OFF; LAS unsigned char* Kt = L + KT_OFF; LAS unsigned char* KhT = L + KHT_OFF; LAS unsigned char* VT = L + VT_OFF;
    LAS unsigned char* Sw = L + SW_OFF; LAS unsigned char* rawV = L + RAWV_OFF; LAS float* sm = (LAS float*)(L + SM_OFF);
    const int tt = w & 3, vb = w >> 2;
    LDS_BARRIER();
    if (IS_ML) { for (int i = tid; i < 16 * 72; i += 512) *(LAS unsigned short*)(VT + (128 * 72 + i) * 2) = (i < 72) ? (unsigned short)0x3F80 : (unsigned short)0; }
#pragma unroll
    for (int i = 0; i < 2; ++i) { const int pc = tid + 512 * i, r = pc >> 4, c8 = pc & 15;
        *(LAS u32x4*)(Qt + r * 272 + c8 * 16) = rq[i]; *(LAS u32x4*)(Kt + r * 272 + c8 * 16) = rk[i]; *(LAS u32x4*)(rawV + r * 256 + c8 * 16) = rv[i]; }
    if (IS_ML && w == 0) {
        const int t = lane; const float ig = gig, lf = glf;
        float a = lf;
#pragma unroll
        for (int o = 1; o < 64; o <<= 1) { const float x = __shfl_up(a, o); if (lane >= o) a += x; }
        const float g = ig - a; float cm = g;
#pragma unroll
        for (int o = 1; o < 64; o <<= 1) { const float x = __shfl_up(cm, o); if (lane >= o) cm = fmaxf(cm, x); }
        const float M63 = __shfl(cm, 63);
        sm[F_SG + t] = g; sm[F_SM + t] = cm; sm[F_SWEND + t] = __expf(g - M63);
        SB[64 + t] = cm; SB[128 + t] = a;
    }
    if (nsrc) {
#pragma unroll
        for (int i = 0; i < 2; ++i) { const int pc = tid + 512 * i, r = pc >> 4, c8 = pc & 15; const bf16_t* src = nsrc + (size_t)r * NPROJ + c8 * 8;
            rq[i] = *(const u32x4*)src; rk[i] = *(const u32x4*)(src + 512); rv[i] = *(const u32x4*)(src + 1024); }
        if (ngates && w == 0) { gig = ngates[lane * 8]; glf = ngates[lane * 8 + 4]; } }
    LDS_BARRIER();
    { const int k = tid & 127, part = tid >> 7; unsigned short kh[16];
        if (!IS_ML) {
            float lfv[16], cs[16]; float run = 0.f;
#pragma unroll
            for (int i = 0; i < 16; ++i) { lfv[i] = bf2f(*(const LAS unsigned short*)(Kt + (part * 16 + i) * 272 + k * 2)); run += lfv[i]; cs[i] = run; }
            sm[F_PTOT + part * 128 + k] = run;
            LDS_BARRIER();
            float pre = 0.f, tot = 0.f;
#pragma unroll
            for (int pp = 0; pp < 4; ++pp) { const float x = sm[F_PTOT + pp * 128 + k]; tot += x; if (pp < part) pre += x; }
            if (part == 0) SB[k] = __expf(tot);
#pragma unroll
            for (int i = 0; i < 16; ++i) { const int s = part * 16 + i; const float b = pre + cs[i], e = __expf(b), r = __builtin_amdgcn_rcpf(e), kk = 1.f - __expf(lfv[i]);
                LAS unsigned short* qp = (LAS unsigned short*)(Qt + s * 272 + k * 2); *qp = f2bf(bf2f(*qp) * e);
                *(LAS unsigned short*)(Kt + s * 272 + k * 2) = f2bf(kk * r); kh[i] = f2bf(kk * __expf(tot - b)); }
        } else {
#pragma unroll
            for (int i = 0; i < 16; ++i) { const int s = part * 16 + i; kh[i] = f2bf(bf2f(*(const LAS unsigned short*)(Kt + s * 272 + k * 2)) * sm[F_SWEND + s]); }
        }
        u32x4 w0, w1;
        w0.x = kh[0] | ((unsigned)kh[1] << 16); w0.y = kh[2] | ((unsigned)kh[3] << 16); w0.z = kh[4] | ((unsigned)kh[5] << 16); w0.w = kh[6] | ((unsigned)kh[7] << 16);
        w1.x = kh[8] | ((unsigned)kh[9] << 16); w1.y = kh[10] | ((unsigned)kh[11] << 16); w1.z = kh[12] | ((unsigned)kh[13] << 16); w1.w = kh[14] | ((unsigned)kh[15] << 16);
        *(LAS u32x4*)(KhT + k * 144 + part * 32) = w0; *(LAS u32x4*)(KhT + k * 144 + part * 32 + 16) = w1;
        unsigned short vv[16];
#pragma unroll
        for (int i = 0; i < 16; ++i) vv[i] = *(const LAS unsigned short*)(rawV + (part * 16 + i) * 256 + k * 2);
        w0.x = vv[0] | ((unsigned)vv[1] << 16); w0.y = vv[2] | ((unsigned)vv[3] << 16); w0.z = vv[4] | ((unsigned)vv[5] << 16); w0.w = vv[6] | ((unsigned)vv[7] << 16);
        w1.x = vv[8] | ((unsigned)vv[9] << 16); w1.y = vv[10] | ((unsigned)vv[11] << 16); w1.z = vv[12] | ((unsigned)vv[13] << 16); w1.w = vv[14] | ((unsigned)vv[15] << 16);
        *(LAS u32x4*)(VT + k * 144 + part * 32) = w0; *(LAS u32x4*)(VT + k * 144 + part * 32 + 16) = w1;
    }
    LDS_BARRIER();
    { const int pt = w >> 1;
#pragma unroll
        for (int e = 0; e < 2; ++e) { const int st = 2 * (w & 1) + e; f32x4 pa = (f32x4){0.f, 0.f, 0.f, 0.f};
            if (st <= pt) {
#pragma unroll
                for (int ks = 0; ks < 4; ++ks) pa = mfma16(ldfrag(Kt, 272, st * 16 + l15, ks * 32 + q4 * 8), ldfrag(Qt, 272, pt * 16 + l15, ks * 32 + q4 * 8), pa); }
            const int t = pt * 16 + l15, s0 = st * 16 + q4 * 4; const float Mt = IS_ML ? sm[F_SM + t] : 0.f;
#pragma unroll
            for (int j = 0; j < 4; ++j) { const int s = s0 + j; float x = pa[j]; if (IS_ML) x *= __expf(sm[F_SG + s] - Mt); pa[j] = (s <= t) ? x : 0.f; }
            *(LAS u32x2*)(Sw + t * 144 + s0 * 2) = pack4(pa); } }
#pragma unroll
    for (int i = 0; i < 2; ++i) { const int pc = tid + 512 * i;
        if (!IS_ML) { const int r = pc >> 4, c8 = pc & 15; *(u32x4*)(PROJ + (size_t)(row0 + r) * NPROJ + c8 * 8) = *(const LAS u32x4*)(Qt + r * 272 + c8 * 16); }
        const int k = pc >> 3, s8 = pc & 7; bf16_t* dst = PROJ + (size_t)(row0 + (k >> 1)) * NPROJ + (k & 1) * 64 + s8 * 8;
        *(u32x4*)(dst + 512) = *(const LAS u32x4*)(KhT + k * 144 + s8 * 16); *(u32x4*)(dst + 1024) = *(const LAS u32x4*)(VT + k * 144 + s8 * 16); }
    LDS_BARRIER();
    { bf16x8 bs[2];
#pragma unroll
        for (int ks = 0; ks < 2; ++ks) bs[ks] = ldfrag(Sw, 144, tt * 16 + l15, ks * 32 + q4 * 8);
#pragma unroll
        for (int i = 0; i < 5; ++i) if (i < 4 || (IS_ML && vb == 1)) { const int vt = i < 4 ? vb * 4 + i : 8; f32x4 o = (f32x4){0.f, 0.f, 0.f, 0.f};
#pragma unroll
            for (int ks = 0; ks < 2; ++ks) o = mfma16(ldfrag(VT, 144, vt * 16 + l15, ks * 32 + q4 * 8), bs[ks], o);
            const int t = tt * 16 + l15;
            if (i < 4) *(u32x2*)(AMIX + (size_t)(row0 + t) * DM + vt * 16 + q4 * 4) = pack4(o);
            else if (q4 == 0) SB[t] = o[0]; } }
}
constexpr int C_QT = 0, C_KHT = 17408, C_VT = 35840, C_ST0 = 56576, C_ST1 = 95744, C_SM = 134912;
constexpr int CF_WI = 0, CF_RHO = 64, CF_DEN = 128, CF_EMT = 192, CF_SCAL = 256, CF_SSSQ = 272;
template <bool IS_ML>
__device__ __forceinline__ void chain_run(const Params& p, LAS unsigned char* L, const int sqi, const int h, const bool write_out = true) {
    const int tid = threadIdx.x, w = __builtin_amdgcn_readfirstlane(tid >> 6), lane = tid & 63, l15 = lane & 15, q4 = lane >> 4;
    const int row0 = sqi * 2048;
    const bf16_t* PROJ = (const bf16_t*)(p.ws + WS_R1) + (IS_ML ? 2048 : 0) + h * 128;
    bf16_t* AMIX = (bf16_t*)p.out + (size_t)MROWS * DM + (IS_ML ? 512 : 0) + h * 128;
    const float* SB0 = (const float*)(p.ws + WS_SB) + (size_t)((((IS_ML ? 8 : 0) + sqi) * 32) * 4 + h) * 256;
    LAS unsigned char* Qt = L + C_QT; LAS unsigned char* KhT = L + C_KHT; LAS unsigned char* VT = L + C_VT; LAS float* sm = (LAS float*)(L + C_SM);
    constexpr int NV = IS_ML ? 9 : 8;
    const int tt = w & 3, vb = w >> 2, t = tt * 16 + l15;
    const size_t sbase = (size_t)(sqi * 4 + h) * 128 * 128;
    f32x4 sacc[NV];
#pragma unroll
    for (int vt = 0; vt < NV; ++vt) sacc[vt] = (f32x4){0.f, 0.f, 0.f, 0.f};
    float m_prev = 0.f;
    const float* gn = (IS_ML ? p.in[13] : p.in[10]) + h * 128;
    u32x4 rq[2], rk[2], rv[2]; u32x2 rin[4], rgt[4]; f32x4 dl = (f32x4){0.f, 0.f, 0.f, 0.f}; float s_den = 0.f, s_ml = 0.f, s_a = 0.f;
    auto prefetch_big = [&](int c) {
#pragma unroll
        for (int i = 0; i < 2; ++i) { const int pc = tid + 512 * i; const int r = pc >> 4, c8 = pc & 15;
            rq[i] = *(const u32x4*)(PROJ + (size_t)(row0 + c * 64 + r) * NPROJ + c8 * 8);
            const int k = pc >> 3, s8 = pc & 7; const bf16_t* src = PROJ + (size_t)(row0 + c * 64 + (k >> 1)) * NPROJ + (k & 1) * 64 + s8 * 8;
            rk[i] = *(const u32x4*)(src + 512); rv[i] = *(const u32x4*)(src + 1024); }
    };
    auto prefetch_io = [&](int c) {
        const size_t row = (size_t)row0 + c * 64 + t;
#pragma unroll
        for (int i = 0; i < 4; ++i) { const int v0 = (vb * 4 + i) * 16 + q4 * 4; rin[i] = *(const u32x2*)(AMIX + row * DM + v0); rgt[i] = *(const u32x2*)(PROJ + row * NPROJ + 1536 + v0); }
    };
    auto prefetch_sb = [&](int c, f32x4& dl_, float& d_, float& ml_, float& a_) {
        const float* sb = SB0 + (size_t)c * 1024;
        if (!IS_ML) dl_ = *(const f32x4*)(sb + w * 16 + q4 * 4);
        else if (w == 0) { d_ = sb[lane]; ml_ = sb[64 + lane]; a_ = sb[128 + lane]; }
    };
    prefetch_big(0); prefetch_io(0); prefetch_sb(0, dl, s_den, s_ml, s_a);
    LDS_BARRIER();
#pragma unroll
    for (int vt = 0; vt < NV; ++vt) *(LAS u32x2*)(L + C_ST0 + (vt * 16 + l15) * 272 + (w * 16 + q4 * 4) * 2) = (u32x2){0u, 0u};
    if (IS_ML) { for (int i = tid; i < 16 * 72; i += 512) *(LAS unsigned short*)(VT + (128 * 72 + i) * 2) = (i < 72) ? (unsigned short)0x3F80 : (unsigned short)0; }
    for (int c = 0; c < 32; ++c) {
        LAS unsigned char* STr = L + ((c & 1) ? C_ST1 : C_ST0); LAS unsigned char* STw = L + ((c & 1) ? C_ST0 : C_ST1);
#pragma unroll
        for (int i = 0; i < 2; ++i) { const int pc = tid + 512 * i; const int r = pc >> 4, c8 = pc & 15, k = pc >> 3, s8 = pc & 7;
            *(LAS u32x4*)(Qt + r * 272 + c8 * 16) = rq[i]; *(LAS u32x4*)(KhT + k * 144 + s8 * 16) = rk[i]; *(LAS u32x4*)(VT + k * 144 + s8 * 16) = rv[i]; }
        if (IS_ML && w == 0) {
            const float M = fmaxf(m_prev, s_ml), M63 = __shfl(M, 63), ml63 = __shfl(s_ml, 63), a63 = __shfl(s_a, 63);
            sm[CF_WI + lane] = __expf(m_prev - M); sm[CF_RHO + lane] = __expf(s_ml - M); sm[CF_DEN + lane] = s_den; sm[CF_EMT + lane] = __expf(-(s_a + M));
            if (lane == 0) { sm[CF_SCAL + 0] = __expf(m_prev - M63); sm[CF_SCAL + 1] = __expf(ml63 - M63); sm[CF_SCAL + 2] = a63 + M63; }
        }
        LDS_BARRIER();
        f32x4 ndl = dl; float n_den = 0.f, n_ml = 0.f, n_a = 0.f;
        if (c + 1 < 32) { prefetch_big(c + 1); prefetch_sb(c + 1, ndl, n_den, n_ml, n_a); }
        float wi_t = 1.f, rho_t = 1.f, denl_t = 0.f, emt_t = 0.f, fend = 1.f, sigma = 1.f;
        if (IS_ML) { wi_t = sm[CF_WI + t]; rho_t = sm[CF_RHO + t]; denl_t = sm[CF_DEN + t]; emt_t = sm[CF_EMT + t]; fend = sm[CF_SCAL + 0]; sigma = sm[CF_SCAL + 1]; m_prev = sm[CF_SCAL + 2]; }
        f32x4 oacc[5];
        { bf16x8 bq[4];
#pragma unroll
            for (int ks = 0; ks < 4; ++ks) bq[ks] = ldfrag(Qt, 272, tt * 16 + l15, ks * 32 + q4 * 8);
#pragma unroll
            for (int i = 0; i < 5; ++i) { oacc[i] = (f32x4){0.f, 0.f, 0.f, 0.f};
                if (i < 4 || IS_ML) { const int vt = i < 4 ? vb * 4 + i : 8;
#pragma unroll
                    for (int ks = 0; ks < 4; ++ks) oacc[i] = mfma16(ldfrag(STr, 272, vt * 16 + l15, ks * 32 + q4 * 8), bq[ks], oacc[i]); } } }
        { bf16x8 ak[2];
#pragma unroll
            for (int ks = 0; ks < 2; ++ks) ak[ks] = ldfrag(KhT, 144, w * 16 + l15, ks * 32 + q4 * 8);
#pragma unroll
            for (int vt = 0; vt < NV; ++vt) {
                if (!IS_ML) { sacc[vt] = sacc[vt] * dl;
#pragma unroll
                    for (int ks = 0; ks < 2; ++ks) sacc[vt] = mfma16(ak[ks], ldfrag(VT, 144, vt * 16 + l15, ks * 32 + q4 * 8), sacc[vt]); }
                else { f32x4 uacc = (f32x4){0.f, 0.f, 0.f, 0.f};
#pragma unroll
                    for (int ks = 0; ks < 2; ++ks) uacc = mfma16(ak[ks], ldfrag(VT, 144, vt * 16 + l15, ks * 32 + q4 * 8), uacc);
                    sacc[vt] = sacc[vt] * fend + uacc * sigma; }
                *(LAS u32x2*)(STw + (vt * 16 + l15) * 272 + (w * 16 + q4 * 4) * 2) = pack4(sacc[vt]); } }
        float inv = 1.f;
        if (IS_ML) { const float di = __shfl(oacc[4][0], l15); inv = 1.0f / fmaxf(fabsf(wi_t * di + rho_t * denl_t), emt_t); }
        float ss = 0.f;
#pragma unroll
        for (int i = 0; i < 4; ++i) { f32x4 in; in[0] = __uint_as_float(rin[i].x << 16); in[1] = __uint_as_float(rin[i].x & 0xffff0000u); in[2] = __uint_as_float(rin[i].y << 16); in[3] = __uint_as_float(rin[i].y & 0xffff0000u);
            if (IS_ML) oacc[i] = (oacc[i] * wi_t + in * rho_t) * inv; else oacc[i] = oacc[i] + in;
            ss += (oacc[i][0] * oacc[i][0] + oacc[i][1] * oacc[i][1]) + (oacc[i][2] * oacc[i][2] + oacc[i][3] * oacc[i][3]); }
        ss += __shfl_xor(ss, 16); ss += __shfl_xor(ss, 32);
        LAS float* sq = sm + CF_SSSQ + (c & 1) * 128;
        if (q4 == 0) sq[t * 2 + vb] = ss;
        LDS_BARRIER();
        { const float rs = rsqrtf((sq[t * 2] + sq[t * 2 + 1]) * (1.f / 128.f) + EPS); const size_t row = (size_t)row0 + c * 64 + t;
#pragma unroll
            for (int i = 0; i < 4; ++i) { const int v0 = (vb * 4 + i) * 16 + q4 * 4; const u32x2 gt = rgt[i];
                const f32x4 gv = *(const f32x4*)(gn + v0);
                f32x4 o; o[0] = oacc[i][0] * rs * gv[0] * __uint_as_float(gt.x << 16); o[1] = oacc[i][1] * rs * gv[1] * __uint_as_float(gt.x & 0xffff0000u);
                o[2] = oacc[i][2] * rs * gv[2] * __uint_as_float(gt.y << 16); o[3] = oacc[i][3] * rs * gv[3] * __uint_as_float(gt.y & 0xffff0000u);
                if (write_out) *(u32x2*)(AMIX + row * DM + v0) = pack4(o); } }
        if (c + 1 < 32) prefetch_io(c + 1);
        dl = ndl; s_den = n_den; s_ml = n_ml; s_a = n_a;
    }
    { float* So = p.out + (IS_ML ? O_CP : O_SP);
#pragma unroll
        for (int vt = 0; vt < 8; ++vt)
#pragma unroll
            for (int j = 0; j < 4; ++j) So[sbase + (size_t)(w * 16 + q4 * 4 + j) * 128 + vt * 16 + l15] = sacc[vt][j];
        if (IS_ML) { if (l15 == 0) { float* no = p.out + O_NP + (size_t)(sqi * 4 + h) * 128;
#pragma unroll
                for (int j = 0; j < 4; ++j) no[w * 16 + q4 * 4 + j] = sacc[NV - 1][j]; }
            if (tid == 0) p.out[O_MP + sqi * 4 + h] = m_prev; } }
}
#ifndef SAMPLE_TWICE
#define SAMPLE_TWICE 0
#endif
#ifndef SAMPLE_TWICE
#define SAMPLE_TWICE 0
#endif
#ifndef CHAIN_TWICE
#define CHAIN_TWICE 0
#endif
#ifndef NS_A
#define NS_A 0
#endif
__device__ __forceinline__ void sample_dispatch(const Params& p, LAS unsigned char* L, int j) {
    const int g = j >> 9, sqi = (j >> 2) & 127, h = j & 3;
    if (g == 0) mixer_item<false>(p, L, sqi, h, false); else mixer_item<true>(p, L, sqi, h, false);
}
__device__ __forceinline__ void phase2a(const Params& p, LAS unsigned char* L) {
    const int tid = threadIdx.x, lane = tid & 63, w = tid >> 6;
    u32x4 rq[2], rk[2], rv[2]; float gig = 0.f, glf = 0.f;
    auto slot = [&](int it) -> const bf16_t* { const int g = it >> 10, sqi = (it >> 7) & 7, c = (it >> 2) & 31, h = it & 3; return (const bf16_t*)(p.ws + WS_R1) + (size_t)(sqi * 2048 + c * 64) * NPROJ + (g ? 2048 : 0) + h * 128; };
    auto gptr = [&](int it) -> const float* { const int g = it >> 10, sqi = (it >> 7) & 7, c = (it >> 2) & 31, h = it & 3; return g ? (const float*)(p.ws + WS_GATES) + (size_t)(sqi * 2048 + c * 64) * 8 + h : nullptr; };
    int it = blockIdx.x;
    if (it < 2048) { const bf16_t* s0 = slot(it);
#pragma unroll
        for (int i = 0; i < 2; ++i) { const int pc = tid + 512 * i, r = pc >> 4, c8 = pc & 15; const bf16_t* src = s0 + (size_t)r * NPROJ + c8 * 8;
            rq[i] = *(const u32x4*)src; rk[i] = *(const u32x4*)(src + 512); rv[i] = *(const u32x4*)(src + 1024); }
        const float* g0 = gptr(it); if (g0 && w == 0) { gig = g0[lane * 8]; glf = g0[lane * 8 + 4]; } }
    for (; it < 2048; it += gridDim.x) { const int g = it >> 10, sqi = (it >> 7) & 7, c = (it >> 2) & 31, h = it & 3; const int nx = it + gridDim.x;
        const bf16_t* ns = nx < 2048 ? slot(nx) : nullptr; const float* ng = nx < 2048 ? gptr(nx) : nullptr;
        if (g == 0) prepass_item<false>(p, L, sqi, c, h, rq, rk, rv, gig, glf, ns, ng); else prepass_item<true>(p, L, sqi, c, h, rq, rk, rv, gig, glf, ns, ng); }
}
__device__ __forceinline__ void phase2a_samples(const Params& p, LAS unsigned char* L) {
    for (int it = 2048 + blockIdx.x; it < 2048 + NS_A; it += gridDim.x) { sample_dispatch(p, L, it - 2048); if (SAMPLE_TWICE) sample_dispatch(p, L, it - 2048); }
}
__device__ __forceinline__ void phase2_naive(const Params& p, unsigned char* shm) {
    float* sq = (float*)shm; float* sd = sq + 128; float* si = sd + 128; float* sv = si + 128; float* part = sv + 128; float* denp = part + 512; float* red = denp + 4;
    const int tid = threadIdx.x, v = tid & 127, kq = tid >> 7;
    const bf16_t* PROJ = (const bf16_t*)(p.ws + WS_R1); bf16_t* AMIX = (bf16_t*)p.out + (size_t)MROWS * DM; const float* GATES = (const float*)(p.ws + WS_GATES);
    for (int it = blockIdx.x; it < 1088; it += gridDim.x) {
        int g, sqi, h, T, row0; const bool prompt = it < 64;
        if (prompt) { g = it >> 5; sqi = (it >> 2) & 7; h = it & 3; T = 2048; row0 = sqi * 2048; }
        else { const int j = it - 64; g = j >> 9; sqi = (j >> 2) & 127; h = j & 3; T = 8; row0 = MPROMPT + sqi * 8; }
        float S[32], nst[32]; float mst = 0.f;
        const size_t sbase = ((size_t)(sqi * 4 + h) * 128) * 128;
#pragma unroll
        for (int i = 0; i < 32; ++i) { S[i] = 0.f; nst[i] = 0.f; }
        if (!prompt) { const float* S0 = g == 0 ? p.in[2] : p.in[3];
#pragma unroll
            for (int i = 0; i < 32; ++i) S[i] = S0[sbase + (size_t)(kq * 32 + i) * 128 + v];
            if (g == 1) { mst = p.in[5][sqi * 4 + h];
#pragma unroll
                for (int i = 0; i < 32; ++i) nst[i] = p.in[4][(size_t)(sqi * 4 + h) * 128 + kq * 32 + i]; } }
        const float* gn = (g == 0 ? p.in[10] : p.in[13]) + h * 128;
        for (int t = 0; t < T; ++t) {
            const size_t row = (size_t)row0 + t; const bf16_t* pr = PROJ + row * NPROJ + g * 2048 + h * 128;
            float m_new = 0.f;
            if (g == 0) {
                if (tid < 128) sq[tid] = bf2f(pr[tid]);
                else if (tid < 256) { const float f = __expf(bf2f(pr[512 + tid - 128])); sd[tid - 128] = f; si[tid - 128] = 1.f - f; }
                else if (tid < 384) sv[tid - 256] = bf2f(pr[1024 + tid - 256]);
            } else {
                const float ig = GATES[row * 8 + h], lf = GATES[row * 8 + 4 + h];
                m_new = fmaxf(lf + mst, ig); const float fd = __expf(lf + mst - m_new), ii = __expf(ig - m_new);
                if (tid < 128) sq[tid] = bf2f(pr[tid]);
                else if (tid < 256) { sd[tid - 128] = fd; si[tid - 128] = ii * bf2f(pr[512 + tid - 128]); }
                else if (tid < 384) sv[tid - 256] = bf2f(pr[1024 + tid - 256]);
            }
            __syncthreads();
            const float vv = sv[v]; float acc = 0.f, dacc = 0.f;
#pragma unroll
            for (int i = 0; i < 32; ++i) { const int k = kq * 32 + i; const float d = sd[k], ik = si[k], q = sq[k]; S[i] = d * S[i] + ik * vv; acc += q * S[i]; nst[i] = d * nst[i] + ik; dacc += q * nst[i]; }
            part[kq * 128 + v] = acc; if (v == 0) denp[kq] = dacc;
            __syncthreads();
            float o = 0.f;
            if (tid < 128) { o = (part[tid] + part[128 + tid]) + (part[256 + tid] + part[384 + tid]);
                if (g == 1) { const float den = (denp[0] + denp[1]) + (denp[2] + denp[3]); o = o / fmaxf(fabsf(den), __expf(-m_new)); }
                const float ss = wave_sum(o * o); if ((tid & 63) == 0) red[tid >> 6] = ss; }
            __syncthreads();
            if (tid < 128) { const float tot = red[0] + red[1]; const float gate = bf2f(pr[1536 + tid]);
                AMIX[row * DM + g * 512 + h * 128 + tid] = f2bf(o * rsqrtf(tot * (1.f / 128.f) + EPS) * gn[tid] * gate); }
            mst = m_new;
            __syncthreads();
        }
        float* So = p.out + (g == 0 ? (prompt ? O_SP : O_SS) : (prompt ? O_CP : O_CS));
#pragma unroll
        for (int i = 0; i < 32; ++i) So[sbase + (size_t)(kq * 32 + i) * 128 + v] = S[i];
        if (g == 1 && v == 0) { float* no = p.out + (prompt ? O_NP : O_NS) + (size_t)(sqi * 4 + h) * 128;
#pragma unroll
            for (int i = 0; i < 32; ++i) no[kq * 32 + i] = nst[i];
            if (kq == 0) p.out[(prompt ? O_MP : O_MS) + sqi * 4 + h] = mst; }
    }
}
__device__ __forceinline__ void phase5(const Params& p) {
    const float* UHL = (const float*)(p.ws + WS_UHL); const float* UHF = (const float*)(p.ws + WS_UHF); bf16_t* ACT = (bf16_t*)(p.ws + WS_R1 + R1_ACT);
    const float* cw = p.in[18]; const float* cbp = p.in[19];
    constexpr int NQ = DFF / 4;
    for (int i = blockIdx.x * 512 + threadIdx.x; i < 256 * 2 * NQ; i += gridDim.x * 512) {
        const int cq = i % NQ, j = (i / NQ) & 1, gi = i / (2 * NQ), c = 4 * cq; const int row = gi * 64 + j;
        const bool first = (gi & 31) == 0;
        const f32x4 z = (f32x4){0.f, 0.f, 0.f, 0.f};
        const f32x4 l0 = first ? z : *(const f32x4*)(UHL + (size_t)((gi - 1) * 2 + 0) * DFF + c), l1 = first ? z : *(const f32x4*)(UHL + (size_t)((gi - 1) * 2 + 1) * DFF + c);
        const f32x4 u0 = *(const f32x4*)(UHF + (size_t)((gi * 2 + 0) * 2) * DFF + c);
        const f32x4 uu = *(const f32x4*)(UHF + (size_t)((gi * 2 + j) * 2) * DFF + c), vv = *(const f32x4*)(UHF + (size_t)((gi * 2 + j) * 2 + 1) * DFF + c);
        const f32x4 p2 = j == 0 ? l0 : l1, p1 = j == 0 ? l1 : u0;
        const f32x4 w0 = *(const f32x4*)(cw + c), w1 = *(const f32x4*)(cw + DFF + c), w2 = *(const f32x4*)(cw + 2 * DFF + c), cb = *(const f32x4*)(cbp + c);
        float a[4];
#pragma unroll
        for (int e = 0; e < 4; ++e) a[e] = gelu_tanh(cb[e] + w0[e] * p2[e] + w1[e] * p1[e] + w2[e] * uu[e]) * vv[e];
        *(u32x2*)(ACT + (size_t)row * DFF + c) = (u32x2){cvt_pk_bf16(a[0], a[1]), cvt_pk_bf16(a[2], a[3])};
    }
}
__device__ __forceinline__ void phase7(const Params& p) {
    const float* gf = p.in[21]; float* Y = p.out; const float* X1 = (const float*)(p.ws + WS_X1); const float* PART = (const float*)(p.ws + WS_R1 + R1_X1B);
    const int wave = threadIdx.x >> 6, lane = threadIdx.x & 63;
    f32x4 g[4];
#pragma unroll
    for (int j = 0; j < 4; ++j) g[j] = *(const f32x4*)(gf + 4 * lane + 256 * j);
    auto load_row = [&](int row, f32x4 (&v)[4]) {
        if (row < MPROMPT) {
#pragma unroll
            for (int j = 0; j < 4; ++j) v[j] = *(const f32x4*)(Y + (size_t)row * DM + 4 * lane + 256 * j);
        } else {
#pragma unroll
            for (int j = 0; j < 4; ++j) v[j] = *(const f32x4*)(X1 + (size_t)row * DM + 4 * lane + 256 * j);
#pragma unroll
            for (int sl = 0; sl < 7; ++sl)
#pragma unroll
                for (int j = 0; j < 4; ++j) v[j] = v[j] + *(const f32x4*)(PART + (size_t)sl * (1024 * DM) + (size_t)(row - MPROMPT) * DM + 4 * lane + 256 * j);
        }
    };
    int row = blockIdx.x * 8 + wave; f32x4 v[4];
    if (row < MROWS) load_row(row, v);
    while (row < MROWS) {
        const int nrow = row + gridDim.x * 8; f32x4 nv[4];
#pragma unroll
        for (int j = 0; j < 4; ++j) nv[j] = (f32x4){0.f, 0.f, 0.f, 0.f};
        if (nrow < MROWS) load_row(nrow, nv);
        float s = 0.f;
#pragma unroll
        for (int j = 0; j < 4; ++j) s += (v[j].x * v[j].x + v[j].y * v[j].y) + (v[j].z * v[j].z + v[j].w * v[j].w);
        const float rs = rsqrtf(wave_sum(s) * (1.f / DM) + EPS);
#pragma unroll
        for (int j = 0; j < 4; ++j) *(f32x4*)(Y + (size_t)row * DM + 4 * lane + 256 * j) = v[j] * rs * g[j];
#pragma unroll
        for (int j = 0; j < 4; ++j) v[j] = nv[j];
        row = nrow;
    }
}
#define RUN(ph) (((PHMASK >> (ph)) & 1) && ph_lo <= (ph) && (ph) <= ph_hi)
#define SYNC(ph) do { if (ph_lo <= (ph) && (ph) < ph_hi) { xcd_barrier(xb); } } while (0)
#define TWICE(ph, body) do { body; if ((REPMASK >> (ph)) & 1) { xcd_barrier(xb); body; } } while (0)
__device__ __forceinline__ void run_p1(const Params& p, PG8_LAS unsigned char* lds) { bf16_t* H = (bf16_t*)p.out; bf16_t* PROJ = (bf16_t*)(p.ws + WS_R1);
    pg8::StaticOrder S; S.init(MROWS, NIN, gridDim.x, blockIdx.x); pg8::Gemm g{H, (const bf16_t*)(p.ws + WS_WIN), MROWS, NIN, DM};
    EpiInProj E{PROJ, p.in[9], (float*)(p.ws + WS_GATES), p.in[11], p.in[12]}; pg8::gemm_phase(lds, g, S, E); }
__device__ __forceinline__ void run_p3(const Params& p, PG8_LAS unsigned char* lds) { bf16_t* AMIX = (bf16_t*)p.out + (size_t)MROWS * DM; bf16_t* X1B = (bf16_t*)(p.ws + WS_R1 + R1_X1B); float* X1 = (float*)(p.ws + WS_X1);
    pg8::StaticOrder S; S.init((P3_OVERLAP && gridDim.x >= 96) ? MPROMPT : MROWS, DM, gridDim.x, blockIdx.x);   pg8::Gemm g{AMIX, (const bf16_t*)(p.ws + WS_WOUT), MROWS, DM, DM};
    EpiResid E{p.in[0], p.in[1], X1, X1B, (float*)(p.ws + WS_SSQ2), nullptr}; pg8::gemm_phase(lds, g, S, E); }
struct OneUnit { int pm, pn, ntK;
    __device__ bool next(int i, Unit& u) const { if (i) return false; u.pm = pm; u.pn = pn; u.k0 = 0; u.nt = ntK; return true; }
    __device__ __forceinline__ void a_ready(const Unit&) const {}
    __device__ __forceinline__ void done(const Unit&) const {} };
__device__ __forceinline__ void run_p3_sample(const Params& p, PG8_LAS unsigned char* lds, const int j) {
    bf16_t* AMIX = (bf16_t*)p.out + (size_t)MROWS * DM; bf16_t* X1B = (bf16_t*)(p.ws + WS_R1 + R1_X1B); float* X1 = (float*)(p.ws + WS_X1);
    OneUnit S{64 + (j >> 2), j & 3, DM / 64}; pg8::Gemm g{AMIX, (const bf16_t*)(p.ws + WS_WOUT), MROWS, DM, DM};
    EpiResid E{p.in[0], p.in[1], X1, X1B, (float*)(p.ws + WS_SSQ2), nullptr}; pg8::gemm_phase(lds, g, S, E); }
__device__ __forceinline__ void phase2b(const Params& p, PG8_LAS unsigned char* lds, unsigned char* shm) {
    const int b = blockIdx.x, G = gridDim.x;
    if (G >= 96) {
        if (b < 64) { const int g = b >> 5, sqi = (b >> 2) & 7, h = b & 3; if (g == 0) chain_run<false>(p, lds, sqi, h); else chain_run<true>(p, lds, sqi, h); }
        else { for (int j = NS_A + (b - 64); j < 1024; j += G - 64) sample_dispatch(p, lds, j);
            LDS_BARRIER();
            deferred_transposes(p, shm, (b - 64) * 8 + (threadIdx.x >> 6), (G - 64) * 8);
            if (P3_OVERLAP) {
                unsigned* cnt = (unsigned*)(p.ws + WS_CTL) + 32;
                asm volatile("s_waitcnt vmcnt(0)" ::: "memory");
                __syncthreads();
                if (threadIdx.x == 0) { __builtin_amdgcn_fence(__ATOMIC_RELEASE, "agent"); asm volatile("s_waitcnt vmcnt(0)" ::: "memory");
                    __hip_atomic_fetch_add(cnt, 1u, __ATOMIC_RELAXED, __HIP_MEMORY_SCOPE_AGENT); }
                if (b < 80) {
                    if (threadIdx.x == 0) { unsigned sp = 0; const unsigned want = (unsigned)(G - 64);
                        while (__hip_atomic_load(cnt, __ATOMIC_RELAXED, __HIP_MEMORY_SCOPE_AGENT) < want) { __builtin_amdgcn_s_sleep(8); if (++sp > (1u << 22)) break; }
                        __builtin_amdgcn_fence(__ATOMIC_ACQUIRE, "agent"); asm volatile("s_waitcnt vmcnt(0)" ::: "memory"); }
                    __syncthreads();
                    run_p3_sample(p, lds, b - 64);
                }
            } }
    } else {
        for (int it = b; it < 64; it += G) { const int g = it >> 5, sqi = (it >> 2) & 7, h = it & 3; if (g == 0) chain_run<false>(p, lds, sqi, h); else chain_run<true>(p, lds, sqi, h); }
        for (int j = NS_A + b; j < 1024; j += G) sample_dispatch(p, lds, j);
        LDS_BARRIER();
        deferred_transposes(p, shm, b * 8 + (threadIdx.x >> 6), G * 8);
    }
}
__device__ __forceinline__ void run_p4(const Params& p, PG8_LAS unsigned char* lds) { bf16_t* X1B = (bf16_t*)(p.ws + WS_R1 + R1_X1B); bf16_t* ACT = (bf16_t*)(p.ws + WS_R1 + R1_ACT);
    pg8::StaticOrder S; S.init(MROWS, NGV, gridDim.x, blockIdx.x); pg8::Gemm g{X1B, (const bf16_t*)(p.ws + WS_WGV), MROWS, NGV, DM};
    EpiGateVal E{ACT, (const float*)(p.ws + WS_SSQ2), p.in[18], p.in[19], p.in[6], (float*)(p.ws + WS_UHL), (float*)(p.ws + WS_UHF), p.out + O_VP, p.out + O_VS}; pg8::gemm_phase(lds, g, S, E); }
struct DownOrder {
    pg8::StaticOrder S; int G, c;
    __device__ void init(int G_, int c_) { G = G_; c = c_; S.init(MPROMPT, DM, G_, c_, DFF); }
    __device__ bool next(int i, Unit& u) const {
        const int L = i * G + c;
        if (L < 256) { pg8::StaticOrder T = S; T.G = 256; T.c = L; return T.next(0, u); }
        const int r = L - 256; if (r >= 112) return false;
        const int s = r % 7, t = r / 7; u.pm = 64 + (t >> 2); u.pn = t & 3; u.k0 = 384 * s; u.nt = s == 6 ? 8 : 6; return true;
    }
    __device__ __forceinline__ void a_ready(const Unit&) const {}
    __device__ __forceinline__ void done(const Unit&) const {}
};
__device__ __forceinline__ void run_p6(const Params& p, PG8_LAS unsigned char* lds) { bf16_t* ACT = (bf16_t*)(p.ws + WS_R1 + R1_ACT); float* X1 = (float*)(p.ws + WS_X1);
    DownOrder S; S.init(gridDim.x, blockIdx.x); pg8::Gemm g{ACT, (const bf16_t*)(p.ws + WS_WD), MROWS, DM, DFF};
    EpiResid E{X1, X1 + (size_t)MPROMPT * DM, p.out, nullptr, nullptr, (float*)(p.ws + WS_R1 + R1_X1B)}; pg8::gemm_phase(lds, g, S, E); }
__global__ __launch_bounds__(512, 2) void fwd_kernel(Params p, int ph_lo, int ph_hi) {
    extern __shared__ __attribute__((aligned(16))) unsigned char shm[];
    PG8_LAS unsigned char* lds = (PG8_LAS unsigned char*)shm;
    cg::grid_group grid = cg::this_grid();
    volatile LAS unsigned* xst = (volatile LAS unsigned*)(lds + LDS_BYTES - 16);
    if (threadIdx.x == 0) { xst[0] = 0u; xst[1] = 0u; }
    __syncthreads();
    XcdBarrier xb = xcd_barrier_post((unsigned*)(p.ws + WS_BAR), xst);
    if (ph_lo < -1000) grid.sync();
    if (RUN(0)) TWICE(0, phase0(p, shm));
    SYNC(0);
    if (RUN(1)) TWICE(1, run_p1(p, lds));
    SYNC(1);
#if NAIVE_MIXER
    if (RUN(2)) phase2_naive(p, shm);
#else
    if (RUN(2)) { phase2a(p, lds); phase2a_samples(p, lds); xcd_barrier(xb); phase2b(p, lds, shm); }
#endif
    SYNC(2);
    if (RUN(3)) run_p3(p, lds);
    SYNC(3);
    if (RUN(4)) TWICE(4, run_p4(p, lds));
    SYNC(4);
    if (RUN(5)) TWICE(5, phase5(p));
    SYNC(5);
    if (RUN(6)) run_p6(p, lds);
    SYNC(6);
    if (RUN(7)) phase7(p);
#if EXTRA_SYNCS
    for (int i = 0; i < EXTRA_SYNCS; ++i) xcd_barrier(xb);
#endif
}
extern "C" void kernel_launch(void* const* d_in, const int* in_sizes, int n_in, void* d_out, int out_size, void* d_ws, size_t ws_size, hipStream_t stream) {
    static int grid = 0;
    if (grid == 0) {
        if (n_in != 22 || ws_size < WS_END) { fprintf(stderr, "kernel_launch: unexpected n_in %d / ws_size %zu (need %zu)\n", n_in, ws_size, (size_t)WS_END); grid = -1; return; }
        int dev = 0, cus = 0, per_cu = 0;
        hipGetDevice(&dev); hipDeviceGetAttribute(&cus, hipDeviceAttributeMultiprocessorCount, dev);
        if (hipFuncSetAttribute((const void*)fwd_kernel, hipFuncAttributeMaxDynamicSharedMemorySize, LDS_BYTES) != hipSuccess) { fprintf(stderr, "kernel_launch: hipFuncSetAttribute failed\n"); grid = -1; return; }
        if (hipOccupancyMaxActiveBlocksPerMultiprocessor(&per_cu, (const void*)fwd_kernel, 512, LDS_BYTES) != hipSuccess || per_cu < 1) { fprintf(stderr, "kernel_launch: occupancy query says %d blocks per CU\n", per_cu); per_cu = 1; }
        (void)hipGetLastError();
        grid = cus;
        fprintf(stderr, "kernel_launch: cus %d per_cu %d grid %d ws %zu\n", cus, per_cu, grid, ws_size);
    }
    if (grid < 0) return;
    Params p{};
    for (int i = 0; i < 22; ++i) p.in[i] = (const float*)d_in[i];
    p.out = (float*)d_out; p.ws = (unsigned char*)d_ws;
    if (hipMemsetAsync((char*)d_ws + WS_BAR, 0, 16384, stream) != hipSuccess) { fprintf(stderr, "kernel_launch: memset of the barrier words failed\n"); return; }
#if ONE_LAUNCH
    int lo = 0, hi = 7; void* args[] = {&p, &lo, &hi};
    hipError_t e = hipLaunchCooperativeKernel((const void*)fwd_kernel, dim3(grid), dim3(512), args, LDS_BYTES, stream);
    if (e != hipSuccess) fprintf(stderr, "cooperative launch failed: %s (grid %d)\n", hipGetErrorString(e), grid);
#else
    for (int ph = 0; ph < 8; ++ph) hipLaunchKernelGGL(fwd_kernel, dim3(grid), dim3(512), LDS_BYTES, stream, p, ph, ph);
#endif
}
```
